# Optimizing an MI355X kernel written in HIP

```python
import math
import jax, jax.numpy as jnp
from jax import lax
import numpy as np

D_MODEL = 1024
BATCH = 2
SEQ = 16384
DEPTH = 2

CTX_LEN = 256
GRID_W = 64
Q_BLOCK = 128
ROPE_THETA = 10000.0
HEAD_DIM = 64
GROUP_WIDTH = D_MODEL // 4
MIX_WIDTH = 4 * GROUP_WIDTH
A_HEADS = GROUP_WIDTH // HEAD_DIM
A_KV_HEADS = A_HEADS // 2
POOL_WINDOWS = (2, 4, 8, 16)
POOL_GROUP = GROUP_WIDTH // len(POOL_WINDOWS)
C_HEADS = GROUP_WIDTH // HEAD_DIM
C_QK_DIM = HEAD_DIM // 2
D_HEADS = 4
CHUNK = 128
PROJ_WIDTHS = (A_HEADS * HEAD_DIM, A_KV_HEADS * HEAD_DIM, A_KV_HEADS * HEAD_DIM,
               GROUP_WIDTH,
               C_HEADS * 2 * C_QK_DIM, C_HEADS * 2 * C_QK_DIM, C_HEADS * HEAD_DIM,
               GROUP_WIDTH, GROUP_WIDTH)
PROJ_WIDTH = sum(PROJ_WIDTHS)
N_EXPERTS = 64
TOP_K = 8
N_EXPERT_GROUPS = 8
TOPK_GROUPS = 4
EXPERT_HIDDEN = D_MODEL // 4
SHARED_HIDDEN = EXPERT_HIDDEN
ROUTED_SCALE = 2.5

kernel_name = 'hybrid_parallel_heads_dit_block'


def rmsnorm(x, g, eps=1e-6):
    xf = x.astype(jnp.float32)
    y = xf * lax.rsqrt(jnp.mean(xf * xf, axis=-1, keepdims=True) + eps)
    return y.astype(x.dtype) * g


def layernorm_plain(x, eps=1e-5):
    xf = x.astype(jnp.float32)
    mu = jnp.mean(xf, axis=-1, keepdims=True)
    var = jnp.mean(jnp.square(xf - mu), axis=-1, keepdims=True)
    return ((xf - mu) * lax.rsqrt(var + eps)).astype(x.dtype)


def modulate(h, shift, scale):
    return h * (1 + scale) + shift


def axial_rope_tables(rows, dim):
    row = jnp.repeat(jnp.arange(rows, dtype=jnp.float32), GRID_W)
    col = jnp.tile(jnp.arange(GRID_W, dtype=jnp.float32), rows)
    half = dim // 2
    inv = ROPE_THETA ** (-jnp.arange(0, half, 2, dtype=jnp.float32) / half)
    ar = row[:, None] * inv[None, :]
    ac = col[:, None] * inv[None, :]
    ang = jnp.concatenate([ar, ar, ac, ac], axis=-1)
    return jnp.cos(ang), jnp.sin(ang)


def apply_axial_rope(x, cos, sin):
    n, d = cos.shape
    shape = (n,) + (1,) * (x.ndim - 3) + (d,)
    cos = cos.reshape(shape).astype(x.dtype)
    sin = sin.reshape(shape).astype(x.dtype)
    x1, x2, x3, x4 = jnp.split(x, 4, axis=-1)
    rot = jnp.concatenate([-x2, x1, -x4, x3], axis=-1)
    return x * cos + rot * sin


def sweep_query_blocks(fn, q):
    b, s = q.shape[:2]
    nb = s // Q_BLOCK
    qb = jnp.moveaxis(q.reshape((b, nb, Q_BLOCK) + q.shape[2:]), 1, 0)
    ob = lax.map(fn, qb)
    return jnp.moveaxis(ob, 0, 1).reshape((b, s) + ob.shape[3:])


def split_proj(p):
    idx = np.cumsum(np.array(PROJ_WIDTHS))[:-1].tolist()
    return jnp.split(p, idx, axis=-1)


def gqa_attend(q, k, v):
    s = jnp.einsum('bqkgd,bskd->bkgqs', q, k).astype(jnp.float32) * (q.shape[-1] ** -0.5)
    p = jax.nn.softmax(s, axis=-1).astype(v.dtype)
    return jnp.einsum('bkgqs,bskd->bqkgd', p, v)


def mixer_gqa(qc, kc, vc, ql, kl, vl, q_gain, k_gain, rope, need_ctx):
    cos, sin = rope

    def q_heads(p):
        return rmsnorm(p.reshape(p.shape[:2] + (A_KV_HEADS, A_HEADS // A_KV_HEADS, HEAD_DIM)), q_gain)

    def kv_heads(p):
        return p.reshape(p.shape[:2] + (A_KV_HEADS, HEAD_DIM))

    kc_h = rmsnorm(kv_heads(kc), k_gain)
    vc_h = kv_heads(vc)
    kl_h = apply_axial_rope(rmsnorm(kv_heads(kl), k_gain), cos, sin)
    ql_h = apply_axial_rope(q_heads(ql), cos, sin)
    k_all = jnp.concatenate([kc_h, kl_h], axis=1)
    v_all = jnp.concatenate([vc_h, kv_heads(vl)], axis=1)
    yl = sweep_query_blocks(lambda qb: gqa_attend(qb, k_all, v_all), ql_h)
    yl = yl.reshape(yl.shape[:2] + (-1,))
    yc = None
    if need_ctx:
        yc = gqa_attend(q_heads(qc), kc_h, vc_h)
        yc = yc.reshape(yc.shape[:2] + (-1,))
    return yc, yl


def diff_attend(q, k, v, lam):
    s = jnp.einsum('bqhcd,bshcd->bhcqs', q, k).astype(jnp.float32) * (q.shape[-1] ** -0.5)
    p = jax.nn.softmax(s, axis=-1)
    a = (p[:, :, 0] - lam * p[:, :, 1]).astype(v.dtype)
    return jnp.einsum('bhqs,bshd->bqhd', a, v)


def mixer_diff(qc, kc, vc, ql, kl, vl, lam_qk, subln_gain, lam_init, rope, need_ctx):
    cos, sin = rope
    lq = lam_qk.astype(jnp.float32)
    lam = jnp.exp(jnp.sum(lq[0] * lq[1])) - jnp.exp(jnp.sum(lq[2] * lq[3])) + lam_init

    def qk_heads(p):
        return p.reshape(p.shape[:2] + (C_HEADS, 2, C_QK_DIM))

    def v_heads(p):
        return p.reshape(p.shape[:2] + (C_HEADS, HEAD_DIM))

    def finish(o):
        o = rmsnorm(o, subln_gain) * (1.0 - lam_init)
        return o.reshape(o.shape[:2] + (-1,))

    kc_h = qk_heads(kc)
    vc_h = v_heads(vc)
    k_all = jnp.concatenate([kc_h, apply_axial_rope(qk_heads(kl), cos, sin)], axis=1)
    v_all = jnp.concatenate([vc_h, v_heads(vl)], axis=1)
    ql_h = apply_axial_rope(qk_heads(ql), cos, sin)
    yl = finish(sweep_query_blocks(lambda qb: diff_attend(qb, k_all, v_all, lam), ql_h))
    yc = finish(diff_attend(qk_heads(qc), kc_h, vc_h, lam)) if need_ctx else None
    return yc, yl


def mixer_pool(p, pool_w, pool_scale):
    b, n, ch = p.shape
    pf = p.astype(jnp.float32)
    cs = jnp.concatenate([jnp.zeros((b, 1, ch), jnp.float32), jnp.cumsum(pf, axis=1)], axis=1)
    t = np.arange(n)
    outs = []
    for g, w in enumerate(POOL_WINDOWS):
        lo = np.clip(t - w // 2, 0, n)
        hi = np.clip(t - w // 2 + w, 0, n)
        sl = slice(g * POOL_GROUP, (g + 1) * POOL_GROUP)
        cnt = (hi - lo).astype(np.float32)[None, :, None]
        win_mean = (cs[:, hi, sl] - cs[:, lo, sl]) / cnt
        outs.append((win_mean - pf[:, :, sl]).astype(p.dtype) @ pool_w[g])
    return jnp.concatenate(outs, axis=-1) * pool_scale


def mixer_sgu(u, v, sgu_w, sgu_b):
    b, n, w = v.shape
    vc = layernorm_plain(v).reshape(b, n // CHUNK, CHUNK, D_HEADS, w // D_HEADS)
    sv = jnp.einsum('hpq,bnqhc->bnphc', sgu_w, vc) + jnp.transpose(sgu_b)[:, :, None]
    return u * sv.reshape(b, n, w)


def token_mix(pc, pl, a_q_gain, a_k_gain, pool_w, pool_scale, lam_qk, c_subln_gain, lam_init,
              sgu_w, sgu_b, rope_a, rope_c, need_ctx):
    aqc, akc, avc, bc, cqc, ckc, cvc, duc, dvc = split_proj(pc)
    aql, akl, avl, bl, cql, ckl, cvl, dul, dvl = split_proj(pl)
    ya_c, ya_l = mixer_gqa(aqc, akc, avc, aql, akl, avl, a_q_gain, a_k_gain, rope_a, need_ctx)
    yc_c, yc_l = mixer_diff(cqc, ckc, cvc, cql, ckl, cvl, lam_qk, c_subln_gain, lam_init, rope_c, need_ctx)
    yl = jnp.concatenate([ya_l, mixer_pool(bl, pool_w, pool_scale), yc_l,
                          mixer_sgu(dul, dvl, sgu_w, sgu_b)], axis=-1)
    yc = None
    if need_ctx:
        yc = jnp.concatenate([ya_c, mixer_pool(bc, pool_w, pool_scale), yc_c,
                              mixer_sgu(duc, dvc, sgu_w, sgu_b)], axis=-1)
    return yc, yl


def swiglu(h, w1, w3, w2):
    return (jax.nn.silu(h @ w1) * (h @ w3)) @ w2


def moe(h, router_w, router_bias, exp_w1, exp_w3, exp_w2, sh_w1, sh_w3, sh_w2):
    n = h.shape[0]
    scores = jax.nn.sigmoid((h @ router_w).astype(jnp.float32))
    sel = scores + router_bias.astype(jnp.float32)
    per_group = N_EXPERTS // N_EXPERT_GROUPS
    gscore = jnp.sum(lax.top_k(sel.reshape(n, N_EXPERT_GROUPS, per_group), 2)[0], axis=-1)
    _, gidx = lax.top_k(gscore, TOPK_GROUPS)
    gmask = jnp.sum(jax.nn.one_hot(gidx, N_EXPERT_GROUPS, dtype=jnp.float32), axis=1)
    emask = jnp.repeat(gmask, per_group, axis=1) > 0
    _, eidx = lax.top_k(jnp.where(emask, sel, -jnp.inf), TOP_K)
    wts = jnp.take_along_axis(scores, eidx, axis=1)
    wts = wts / jnp.sum(wts, axis=-1, keepdims=True) * ROUTED_SCALE
    gates = jnp.sum(jax.nn.one_hot(eidx, N_EXPERTS, dtype=jnp.float32) * wts[..., None], axis=1)

    def body(acc, ew):
        w1, w3, w2, g = ew
        return acc + g[:, None] * swiglu(h, w1, w3, w2), None

    routed, _ = lax.scan(body, jnp.zeros_like(h), (exp_w1, exp_w3, exp_w2, gates.T.astype(h.dtype)))
    return swiglu(h, sh_w1, sh_w3, sh_w2) + routed


def setup_inputs(seed: int = 0) -> dict:
    key = jax.random.key(seed)
    ks = jax.random.split(key, 32)
    f32 = jnp.float32
    L, D = DEPTH, D_MODEL

    def nrm(k, shape, scale):
        return jax.random.normal(k, shape, f32) * scale

    return {
        'x': nrm(ks[0], (BATCH, SEQ, D), 1.0),
        'c': nrm(ks[1], (BATCH, D), 1.0),
        'ctx': nrm(ks[2], (BATCH, CTX_LEN, D), 1.0),
        'c_ctx': nrm(ks[3], (D,), 1.0),
        'ada_w': nrm(ks[4], (L, D, 6 * D), 0.5 * D ** -0.5),
        'ada_b': nrm(ks[5], (L, 6 * D), 0.02),
        'g_pre_mix': 1.0 + nrm(ks[6], (L, D), 0.05),
        'g_post_mix': 1.0 + nrm(ks[7], (L, D), 0.05),
        'g_pre_ffn': 1.0 + nrm(ks[8], (L, D), 0.05),
        'g_post_ffn': 1.0 + nrm(ks[9], (L, D), 0.05),
        'w_in': nrm(ks[10], (L, D, PROJ_WIDTH), D ** -0.5),
        'w_out': nrm(ks[11], (L, MIX_WIDTH, D), MIX_WIDTH ** -0.5),
        'a_q_gain': 1.0 + nrm(ks[12], (L, HEAD_DIM), 0.05),
        'a_k_gain': 1.0 + nrm(ks[13], (L, HEAD_DIM), 0.05),
        'pool_w': nrm(ks[14], (L, len(POOL_WINDOWS), POOL_GROUP, POOL_GROUP), POOL_GROUP ** -0.5),
        'pool_scale': 1.0 + nrm(ks[15], (L, GROUP_WIDTH), 0.1),
        'lam_qk': nrm(ks[16], (L, 4, C_QK_DIM), 0.1),
        'c_subln_gain': 1.0 + nrm(ks[17], (L, HEAD_DIM), 0.05),
        'sgu_w': nrm(ks[18], (L, D_HEADS, CHUNK, CHUNK), CHUNK ** -0.5),
        'sgu_b': 1.0 + nrm(ks[19], (L, D_HEADS, CHUNK), 0.1),
        'router_w': nrm(ks[20], (L, D, N_EXPERTS), D ** -0.5),
        'router_bias': nrm(ks[21], (L, N_EXPERTS), 0.01),
        'exp_w1': nrm(ks[22], (L, N_EXPERTS, D, EXPERT_HIDDEN), D ** -0.5),
        'exp_w3': nrm(ks[23], (L, N_EXPERTS, D, EXPERT_HIDDEN), D ** -0.5),
        'exp_w2': nrm(ks[24], (L, N_EXPERTS, EXPERT_HIDDEN, D), EXPERT_HIDDEN ** -0.5),
        'sh_w1': nrm(ks[25], (L, D, SHARED_HIDDEN), D ** -0.5),
        'sh_w3': nrm(ks[26], (L, D, SHARED_HIDDEN), D ** -0.5),
        'sh_w2': nrm(ks[27], (L, SHARED_HIDDEN, D), SHARED_HIDDEN ** -0.5),
    }


def reference(x, c, ctx, c_ctx, ada_w, ada_b, g_pre_mix, g_post_mix, g_pre_ffn, g_post_ffn,
              w_in, w_out, a_q_gain, a_k_gain, pool_w, pool_scale, lam_qk, c_subln_gain,
              sgu_w, sgu_b, router_w, router_bias, exp_w1, exp_w3, exp_w2, sh_w1, sh_w3, sh_w2):
    b, s, d = x.shape
    rows = s // GRID_W
    rope_a = axial_rope_tables(rows, HEAD_DIM)
    rope_c = axial_rope_tables(rows, C_QK_DIM)
    silu_c = jax.nn.silu(c)
    silu_cc = jax.nn.silu(c_ctx)
    xl, xc = x, ctx
    for l in range(DEPTH):
        need_ctx = l < DEPTH - 1
        lam_init = 0.8 - 0.6 * math.exp(-0.3 * l)
        mod_l = jnp.split((silu_c @ ada_w[l] + ada_b[l])[:, None, :], 6, axis=-1)
        mod_c = jnp.split(silu_cc @ ada_w[l] + ada_b[l], 6, axis=-1)
        hl = modulate(rmsnorm(xl, g_pre_mix[l]), mod_l[0], mod_l[1])
        hc = modulate(rmsnorm(xc, g_pre_mix[l]), mod_c[0], mod_c[1])
        yc, yl = token_mix(hc @ w_in[l], hl @ w_in[l], a_q_gain[l], a_k_gain[l], pool_w[l], pool_scale[l],
                           lam_qk[l], c_subln_gain[l], lam_init, sgu_w[l], sgu_b[l], rope_a, rope_c, need_ctx)
        xl = xl + mod_l[2] * rmsnorm(yl @ w_out[l], g_post_mix[l])
        if need_ctx:
            xc = xc + mod_c[2] * rmsnorm(yc @ w_out[l], g_post_mix[l])
        tokens = modulate(rmsnorm(xl, g_pre_ffn[l]), mod_l[3], mod_l[4]).reshape(b * s, d)
        if need_ctx:
            hc2 = modulate(rmsnorm(xc, g_pre_ffn[l]), mod_c[3], mod_c[4]).reshape(-1, d)
            tokens = jnp.concatenate([tokens, hc2], axis=0)
        f = moe(tokens, router_w[l], router_bias[l], exp_w1[l], exp_w3[l], exp_w2[l],
                sh_w1[l], sh_w3[l], sh_w2[l])
        xl = xl + mod_l[5] * rmsnorm(f[:b * s].reshape(b, s, d), g_post_ffn[l])
        if need_ctx:
            xc = xc + mod_c[5] * rmsnorm(f[b * s:].reshape(xc.shape), g_post_ffn[l])
    return xl
```

```cpp
#include <hip/hip_runtime.h>
#include <cstdio>
#include <cstdint>

#ifndef MK_ONE_LAUNCH
#define MK_ONE_LAUNCH 0
#endif

#define DI __device__ __forceinline__
#define LAS __attribute__((address_space(3)))
#define GAS __attribute__((address_space(1)))
typedef unsigned short bf16;
typedef short bf16x8 __attribute__((ext_vector_type(8)));
typedef float f32x4 __attribute__((ext_vector_type(4)));
typedef float f32x2 __attribute__((ext_vector_type(2)));
typedef unsigned u32x4 __attribute__((ext_vector_type(4)));
typedef unsigned u32x2 __attribute__((ext_vector_type(2)));

constexpr int D = 1024, NB = 2, SEQ = 16384, NLAT = NB * SEQ, CTXL = 256, NCTX = NB * CTXL, NTOK = NLAT + NCTX;
constexpr int PW = 2048, KEYS = CTXL + SEQ, QROWS = SEQ + CTXL;
constexpr int NEXP = 64, TOPK = 8, EH = 256, NCHUNK = 4, LCAP = NTOK / NCHUNK;
constexpr int NWAVES = 8, NTHREADS = 512;
constexpr float RMS_EPS = 1e-6f, LN_EPS = 1e-5f;
constexpr float LOG2E = 1.4426950408889634f;
constexpr float QA_SCALE = 0.125f * LOG2E;
constexpr float QC_SCALE = 0.17677669529663687f * LOG2E;

constexpr size_t MiB = 1u << 20;
constexpr size_t WS_CTL = 0, CTL_ZERO_BYTES = 1 * MiB;
constexpr size_t WS_MOD = 1 * MiB;
constexpr size_t WS_TAB = 1 * MiB + 256 * 1024;
constexpr size_t WS_TABC = WS_TAB + 32768, WS_SCAL = WS_TAB + 49152;
constexpr size_t WS_SGUW = 2 * MiB;
constexpr size_t WS_POOLW = 2 * MiB + 512 * 1024;
constexpr size_t WS_WIN = 8 * MiB;
constexpr size_t WS_WOUT = 16 * MiB;
constexpr size_t WS_WSH13 = 20 * MiB;
constexpr size_t WS_WSH2 = 22 * MiB;
constexpr size_t WS_XC = 24 * MiB;
constexpr size_t WS_RINFO = 26 * MiB;
constexpr size_t WS_LISTS = 28 * MiB;
constexpr size_t WS_WE13 = 40 * MiB;
constexpr size_t WS_WE2 = 104 * MiB;
constexpr size_t WS_ACT = 136 * MiB;
constexpr size_t WS_R = 201 * MiB;
constexpr size_t WS_PJ = WS_R;
constexpr size_t QA_BYTES = (size_t)NB * 4 * QROWS * 64 * 2, KA_BYTES = (size_t)NB * 2 * KEYS * 64 * 2;
constexpr size_t WS_QA = 331 * MiB, WS_KA = WS_QA + QA_BYTES, WS_VA = WS_KA + KA_BYTES, WS_QC = WS_VA + KA_BYTES;
constexpr size_t WS_KC = WS_QC + QA_BYTES, WS_VC = WS_KC + QA_BYTES;
constexpr size_t WS_Y = 413 * MiB, WS_Z = 478 * MiB;
static_assert(WS_VC + QA_BYTES <= WS_Y, "qkv region");
constexpr int HS_SH_BASE = NTOK * TOPK + NCHUNK * NEXP * 255;
constexpr size_t WS_HS = WS_R;
constexpr size_t WS_OUT2 = 380 * MiB;
constexpr size_t WS_F0 = 510 * MiB;
constexpr size_t WS_END = 575 * MiB;
static_assert(WS_HS + (size_t)(HS_SH_BASE + NTOK) * 512 <= WS_OUT2, "hs region");
constexpr int CW_TMO = 0, CW_BAR = 4096, CW_CNT = 16384;

constexpr int LDS_BYTES = 147456, LDS_SCRATCH = 141312, LDSCTL_OFF = LDS_SCRATCH;
constexpr int MISC_OFF = LDSCTL_OFF;
constexpr int TBL_OFF = LDSCTL_OFF + 128;

DI float bf2f(unsigned v) { return __uint_as_float(v << 16); }
DI unsigned f2bf(float f) { unsigned u = __float_as_uint(f); return (u + 0x7fffu + ((u >> 16) & 1u)) >> 16; }
DI unsigned pk2(float lo, float hi) { return f2bf(lo) | (f2bf(hi) << 16); }
DI float lo16(unsigned w) { return __uint_as_float(w << 16); }
DI float hi16(unsigned w) { return __uint_as_float(w & 0xffff0000u); }
DI float wave_sum(float v) {
#pragma unroll
    for (int o = 1; o < 64; o <<= 1) v += __shfl_xor(v, o);
    return v;
}
#define LDS_WAIT() asm volatile("s_waitcnt lgkmcnt(0)" ::: "memory")
#define VM_WAIT() asm volatile("s_waitcnt vmcnt(0)" ::: "memory")

namespace pg8 {
constexpr int BM = 256, BK = 64, HALF = 128, HTB = HALF * BK * 2, STAGE_BYTES = 8 * HTB, NXCD = 8, WGM = 8;
__host__ __device__ __forceinline__ int lds_byte(int r, int c) { const int st = (r >> 4) * 2 + (c >> 5), rr = r & 15, cc = c & 31, ob = rr * 64 + cc * 2; return st * 1024 + (ob ^ (((ob >> 9) & 1) << 5)); }
__host__ __device__ __forceinline__ void stage_rc(int b, int& R, int& C) { const int st = b / 1024, sb = b % 1024, swz = sb ^ (((sb >> 9) & 1) << 5); R = (st >> 1) * 16 + swz / 64; C = (st & 1) * 32 + (swz % 64) / 2; }
__host__ __device__ __forceinline__ int perm32(int rho) { const int n = rho >> 4, i = rho & 15; return 8 * (i >> 2) + 4 * n + (i & 3); }

struct Unit {
    const char* A;
    const char* B;
    const int* rows;
    int nvalid;
    int orow0;
    int pn;
    int aux;
};

struct DenseOrder {
    const bf16* A; const bf16* Bt; int K; int nM, nN, nwg, G, c;
    DI void init(const bf16* A_, const bf16* Bt_, int M, int N, int K_, int G_, int c_) { A = A_; Bt = Bt_; K = K_; nM = M / BM; nN = N / BM; nwg = nM * nN; G = G_; c = c_; }
    DI bool next(int i, Unit& u) const {
        const long L = (long)i * G + c; if (L >= nwg) return false;
        int wgid = (int)L; { const int q = nwg / NXCD, r = nwg % NXCD, xcd = wgid % NXCD, off = wgid / NXCD; wgid = (xcd < r ? xcd * (q + 1) : r * (q + 1) + (xcd - r) * q) + off; }
        const int nig = WGM * nN, gid = wgid / nig, fm = gid * WGM, gsz = (nM - fm) < WGM ? (nM - fm) : WGM;
        const int pm = fm + ((wgid % nig) % gsz), pn = (wgid % nig) / gsz;
        u.A = (const char*)A + (size_t)pm * BM * K * 2; u.B = (const char*)Bt + (size_t)pn * BM * K * 2; u.rows = nullptr; u.nvalid = BM; u.orow0 = pm * BM; u.pn = pn; u.aux = 0;
        return true;
    }
};

DI unsigned cvt_pk_bf16(float lo, float hi) { unsigned r; asm volatile("v_cvt_pk_bf16_f32 %0, %1, %2" : "=v"(r) : "v"(lo), "v"(hi)); return r; }

struct EpiBf16 {
    static constexpr bool PERM = true;
    bf16* O; int ldc;
    DI void operator()(const f32x4 (&acc)[2][2][4][2], const Unit& u, int wr, int wc, int fr, int fq) const {
        const int row0 = u.orow0 + wr * 64 + fr; const int col0 = u.pn * BM + wc * 32 + 8 * fq;
#pragma unroll
        for (int ai = 0; ai < 2; ++ai)
#pragma unroll
            for (int m = 0; m < 4; ++m) { bf16* rowp = O + (size_t)(row0 + ai * HALF + m * 16) * ldc + col0;
#pragma unroll
                for (int bj = 0; bj < 2; ++bj) { const f32x4 v0 = acc[ai][bj][m][0], v1 = acc[ai][bj][m][1];
                    u32x4 w; w.x = cvt_pk_bf16(v0[0], v0[1]); w.y = cvt_pk_bf16(v0[2], v0[3]); w.z = cvt_pk_bf16(v1[0], v1[1]); w.w = cvt_pk_bf16(v1[2], v1[3]);
                    *(u32x4*)(rowp + bj * HALF) = w; } }
    }
};
struct EpiSwiglu {
    static constexpr bool PERM = false;
    bf16* Hs;
    DI void operator()(const f32x4 (&acc)[2][2][4][2], const Unit& u, int wr, int wc, int fr, int fq) const {
        const int row0 = u.orow0 + wr * 64 + fr; const int f0 = u.pn * 128 + wc * 16 + 4 * fq;
#pragma unroll
        for (int ai = 0; ai < 2; ++ai)
#pragma unroll
            for (int m = 0; m < 4; ++m) { bf16* rowp = Hs + (size_t)(row0 + ai * HALF + m * 16) * EH + f0;
#pragma unroll
                for (int bj = 0; bj < 2; ++bj) { const f32x4 a = acc[ai][bj][m][0], b = acc[ai][bj][m][1]; float h[4];
#pragma unroll
                    for (int j = 0; j < 4; ++j) { const float s = a[j] * __builtin_amdgcn_rcpf(1.0f + __builtin_amdgcn_exp2f(-a[j] * LOG2E)); h[j] = s * b[j]; }
                    u32x2 w; w.x = cvt_pk_bf16(h[0], h[1]); w.y = cvt_pk_bf16(h[2], h[3]);
                    *(u32x2*)(rowp + bj * 64) = w; } }
    }
};
struct EpiMoeOut {
    static constexpr bool PERM = true;
    bf16* OUT2; bf16* F0; int ebase;
    DI void operator()(const f32x4 (&acc)[2][2][4][2], const Unit& u, int wr, int wc, int fr, int fq) const {
        const int col0 = u.pn * BM + wc * 32 + 8 * fq;
        const bool routed = u.rows != nullptr;
        bf16* base = routed ? OUT2 : F0;
        int drow[2][4];
#pragma unroll
        for (int ai = 0; ai < 2; ++ai)
#pragma unroll
            for (int m = 0; m < 4; ++m) { const int r = wr * 64 + fr + ai * HALF + m * 16;
                if (routed) drow[ai][m] = (r < u.nvalid) ? (u.rows[r] - ebase) : -1; else drow[ai][m] = u.orow0 + r; }
#pragma unroll
        for (int ai = 0; ai < 2; ++ai)
#pragma unroll
            for (int m = 0; m < 4; ++m) {
                if (drow[ai][m] >= 0) { bf16* rowp = base + (size_t)drow[ai][m] * D + col0;
#pragma unroll
                for (int bj = 0; bj < 2; ++bj) { const f32x4 v0 = acc[ai][bj][m][0], v1 = acc[ai][bj][m][1];
                    u32x4 w; w.x = cvt_pk_bf16(v0[0], v0[1]); w.y = cvt_pk_bf16(v0[2], v0[3]); w.z = cvt_pk_bf16(v1[0], v1[1]); w.w = cvt_pk_bf16(v1[2], v1[3]);
                    *(u32x4*)(rowp + bj * HALF) = w; } } }
    }
};

template <bool GATHER> DI void set_voff(const Unit& u, unsigned (&v)[2][2], const int (&Rr)[2], const int (&Cc)[2], int K) {
#pragma unroll
    for (int h = 0; h < 2; ++h)
#pragma unroll
        for (int i = 0; i < 2; ++i) {
            if (GATHER && u.rows) { const int r = h * HALF + Rr[i]; const int e = (r < u.nvalid) ? u.rows[r] : 0; v[h][i] = (unsigned)((e >> 3) * K + Cc[i]) * 2u; }
            else v[h][i] = (unsigned)((h * HALF + Rr[i]) * K + Cc[i]) * 2u;
        }
}

template <class Epi, class Sched, bool GATHER>
DI void gemm_phase(LAS unsigned char* lds, const int tid, const int K, const Sched& S, const Epi& E) {
    const int wid = __builtin_amdgcn_readfirstlane(tid >> 6), lane = tid & 63, wr = wid >> 2, wc = wid & 3, fr = lane & 15, fq = lane >> 4;
    const int nt = K / BK;
    int Rr[2], Cc[2]; unsigned voffB[2];
#pragma unroll
    for (int i = 0; i < 2; ++i) { int R, C; stage_rc(tid * 16 + i * 8192, R, C); const int Rb = Epi::PERM ? ((R & ~31) + perm32(R & 31)) : R; Rr[i] = R; Cc[i] = C; voffB[i] = (unsigned)(Rb * K + C) * 2u; }
    const size_t kstep = (size_t)(BK * 2);
    const size_t hstep = (size_t)HALF * K * 2;
    const unsigned ldsw = (unsigned)wid * 1024u;
    const int aoff = lds_byte(wr * 64 + fr, fq * 8), boff = lds_byte(wc * 32 + fr, fq * 8);
#define PG8_SA(b, h) (((b) * 2 + (h)) * HTB)
#define PG8_SB(b, h) ((4 + (b) * 2 + (h)) * HTB)
#define PG8_STAGE(bufoff, gbase, voff) do { _Pragma("unroll") for (int _i = 0; _i < 2; ++_i) \
        __builtin_amdgcn_global_load_lds((const unsigned*)((const char*)(gbase) + (voff)[_i]), (LAS unsigned*)(lds + (bufoff) + ldsw + _i * 8192), 16, 0, 0); } while (0)
#define PG8_LDA(dst, b, h) do { _Pragma("unroll") for (int m = 0; m < 4; ++m) _Pragma("unroll") for (int k = 0; k < 2; ++k) dst[m][k] = *(const LAS bf16x8*)(lds + PG8_SA(b, h) + aoff + m * 2048 + k * 1024); } while (0)
#define PG8_LDB(dst, b, h) do { _Pragma("unroll") for (int n = 0; n < 2; ++n) _Pragma("unroll") for (int k = 0; k < 2; ++k) dst[n][k] = *(const LAS bf16x8*)(lds + PG8_SB(b, h) + boff + n * 2048 + k * 1024); } while (0)
#define PG8_MMA(ai, bj, At, Bt) do { __builtin_amdgcn_s_setprio(1); _Pragma("unroll") for (int m = 0; m < 4; ++m) _Pragma("unroll") for (int n = 0; n < 2; ++n) _Pragma("unroll") for (int k = 0; k < 2; ++k) \
        acc[ai][bj][m][n] = __builtin_amdgcn_mfma_f32_16x16x32_bf16(Bt[n][k], At[m][k], acc[ai][bj][m][n], 0, 0, 0); __builtin_amdgcn_s_setprio(0); } while (0)
#define PG8_WAIT_V(n) asm volatile("s_waitcnt vmcnt(" #n ")" ::: "memory")
#define PG8_WAIT_L(n) asm volatile("s_waitcnt lgkmcnt(" #n ")" ::: "memory")
#define PG8_BAR __builtin_amdgcn_s_barrier()
#define PG8_SCHED __builtin_amdgcn_sched_barrier(0)
    Unit cur, nxt; int ui = 0;
    if (!S.next(0, cur)) return;
    f32x4 acc[2][2][4][2];
#pragma unroll
    for (int a = 0; a < 2; ++a)
#pragma unroll
        for (int b = 0; b < 2; ++b)
#pragma unroll
            for (int m = 0; m < 4; ++m)
#pragma unroll
                for (int n = 0; n < 2; ++n) acc[a][b][m][n] = (f32x4){0.f, 0.f, 0.f, 0.f};
    bf16x8 At[4][2], B0[2][2], B1[2][2];
    unsigned voC[2][2], voN[2][2];
    set_voff<GATHER>(cur, voC, Rr, Cc, K);
    const char* cA = cur.A; const char* cB = cur.B;
    PG8_STAGE(PG8_SB(0, 0), cB, voffB); PG8_STAGE(PG8_SB(0, 1), cB + hstep, voffB); PG8_STAGE(PG8_SA(0, 0), cA, voC[0]); PG8_STAGE(PG8_SA(0, 1), cA, voC[1]);
    if (wr == 1) PG8_BAR;
    PG8_WAIT_V(2); PG8_BAR;
    PG8_STAGE(PG8_SB(1, 0), cB + kstep, voffB); PG8_STAGE(PG8_SA(1, 0), cA + kstep, voC[0]); PG8_STAGE(PG8_SB(1, 1), cB + hstep + kstep, voffB);
    PG8_WAIT_V(6); PG8_BAR;
    for (;;) {
        const bool has_next = S.next(ui + 1, nxt);
        const char* nA = has_next ? nxt.A : cA; const char* nB = has_next ? nxt.B : cB;
        if (GATHER && has_next) set_voff<GATHER>(nxt, voN, Rr, Cc, K);
        else {
#pragma unroll
            for (int h = 0; h < 2; ++h)
#pragma unroll
                for (int i = 0; i < 2; ++i) voN[h][i] = voC[h][i]; }
#pragma unroll 1
        for (int t = 0; t < nt; t += 2) {
            const bool last = (t == nt - 2);
            const char* a1 = cA + (size_t)(t + 1) * kstep;
            const char* a2 = last ? nA : cA + (size_t)(t + 2) * kstep; const char* b2 = last ? nB : cB + (size_t)(t + 2) * kstep;
            const char* a3 = a2 + kstep; const char* b3 = b2 + kstep;
            unsigned vo2[2][2];
#pragma unroll
            for (int h = 0; h < 2; ++h)
#pragma unroll
                for (int i = 0; i < 2; ++i) vo2[h][i] = (GATHER && last) ? voN[h][i] : voC[h][i];
            PG8_LDB(B0, 0, 0); PG8_LDB(B1, 0, 1); PG8_SCHED; PG8_LDA(At, 0, 0); PG8_STAGE(PG8_SA(1, 1), a1, voC[1]);
            PG8_WAIT_V(8); PG8_WAIT_L(0); PG8_BAR; PG8_MMA(0, 0, At, B0); PG8_MMA(0, 1, At, B1); PG8_BAR; PG8_SCHED;
            PG8_LDA(At, 0, 1); PG8_STAGE(PG8_SB(0, 0), b2, voffB); PG8_STAGE(PG8_SB(0, 1), b2 + hstep, voffB); PG8_STAGE(PG8_SA(0, 0), a2, vo2[0]);
            PG8_WAIT_V(8); PG8_WAIT_L(0); PG8_BAR; PG8_MMA(1, 0, At, B0); PG8_MMA(1, 1, At, B1); PG8_BAR; PG8_SCHED;
            PG8_LDB(B0, 1, 0); PG8_LDB(B1, 1, 1); PG8_SCHED; PG8_LDA(At, 1, 0); PG8_STAGE(PG8_SA(0, 1), a2, vo2[1]);
            PG8_WAIT_V(8); PG8_WAIT_L(0); PG8_BAR; PG8_MMA(0, 0, At, B0); PG8_MMA(0, 1, At, B1); PG8_BAR; PG8_SCHED;
            PG8_LDA(At, 1, 1); PG8_STAGE(PG8_SB(1, 0), b3, voffB); PG8_STAGE(PG8_SB(1, 1), b3 + hstep, voffB); PG8_STAGE(PG8_SA(1, 0), a3, vo2[0]);
            PG8_WAIT_V(8); PG8_WAIT_L(0); PG8_BAR; PG8_MMA(1, 0, At, B0); PG8_MMA(1, 1, At, B1); PG8_BAR; PG8_SCHED;
        }
        if (wr == 0) PG8_BAR;
        E(acc, cur, wr, wc, fr, fq);
        if (!has_next) break;
#pragma unroll
        for (int a = 0; a < 2; ++a)
#pragma unroll
            for (int b = 0; b < 2; ++b)
#pragma unroll
                for (int m = 0; m < 4; ++m)
#pragma unroll
                    for (int n = 0; n < 2; ++n) acc[a][b][m][n] = (f32x4){0.f, 0.f, 0.f, 0.f};
        cur = nxt; cA = nA; cB = nB; ++ui;
#pragma unroll
        for (int h = 0; h < 2; ++h)
#pragma unroll
            for (int i = 0; i < 2; ++i) voC[h][i] = voN[h][i];
        if (wr == 1) PG8_BAR;
    }
    PG8_WAIT_V(0);
    PG8_BAR;
#undef PG8_SA
#undef PG8_SB
#undef PG8_STAGE
#undef PG8_LDA
#undef PG8_LDB
#undef PG8_MMA
#undef PG8_WAIT_V
#undef PG8_WAIT_L
#undef PG8_BAR
#undef PG8_SCHED
}
}

#define XB_TMO      128
#define XB_XCNT(j)  (256  + 64 * (j))
#define XB_XSUB(j)  (1280 + 64 * (j))
#define XB_XGEN(j)  (2304 + 64 * (j))
#define XB_TOP      3328
#define XB_TOPGEN   3392
#define XCD_BAR_WORDS 3456
#define XB_SPIN_CAP (1u << 18)
DI unsigned xb_ld(unsigned* p)              { return __hip_atomic_load(p, __ATOMIC_RELAXED, __HIP_MEMORY_SCOPE_AGENT); }
DI unsigned xb_add(unsigned* p, unsigned v) { return __hip_atomic_fetch_add(p, v, __ATOMIC_RELAXED, __HIP_MEMORY_SCOPE_AGENT); }
DI unsigned xb_xcc_id() { return (unsigned)__builtin_amdgcn_s_getreg((3 << 11) | 20) & 0xFu; }
#define XB_SPIN(cond, bar) do { unsigned _sp = 0; while (cond) { __builtin_amdgcn_s_sleep(1); \
    if ((++_sp & 255u) == 0u) { if (xb_ld(&(bar)[XB_TMO])) break; if (_sp > XB_SPIN_CAP) { atomicAdd(&(bar)[XB_TMO], 1u); break; } } } } while (0)
struct XcdBarrier { unsigned* bar; unsigned x; volatile LAS unsigned* st; };
DI XcdBarrier xcd_barrier_post(unsigned* bar, volatile LAS unsigned* st) {
    XcdBarrier b; b.bar = bar; b.x = xb_xcc_id(); b.st = st;
    if (threadIdx.x == 0) (void)xb_add(&bar[XB_XCNT(b.x)], 1u);
    return b;
}
DI void xcd_barrier_complete(unsigned* bar, unsigned x, unsigned& nloc, unsigned& nx) {
    const unsigned G = gridDim.x * gridDim.y * gridDim.z;
    unsigned sum, cnt, mine, sp = 0u;
    for (;;) {
        sum = 0u; cnt = 0u; mine = 0u;
#pragma unroll
        for (unsigned j = 0; j < 16; ++j) { const unsigned c = xb_ld(&bar[XB_XCNT(j)]); sum += c; cnt += (c > 0u) ? 1u : 0u; mine = (j == x) ? c : mine; }
        if (sum == G) break;
        __builtin_amdgcn_s_sleep(1);
        if ((++sp & 255u) == 0u) { if (xb_ld(&bar[XB_TMO])) break; if (sp > XB_SPIN_CAP) { atomicAdd(&bar[XB_TMO], 1u); break; } }
    }
    nloc = mine > 0u ? mine : 1u; nx = cnt > 0u ? cnt : 1u;
}
DI void xcd_barrier(const XcdBarrier& b) {
    asm volatile("s_waitcnt vmcnt(0)" ::: "memory");
    __syncthreads();
    if (threadIdx.x == 0) {
        unsigned* bar = b.bar;
        __builtin_amdgcn_s_waitcnt(0);
        unsigned nloc = b.st[0], nx = b.st[1];
        if (nloc == 0u) { xcd_barrier_complete(bar, b.x, nloc, nx); b.st[0] = nloc; b.st[1] = nx; }
        const unsigned old = xb_add(&bar[XB_XSUB(b.x)], 1u);
        const unsigned gen = old / nloc;
        if (old + 1u == (gen + 1u) * nloc) {
            __builtin_amdgcn_fence(__ATOMIC_RELEASE, "agent");
            asm volatile("s_waitcnt vmcnt(0)" ::: "memory");
            const unsigned og = xb_add(&bar[XB_TOP], 1u);
            const unsigned tg = og / nx;
            if (og + 1u == (tg + 1u) * nx) xb_add(&bar[XB_TOPGEN], 1u);
            else XB_SPIN(xb_ld(&bar[XB_TOPGEN]) == tg, bar);
            __builtin_amdgcn_fence(__ATOMIC_ACQUIRE, "agent");
            xb_add(&bar[XB_XGEN(b.x)], 1u);
            asm volatile("s_waitcnt vmcnt(0)" ::: "memory");
        } else {
            XB_SPIN(xb_ld(&bar[XB_XGEN(b.x)]) == gen, bar);
            __builtin_amdgcn_fence(__ATOMIC_ACQUIRE, "agent");
            asm volatile("s_waitcnt vmcnt(0)" ::: "memory");
        }
    }
    __syncthreads();
}

struct Args { const float* in[28]; float* out; unsigned char* ws; int ph_lo, ph_hi; };
enum { I_X = 0, I_C, I_CTX, I_CCTX, I_ADAW, I_ADAB, I_GPREMIX, I_GPOSTMIX, I_GPREFFN, I_GPOSTFFN, I_WIN, I_WOUT, I_AQG, I_AKG, I_POOLW, I_POOLS, I_LAMQK, I_CSUBLN,
       I_SGUW, I_SGUB, I_ROUTERW, I_ROUTERB, I_EW1, I_EW3, I_EW2, I_SW1, I_SW3, I_SW2 };

struct Frame {
    LAS unsigned char* lds;
    int tid, lane, wave, G, bid;
    const float* const* in; float* out; unsigned char* ws;
};

DI size_t opaque0() { unsigned z; asm volatile("s_mov_b32 %0, 0" : "=s"(z)); return (size_t)z; }
#ifdef NO_LAUNDER
DI Frame fresh(const Frame& F) { return F; }
#else
DI Frame fresh(const Frame& F) { Frame G = F; const size_t z = opaque0(); G.ws = F.ws + z; G.in = F.in + z; G.out = F.out + z; G.tid = F.tid + (int)z; G.lane = G.tid & 63; G.wave = __builtin_amdgcn_readfirstlane(G.tid >> 6); G.bid = F.bid + (int)z; G.G = F.G + (int)z; G.lds = F.lds + z; return G; }
#endif
DI void load_row_f32(const float* p, int lane, f32x4 (&v)[4]) {
#pragma unroll
    for (int j = 0; j < 4; ++j) v[j] = *(const f32x4*)(p + 4 * lane + 256 * j);
}
DI void load_row_bf16(const bf16* p, int lane, f32x4 (&v)[4]) {
#pragma unroll
    for (int j = 0; j < 4; ++j) { const u32x2 w = *(const u32x2*)(p + 4 * lane + 256 * j); v[j] = (f32x4){lo16(w.x), hi16(w.x), lo16(w.y), hi16(w.y)}; }
}
DI void store_row_f32(float* p, int lane, const f32x4 (&v)[4]) {
#pragma unroll
    for (int j = 0; j < 4; ++j) *(f32x4*)(p + 4 * lane + 256 * j) = v[j];
}
DI void store_row_bf16(bf16* p, int lane, const f32x4 (&v)[4]) {
#pragma unroll
    for (int j = 0; j < 4; ++j) { u32x2 w; w.x = pk2(v[j][0], v[j][1]); w.y = pk2(v[j][2], v[j][3]); *(u32x2*)(p + 4 * lane + 256 * j) = w; }
}
DI float row_sumsq(const f32x4 (&v)[4]) {
    float s = 0.f;
#pragma unroll
    for (int j = 0; j < 4; ++j) s += (v[j][0] * v[j][0] + v[j][1] * v[j][1]) + (v[j][2] * v[j][2] + v[j][3] * v[j][3]);
    return wave_sum(s);
}
DI void norm_mod(f32x4 (&v)[4], float rstd, const float* g, const float* shift, const float* scale, int lane) {
#pragma unroll
    for (int j = 0; j < 4; ++j) { const int c = 4 * lane + 256 * j; const f32x4 gg = *(const f32x4*)(g + c), sh = *(const f32x4*)(shift + c), sc = *(const f32x4*)(scale + c);
        v[j] = (v[j] * rstd * gg) * (1.0f + sc) + sh; }
}
DI const float* modp(const Frame& F, int l, int r, int j) { return (const float*)(F.ws + WS_MOD) + ((size_t)(l * 3 + r) * 6 + j) * D; }
DI int mod_row(int row) { return row < NLAT ? row / SEQ : 2; }

template <class RowMap>
DI void transpose_item(const float* W, int K, int N, bf16* WT, const RowMap& rm, LAS float* scr, int item, int lane) {
    const int nblk = N / 32, kb = item / nblk, nb = item % nblk, k0 = 64 * kb, n0 = 32 * nb;
#pragma unroll 8
    for (int i = 0; i < 32; ++i) { const int kk = 2 * i + (lane >> 5); scr[kk * 33 + (lane & 31)] = W[(size_t)(k0 + kk) * N + n0 + (lane & 31)]; }
    LDS_WAIT(); asm volatile("" ::: "memory");
    const int c = lane & 7;
#pragma unroll
    for (int j = 0; j < 4; ++j) { const int n = (lane >> 3) + 8 * j; const LAS float* s = scr + (8 * c) * 33 + n;
        u32x4 o; o.x = pk2(s[0 * 33], s[1 * 33]); o.y = pk2(s[2 * 33], s[3 * 33]); o.z = pk2(s[4 * 33], s[5 * 33]); o.w = pk2(s[6 * 33], s[7 * 33]);
        *(u32x4*)(WT + (size_t)rm(n0 + n) * K + k0 + 8 * c) = o; }
    LDS_WAIT(); asm volatile("" ::: "memory");
}
struct RowId { int off; DI int operator()(int n) const { return off + n; } };
struct RowW13 { int which; DI int operator()(int f) const { return ((f >> 4) << 5) + (f & 15) + 16 * which; } };

DI void convert_experts(const Frame& F, int l, LAS float* scr) {
    const int gw = F.bid * NWAVES + F.wave, NGW = F.G * NWAVES;
    bf16* WE13 = (bf16*)(F.ws + WS_WE13); bf16* WE2 = (bf16*)(F.ws + WS_WE2);
    constexpr int IT = 128;
    for (int it = gw; it < NEXP * 3 * IT; it += NGW) {
        const int e = it / (3 * IT), r = it % (3 * IT), m = r / IT, item = r % IT;
        const size_t eo = ((size_t)l * NEXP + e) * (size_t)(D * EH);
        if (m == 0) transpose_item(F.in[I_EW1] + eo, D, EH, WE13 + (size_t)e * 512 * D, RowW13{0}, scr, item, F.lane);
        else if (m == 1) transpose_item(F.in[I_EW3] + eo, D, EH, WE13 + (size_t)e * 512 * D, RowW13{1}, scr, item, F.lane);
        else transpose_item(F.in[I_EW2] + eo, EH, D, WE2 + (size_t)e * D * EH, RowId{0}, scr, item, F.lane);
    }
}

DI void phase_pro_a(const Frame& F) {
    LAS float* scrw = (LAS float*)(F.lds + F.wave * 16384);
    if (F.bid < 192) {
        const int l = F.bid / 96, cg = F.bid % 96, n = cg * 64 + F.lane;
        const float* W = F.in[I_ADAW] + (size_t)l * D * 6144;
        float a0 = 0.f, a1 = 0.f, a2 = 0.f;
        const int k0 = F.wave * 128;
#pragma unroll 8
        for (int k = k0; k < k0 + 128; ++k) {
            const float w = W[(size_t)k * 6144 + n];
            const float c0 = F.in[I_C][k], c1 = F.in[I_C][D + k], c2 = F.in[I_CCTX][k];
            a0 += w * (c0 / (1.0f + __expf(-c0))); a1 += w * (c1 / (1.0f + __expf(-c1))); a2 += w * (c2 / (1.0f + __expf(-c2)));
        }
        LAS float* red = (LAS float*)(F.lds + 131072);
        red[(F.wave * 3 + 0) * 64 + F.lane] = a0; red[(F.wave * 3 + 1) * 64 + F.lane] = a1; red[(F.wave * 3 + 2) * 64 + F.lane] = a2;
        __syncthreads();
        if (F.wave < 3) { float s = F.in[I_ADAB][l * 6144 + n];
#pragma unroll
            for (int w = 0; w < 8; ++w) s += red[(w * 3 + F.wave) * 64 + F.lane];
            ((float*)(F.ws + WS_MOD))[(size_t)(l * 3 + F.wave) * 6144 + n] = s; }
        __syncthreads();
    }
    const int gw = F.bid * NWAVES + F.wave, NGW = F.G * NWAVES;
    {
        constexpr int I_IN = 16 * 64, I_OUT = 16 * 32, I_S = 128;
        constexpr int PER_L = I_IN + I_OUT + 3 * I_S;
        for (int it = gw; it < 2 * PER_L; it += NGW) {
            const int l = it / PER_L; int r = it % PER_L;
            if (r < I_IN) { transpose_item(F.in[I_WIN] + (size_t)l * D * PW, D, PW, (bf16*)(F.ws + WS_WIN) + (size_t)l * PW * D, RowId{0}, scrw, r, F.lane); continue; } r -= I_IN;
            if (r < I_OUT) { transpose_item(F.in[I_WOUT] + (size_t)l * D * D, D, D, (bf16*)(F.ws + WS_WOUT) + (size_t)l * D * D, RowId{0}, scrw, r, F.lane); continue; } r -= I_OUT;
            bf16* S13 = (bf16*)(F.ws + WS_WSH13) + (size_t)l * 512 * D; bf16* S2 = (bf16*)(F.ws + WS_WSH2) + (size_t)l * D * EH;
            if (r < I_S) { transpose_item(F.in[I_SW1] + (size_t)l * D * EH, D, EH, S13, RowW13{0}, scrw, r, F.lane); continue; } r -= I_S;
            if (r < I_S) { transpose_item(F.in[I_SW3] + (size_t)l * D * EH, D, EH, S13, RowW13{1}, scrw, r, F.lane); continue; } r -= I_S;
            transpose_item(F.in[I_SW2] + (size_t)l * EH * D, EH, D, S2, RowId{0}, scrw, r, F.lane);
        }
    }
    convert_experts(F, 0, scrw);
    const int gt = F.bid * NTHREADS + F.tid, NGT = F.G * NTHREADS;
    for (int i = gt; i < 2 * 4 * 128 * 128; i += NGT) ((bf16*)(F.ws + WS_SGUW))[i] = (bf16)f2bf(F.in[I_SGUW][i]);
    for (int i = gt; i < 2 * 4 * 64 * 64; i += NGT) { const int lg = i / 4096, n = (i / 64) % 64, k = i % 64; ((bf16*)(F.ws + WS_POOLW))[i] = (bf16)f2bf(F.in[I_POOLW][(size_t)lg * 4096 + k * 64 + n]); }
    for (int i = gt; i < 256 * 16; i += NGT) { const int p = i / 16, f = i % 16; const float inv = powf(10000.0f, -(float)f / 16.0f); const float ang = (float)p * inv;
        ((float*)(F.ws + WS_TAB))[2 * i] = cosf(ang); ((float*)(F.ws + WS_TAB))[2 * i + 1] = sinf(ang); }
    for (int i = gt; i < 256 * 8; i += NGT) { const int p = i / 8, f = i % 8; const float inv = powf(10000.0f, -(float)f / 8.0f); const float ang = (float)p * inv;
        ((float*)(F.ws + WS_TABC))[2 * i] = cosf(ang); ((float*)(F.ws + WS_TABC))[2 * i + 1] = sinf(ang); }
    if (gt < 2) { const int l = gt; const float* lq = F.in[I_LAMQK] + l * 128; float s0 = 0.f, s1 = 0.f;
        for (int i = 0; i < 32; ++i) { s0 += lq[i] * lq[32 + i]; s1 += lq[64 + i] * lq[96 + i]; }
        const float lam_init = 0.8f - 0.6f * expf(-0.3f * (float)l);
        float* sc = (float*)(F.ws + WS_SCAL); sc[2 * l] = expf(s0) - expf(s1) + lam_init; sc[2 * l + 1] = lam_init; }
}

DI void phase_pro_b(const Frame& F) {
    const int gw = F.bid * NWAVES + F.wave, NGW = F.G * NWAVES;
    bf16* ACT = (bf16*)(F.ws + WS_ACT);
    for (int row = gw; row < NTOK; row += NGW) {
        const float* src = row < NLAT ? F.in[I_X] + (size_t)row * D : F.in[I_CTX] + (size_t)(row - NLAT) * D;
        f32x4 v[4]; load_row_f32(src, F.lane, v);
        const float rstd = rsqrtf(row_sumsq(v) * (1.0f / D) + RMS_EPS);
        const int r = mod_row(row);
        norm_mod(v, rstd, F.in[I_GPREMIX], modp(F, 0, r, 0), modp(F, 0, r, 1), F.lane);
        store_row_bf16(ACT + (size_t)row * D, F.lane, v);
    }
}

DI void rope8(float (&x)[8], int px, bool second, const float* tab) {
#pragma unroll
    for (int e = 0; e < 8; ++e) { const float p = __shfl_xor(x[e], px); const float c = tab[2 * e], s = tab[2 * e + 1]; x[e] = x[e] * c + (second ? p : -p) * s; }
}
DI void unpack8(const u32x4 w, float (&x)[8]) { x[0] = lo16(w.x); x[1] = hi16(w.x); x[2] = lo16(w.y); x[3] = hi16(w.y); x[4] = lo16(w.z); x[5] = hi16(w.z); x[6] = lo16(w.w); x[7] = hi16(w.w); }
DI u32x4 pack8(const float (&x)[8]) { u32x4 w; w.x = pk2(x[0], x[1]); w.y = pk2(x[2], x[3]); w.z = pk2(x[4], x[5]); w.w = pk2(x[6], x[7]); return w; }

DI void phase_post(const Frame& F, int l) {
    const bf16* PJ = (const bf16*)(F.ws + WS_PJ);
    bf16* QA = (bf16*)(F.ws + WS_QA); bf16* KA = (bf16*)(F.ws + WS_KA); bf16* VA = (bf16*)(F.ws + WS_VA);
    bf16* QC = (bf16*)(F.ws + WS_QC); bf16* KC = (bf16*)(F.ws + WS_KC); bf16* VC = (bf16*)(F.ws + WS_VC);
    bf16* Y = (bf16*)(F.ws + WS_Y);
    const float* tabA = (const float*)(F.ws + WS_TAB); const float* tabC = (const float*)(F.ws + WS_TABC);
    constexpr int DSTR = 264, VSTR = 136;
    LAS bf16* DIFF = (LAS bf16*)F.lds;
    LAS bf16* VCT = (LAS bf16*)(F.lds + 128 * DSTR * 2);
    const int lane = F.lane, w = F.wave;
    for (int u = F.bid; u < 260; u += F.G) {
        const bool is_ctx = u >= 256;
        int b, p0, row0, n;
        if (!is_ctx) { b = u / 128; p0 = (u % 128) * 128; row0 = b * SEQ + p0; n = SEQ; }
        else { const int cc = u - 256; b = cc / 2; p0 = (cc % 2) * 128; row0 = NLAT + b * CTXL + p0; n = CTXL; }
        const int seq0 = row0 - p0;
        for (int tt = 0; tt < 16; ++tt) {
            const int tl = 16 * w + tt, p = p0 + tl, row = row0 + tl;
            const int qpos = is_ctx ? SEQ + p : p, kpos = is_ctx ? p : CTXL + p;
            const int prow = p >> 6, pcol = p & 63;
            const bf16* pr = PJ + (size_t)row * PW;
            float x[8];
            {
                unpack8(*(const u32x4*)(pr + 8 * lane), x);
                float ss = 0.f;
#pragma unroll
                for (int e = 0; e < 8; ++e) ss += x[e] * x[e];
                ss += __shfl_xor(ss, 1); ss += __shfl_xor(ss, 2); ss += __shfl_xor(ss, 4);
                const int j8 = lane & 7;
                if (lane < 48) { const float rstd = rsqrtf(ss * (1.0f / 64.0f) + RMS_EPS); const float* g = (lane < 32 ? F.in[I_AQG] : F.in[I_AKG]) + l * 64 + 8 * j8;
#pragma unroll
                    for (int e = 0; e < 8; ++e) x[e] = x[e] * rstd * g[e]; }
                if (!is_ctx) { float xr[8];
#pragma unroll
                    for (int e = 0; e < 8; ++e) xr[e] = x[e];
                    rope8(xr, 2, (j8 & 2) != 0, tabA + ((size_t)((j8 & 4) ? pcol : prow) * 16 + 8 * (j8 & 1)) * 2);
                    if (lane < 48) {
#pragma unroll
                        for (int e = 0; e < 8; ++e) x[e] = xr[e]; } }
                if (lane < 32) {
#pragma unroll
                    for (int e = 0; e < 8; ++e) x[e] *= QA_SCALE; }
                bf16* dst;
                if (lane < 32) dst = QA + ((size_t)(b * 4 + (lane >> 3)) * QROWS + qpos) * 64 + 8 * j8;
                else if (lane < 48) dst = KA + ((size_t)(b * 2 + ((lane - 32) >> 3)) * KEYS + kpos) * 64 + 8 * j8;
                else dst = VA + ((size_t)(b * 2 + ((lane - 48) >> 3)) * KEYS + kpos) * 64 + 8 * j8;
                *(u32x4*)dst = pack8(x);
            }
            {
                const u32x4 own = *(const u32x4*)(pr + 512 + 8 * lane);
                unpack8(own, x);
                const int g = (lane >> 3) & 3, half = 1 << g;
                float acc[8];
#pragma unroll
                for (int e = 0; e < 8; ++e) acc[e] = 0.f;
                const int lo = max(p - half, 0), hi = min(p + half, n);
                for (int o = -8; o < 8; ++o) { const int q = p + o;
                    if (lane < 32 && q >= lo && q < hi) { float y[8]; unpack8(*(const u32x4*)(PJ + (size_t)(seq0 + q) * PW + 512 + 8 * lane), y);
#pragma unroll
                        for (int e = 0; e < 8; ++e) acc[e] += y[e]; } }
                if (lane < 32) { const float inv = 1.0f / (float)(hi - lo); float d[8];
#pragma unroll
                    for (int e = 0; e < 8; ++e) d[e] = acc[e] * inv - x[e];
                    *(LAS u32x4*)(DIFF + tl * DSTR + 8 * lane) = pack8(d); }
                const int j4 = lane & 3;
                if (!is_ctx) rope8(x, 1, (j4 & 1) != 0, tabC + ((size_t)((j4 & 2) ? pcol : prow) * 8) * 2);
                if (lane >= 32) {
#pragma unroll
                    for (int e = 0; e < 8; ++e) x[e] *= QC_SCALE;
                    const int hh = (lane - 32) >> 3, comp = ((lane - 32) >> 2) & 1;
                    *(u32x4*)(QC + ((size_t)((b * 4 + hh) * 2 + comp) * QROWS + qpos) * 32 + 8 * j4) = pack8(x); }
            }
            {
                const u32x4 own = *(const u32x4*)(pr + 1024 + 8 * lane);
                unpack8(own, x);
                const int j4 = lane & 3;
                if (!is_ctx) { float xr[8];
#pragma unroll
                    for (int e = 0; e < 8; ++e) xr[e] = x[e];
                    rope8(xr, 1, (j4 & 1) != 0, tabC + ((size_t)((j4 & 2) ? pcol : prow) * 8) * 2);
                    if (lane < 32) {
#pragma unroll
                        for (int e = 0; e < 8; ++e) x[e] = xr[e]; } }
                if (lane < 32) { const int hh = lane >> 3, comp = (lane >> 2) & 1;
                    *(u32x4*)(KC + ((size_t)((b * 4 + hh) * 2 + comp) * KEYS + kpos) * 32 + 8 * j4) = pack8(x); }
                else { const int hh = (lane - 32) >> 3;
                    *(u32x4*)(VC + ((size_t)(b * 4 + hh) * KEYS + kpos) * 64 + 8 * (lane & 7)) = own; }
            }
            {
                unpack8(*(const u32x4*)(pr + 1536 + 8 * lane), x);
                float s = 0.f;
#pragma unroll
                for (int e = 0; e < 8; ++e) s += x[e];
                s += __shfl_xor(s, 1); s += __shfl_xor(s, 2); s += __shfl_xor(s, 4); s += __shfl_xor(s, 8); s += __shfl_xor(s, 16);
                const float mu = s * (1.0f / 256.0f); float q = 0.f;
#pragma unroll
                for (int e = 0; e < 8; ++e) { x[e] -= mu; q += x[e] * x[e]; }
                q += __shfl_xor(q, 1); q += __shfl_xor(q, 2); q += __shfl_xor(q, 4); q += __shfl_xor(q, 8); q += __shfl_xor(q, 16);
                const float rstd = rsqrtf(q * (1.0f / 256.0f) + LN_EPS);
                if (lane >= 32) {
#pragma unroll
                    for (int e = 0; e < 8; ++e) VCT[(8 * (lane - 32) + e) * VSTR + tl] = (bf16)f2bf(x[e] * rstd); }
            }
        }
        LDS_WAIT(); __syncthreads();
        {
            const bf16* PWt = (const bf16*)(F.ws + WS_POOLW) + (size_t)l * 4 * 4096;
            const int fr = lane & 15, fq = lane >> 4;
#pragma unroll 1
            for (int g = 0; g < 4; ++g) {
                bf16x8 a[2];
#pragma unroll
                for (int ks = 0; ks < 2; ++ks) a[ks] = *(const LAS bf16x8*)(DIFF + (16 * w + fr) * DSTR + 64 * g + 32 * ks + 8 * fq);
#pragma unroll
                for (int nb = 0; nb < 4; ++nb) {
                    f32x4 acc = {0.f, 0.f, 0.f, 0.f};
#pragma unroll
                    for (int ks = 0; ks < 2; ++ks) { const bf16x8 bb = *(const bf16x8*)(PWt + (size_t)g * 4096 + (16 * nb + fr) * 64 + 32 * ks + 8 * fq);
                        acc = __builtin_amdgcn_mfma_f32_16x16x32_bf16(a[ks], bb, acc, 0, 0, 0); }
                    const int ch = 64 * g + 16 * nb + fr; const float sc = F.in[I_POOLS][l * 256 + ch];
#pragma unroll
                    for (int r = 0; r < 4; ++r) Y[(size_t)(row0 + 16 * w + 4 * fq + r) * D + 256 + ch] = (bf16)f2bf(acc[r] * sc);
                }
            }
        }
        {
            const bf16* SW = (const bf16*)(F.ws + WS_SGUW) + (size_t)l * 4 * 16384;
            const int fr = lane & 15, fq = lane >> 4;
#pragma unroll 1
            for (int h = 0; h < 4; ++h) {
                bf16x8 a[4];
#pragma unroll
                for (int ks = 0; ks < 4; ++ks) a[ks] = *(const bf16x8*)(SW + (size_t)h * 16384 + (16 * w + fr) * 128 + 32 * ks + 8 * fq);
#pragma unroll
                for (int nb = 0; nb < 4; ++nb) {
                    f32x4 acc = {0.f, 0.f, 0.f, 0.f};
                    const int ch = 64 * h + 16 * nb + fr;
#pragma unroll
                    for (int ks = 0; ks < 4; ++ks) { const bf16x8 bb = *(const LAS bf16x8*)(VCT + ch * VSTR + 32 * ks + 8 * fq);
                        acc = __builtin_amdgcn_mfma_f32_16x16x32_bf16(a[ks], bb, acc, 0, 0, 0); }
#pragma unroll
                    for (int r = 0; r < 4; ++r) { const int pp = 16 * w + 4 * fq + r; const float sv = acc[r] + F.in[I_SGUB][(l * 4 + h) * 128 + pp];
                        const float uu = bf2f(PJ[(size_t)(row0 + pp) * PW + 1536 + ch]);
                        Y[(size_t)(row0 + pp) * D + 768 + ch] = (bf16)f2bf(uu * sv); }
                }
            }
        }
        __syncthreads();
    }
}

template <int QD>
DI void attn_naive_pass(const Frame& F, const bf16* Qrow, const bf16* Kb, const bf16* Vb, int nkeys, float (&o)[64]) {
    LAS float* Ks = (LAS float*)F.lds;
    LAS float* Vs = (LAS float*)(F.lds + 2 * 64 * QD * 4);
    LAS float* MG = (LAS float*)(F.lds + 65536);
    const int r = F.tid & 255, half = F.tid >> 8;
    float q[QD];
#pragma unroll
    for (int i = 0; i < QD / 8; ++i) { float x[8]; unpack8(*(const u32x4*)(Qrow + 8 * i), x);
#pragma unroll
        for (int e = 0; e < 8; ++e) q[8 * i + e] = x[e]; }
#pragma unroll
    for (int d = 0; d < 64; ++d) o[d] = 0.f;
    float m = -1e30f, lsum = 0.f;
    const int kh = nkeys / 2, kbeg = half * kh, ntile = kh / 64;
    for (int t = 0; t < ntile; ++t) {
        __syncthreads();
        const int key0 = kbeg + t * 64;
        for (int pc = r; pc < 64 * QD / 8; pc += 256) { const int kk = pc / (QD / 8), c = pc % (QD / 8); float x[8]; unpack8(*(const u32x4*)(Kb + (size_t)(key0 + kk) * QD + 8 * c), x);
#pragma unroll
            for (int e = 0; e < 8; ++e) Ks[(half * 64 + kk) * QD + 8 * c + e] = x[e]; }
        for (int pc = r; pc < 512; pc += 256) { const int kk = pc / 8, c = pc % 8; float x[8]; unpack8(*(const u32x4*)(Vb + (size_t)(key0 + kk) * 64 + 8 * c), x);
#pragma unroll
            for (int e = 0; e < 8; ++e) Vs[(half * 64 + kk) * 64 + 8 * c + e] = x[e]; }
        __syncthreads();
#pragma unroll 2
        for (int j = 0; j < 64; ++j) {
            const LAS float* kr = Ks + (half * 64 + j) * QD; float s = 0.f;
#pragma unroll
            for (int d = 0; d < QD; ++d) s += q[d] * kr[d];
            if (s > m) { const float a = exp2f(m - s); lsum *= a;
#pragma unroll
                for (int d = 0; d < 64; ++d) o[d] *= a;
                m = s; }
            const float pp = exp2f(s - m); lsum += pp;
            const LAS float* vr = Vs + (half * 64 + j) * 64;
#pragma unroll
            for (int d = 0; d < 64; ++d) o[d] += pp * vr[d];
        }
    }
    __syncthreads();
    if (half == 1) { MG[r * 66] = m; MG[r * 66 + 1] = lsum;
#pragma unroll
        for (int d = 0; d < 64; ++d) MG[r * 66 + 2 + d] = o[d]; }
    __syncthreads();
    if (half == 0) { const float m1 = MG[r * 66], l1 = MG[r * 66 + 1]; const float mm = fmaxf(m, m1); const float a0 = exp2f(m - mm), a1 = exp2f(m1 - mm);
        const float inv = 1.0f / (lsum * a0 + l1 * a1);
#pragma unroll
        for (int d = 0; d < 64; ++d) o[d] = (o[d] * a0 + MG[r * 66 + 2 + d] * a1) * inv; }
    __syncthreads();
}
DI void phase_attn_naive(const Frame& F, int l) {
    const bf16* QA = (const bf16*)(F.ws + WS_QA); const bf16* KA = (const bf16*)(F.ws + WS_KA); const bf16* VA = (const bf16*)(F.ws + WS_VA);
    const bf16* QC = (const bf16*)(F.ws + WS_QC); const bf16* KC = (const bf16*)(F.ws + WS_KC); const bf16* VC = (const bf16*)(F.ws + WS_VC);
    bf16* Y = (bf16*)(F.ws + WS_Y);
    const float lam = ((const float*)(F.ws + WS_SCAL))[2 * l], lam_init = ((const float*)(F.ws + WS_SCAL))[2 * l + 1];
    const int r = F.tid & 255, half = F.tid >> 8;
    const int nqt = (l == 0) ? 65 : 64;
    const int nunits = 2 * NB * 4 * nqt;
    for (int u = F.bid; u < nunits; u += F.G) {
        const int kind = u / (NB * 4 * nqt), v = u % (NB * 4 * nqt), qt = v % nqt, bh = v / nqt, b = bh / 4, h = bh % 4;
        const int nkeys = (qt == 64) ? CTXL : KEYS;
        const int qpos = qt * 256 + r;
        const int orow = (qt == 64) ? NLAT + b * CTXL + r : b * SEQ + qt * 256 + r;
        float o[64];
        if (kind == 0) {
            attn_naive_pass<64>(F, QA + ((size_t)(b * 4 + h) * QROWS + qpos) * 64, KA + (size_t)(b * 2 + h / 2) * KEYS * 64, VA + (size_t)(b * 2 + h / 2) * KEYS * 64, nkeys, o);
            if (half == 0) {
#pragma unroll
                for (int i = 0; i < 8; ++i) { float x[8];
#pragma unroll
                    for (int e = 0; e < 8; ++e) x[e] = o[8 * i + e];
                    *(u32x4*)(Y + (size_t)orow * D + h * 64 + 8 * i) = pack8(x); } }
        } else {
            float o0[64];
            attn_naive_pass<32>(F, QC + ((size_t)((b * 4 + h) * 2 + 0) * QROWS + qpos) * 32, KC + (size_t)((b * 4 + h) * 2 + 0) * KEYS * 32, VC + (size_t)(b * 4 + h) * KEYS * 64, nkeys, o0);
            attn_naive_pass<32>(F, QC + ((size_t)((b * 4 + h) * 2 + 1) * QROWS + qpos) * 32, KC + (size_t)((b * 4 + h) * 2 + 1) * KEYS * 32, VC + (size_t)(b * 4 + h) * KEYS * 64, nkeys, o);
            if (half == 0) { float ss = 0.f;
#pragma unroll
                for (int d = 0; d < 64; ++d) { o[d] = o0[d] - lam * o[d]; ss += o[d] * o[d]; }
                const float rstd = rsqrtf(ss * (1.0f / 64.0f) + RMS_EPS) * (1.0f - lam_init);
#pragma unroll
                for (int i = 0; i < 8; ++i) { float x[8];
#pragma unroll
                    for (int e = 0; e < 8; ++e) x[e] = o[8 * i + e] * rstd * F.in[I_CSUBLN][l * 64 + 8 * i + e];
                    *(u32x4*)(Y + (size_t)orow * D + 512 + h * 64 + 8 * i) = pack8(x); } }
        }
    }
}

DI void phase_route(const Frame& F, int l, int ntok) {
    constexpr int TSTR = 1032;
    LAS float* TK = (LAS float*)F.lds;
    LAS float* LG = (LAS float*)(F.lds + 32 * TSTR * 4);
    const int lane = F.lane, w = F.wave;
    const bf16* Z = (const bf16*)(F.ws + WS_Z); bf16* T = (bf16*)(F.ws + WS_ACT);
    float* XC = (float*)(F.ws + WS_XC); float* RINFO = (float*)(F.ws + WS_RINFO); int* LISTS = (int*)(F.ws + WS_LISTS);
    unsigned* CNT = (unsigned*)(F.ws + WS_CTL) + CW_CNT;
    const int chunk = ntok / NCHUNK;
    const float* RW = F.in[I_ROUTERW] + (size_t)l * D * NEXP;
    for (int grp = F.bid; grp < ntok / 32; grp += F.G) {
        for (int tt = 0; tt < 4; ++tt) {
            const int ti = 4 * w + tt, row = grp * 32 + ti, r = mod_row(row);
            const float* src = row < NLAT ? (l == 0 ? F.in[I_X] : F.out) + (size_t)row * D : (l == 0 ? F.in[I_CTX] : XC) + (size_t)(row - NLAT) * D;
            float* dst = row < NLAT ? F.out + (size_t)row * D : XC + (size_t)(row - NLAT) * D;
            f32x4 z[4], x[4]; load_row_bf16(Z + (size_t)row * D, lane, z); load_row_f32(src, lane, x);
            const float rz = rsqrtf(row_sumsq(z) * (1.0f / D) + RMS_EPS);
            const float* gate = modp(F, l, r, 2); const float* gp = F.in[I_GPOSTMIX] + l * D;
#pragma unroll
            for (int j = 0; j < 4; ++j) { const int c = 4 * lane + 256 * j; x[j] = x[j] + *(const f32x4*)(gate + c) * (z[j] * rz * *(const f32x4*)(gp + c)); }
            store_row_f32(dst, lane, x);
            const float rx = rsqrtf(row_sumsq(x) * (1.0f / D) + RMS_EPS);
            norm_mod(x, rx, F.in[I_GPREFFN] + l * D, modp(F, l, r, 3), modp(F, l, r, 4), lane);
            store_row_bf16(T + (size_t)row * D, lane, x);
#pragma unroll
            for (int j = 0; j < 4; ++j) *(LAS f32x4*)(TK + ti * TSTR + 4 * lane + 256 * j) = x[j];
        }
        LDS_WAIT(); __syncthreads();
        {
            const int tb = w & 1, eb = w >> 1, fr = lane & 15, fq = lane >> 4;
            f32x4 acc = {0.f, 0.f, 0.f, 0.f};
            const LAS float* ap = TK + (16 * tb + fr) * TSTR + fq; const float* bp = RW + (size_t)fq * NEXP + 16 * eb + fr;
#pragma unroll 8
            for (int k0 = 0; k0 < D; k0 += 4) acc = __builtin_amdgcn_mfma_f32_16x16x4f32(ap[k0], bp[(size_t)k0 * NEXP], acc, 0, 0, 0);
#pragma unroll
            for (int rr = 0; rr < 4; ++rr) LG[(16 * tb + 4 * fq + rr) * 64 + 16 * eb + fr] = acc[rr];
        }
        LDS_WAIT(); __syncthreads();
        for (int tt = 0; tt < 4; ++tt) {
            const int ti = 4 * w + tt, row = grp * 32 + ti;
            const float logit = LG[ti * 64 + lane];
            const float score = 1.0f / (1.0f + __expf(-logit));
            const float sel = score + F.in[I_ROUTERB][l * NEXP + lane];
            float m1 = sel; m1 = fmaxf(m1, __shfl_xor(m1, 1)); m1 = fmaxf(m1, __shfl_xor(m1, 2)); m1 = fmaxf(m1, __shfl_xor(m1, 4));
            int i1 = (sel == m1) ? (lane & 7) : 8; i1 = min(i1, __shfl_xor(i1, 1)); i1 = min(i1, __shfl_xor(i1, 2)); i1 = min(i1, __shfl_xor(i1, 4));
            float s2 = ((lane & 7) == i1) ? -INFINITY : sel; s2 = fmaxf(s2, __shfl_xor(s2, 1)); s2 = fmaxf(s2, __shfl_xor(s2, 2)); s2 = fmaxf(s2, __shfl_xor(s2, 4));
            const float gs = m1 + s2; const int g = lane >> 3;
            int grank = 0;
#pragma unroll
            for (int g2 = 0; g2 < 8; ++g2) { const float o = __shfl(gs, 8 * g2); grank += (o > gs || (o == gs && g2 < g)) ? 1 : 0; }
            const float msel = (grank < 4) ? sel : -INFINITY;
            int rank = 0;
            for (int l2 = 0; l2 < 64; ++l2) { const float o = __shfl(msel, l2); rank += (o > msel || (o == msel && l2 < lane)) ? 1 : 0; }
            const bool chosen = (rank < TOPK) && (grank < 4);
            const float wsum = wave_sum(chosen ? score : 0.f);
            if (chosen) {
                const int c = row / chunk;
                const unsigned slot = atomicAdd(CNT + 16 * ((l * NCHUNK + c) * NEXP + lane), 1u);
                if (slot < (unsigned)LCAP) LISTS[(size_t)(c * NEXP + lane) * LCAP + slot] = row * 8 + rank;
                RINFO[(size_t)row * 8 + rank] = score / wsum * 2.5f;
            }
        }
        __syncthreads();
    }
}

struct MoeSched {
    const LAS int* pre; const LAS int* cnt; const LAS int* hsb;
    int ng, nct, G, c, K; int g0;
    const char* A; const char* Wr; const char* Wsh; size_t wstride; const int* lists;
    bool gatherA; int shared_grp;
    DI bool next(int i, pg8::Unit& u) const {
        const long L = (long)i * G + c; const int total = __builtin_amdgcn_readfirstlane(pre[ng]) * nct; if (L >= total) return false;
        const int tile = (int)(L / nct), ct = (int)(L % nct);
        int lo = 0, hi = ng;
        while (hi - lo > 1) { const int mid = (lo + hi) >> 1; if (__builtin_amdgcn_readfirstlane(pre[mid]) <= tile) lo = mid; else hi = mid; }
        const int g = lo, rt = tile - __builtin_amdgcn_readfirstlane(pre[g]);
        const int cg = __builtin_amdgcn_readfirstlane(cnt[g]), hb = __builtin_amdgcn_readfirstlane(hsb[g]);
        const bool sh = (g == shared_grp);
        u.pn = ct; u.nvalid = min(cg - rt * 256, 256); u.aux = g;
        u.rows = sh ? nullptr : lists + (size_t)(g0 + g) * LCAP + rt * 256;
        const char* Wb = sh ? Wsh : Wr + (size_t)((g0 + g) % NEXP) * wstride;
        u.B = Wb + (size_t)ct * 256 * K * 2;
        if (gatherA) { u.A = sh ? A + (size_t)rt * 256 * K * 2 : A; u.orow0 = hb + rt * 256; }
        else { u.A = A + (size_t)(hb + rt * 256) * K * 2; u.orow0 = rt * 256; }
        return true;
    }
};
DI void moe_tables(const Frame& F, int l, int ntok, int gbeg, int n, bool with_shared, LAS int* pre, LAS int* cnt, LAS int* hsb, LAS int* tmp) {
    const unsigned* CNT = (const unsigned*)(F.ws + WS_CTL) + CW_CNT;
    __syncthreads();
    if (F.tid < NCHUNK * NEXP) tmp[F.tid] = (int)min(__hip_atomic_load(CNT + 16 * (l * NCHUNK * NEXP + F.tid), __ATOMIC_RELAXED, __HIP_MEMORY_SCOPE_AGENT), (unsigned)LCAP);
    __syncthreads();
    if (F.tid == 0) {
        int hs = 0, p = 0;
        for (int g = 0; g < NCHUNK * NEXP; ++g) {
            const int c = tmp[g];
            const int tiles = (c + 255) >> 8;
            if (g >= gbeg && g < gbeg + n) { pre[g - gbeg] = p; cnt[g - gbeg] = c; hsb[g - gbeg] = hs; p += tiles; }
            hs += tiles * 256;
        }
        if (with_shared) { pre[n] = p; cnt[n] = ntok; hsb[n] = HS_SH_BASE; p += ntok / 256; pre[n + 1] = p; }
        else pre[n] = p;
    }
    __syncthreads();
}

DI void phase_combine(const Frame& F, int l, int ntok, int c) {
    const int gw = F.bid * NWAVES + F.wave, NGW = F.G * NWAVES, lane = F.lane;
    const int chunk = ntok / NCHUNK;
    const bf16* OUT2 = (const bf16*)(F.ws + WS_OUT2); const bf16* F0 = (const bf16*)(F.ws + WS_F0); const float* RINFO = (const float*)(F.ws + WS_RINFO);
    float* XC = (float*)(F.ws + WS_XC); bf16* ACT = (bf16*)(F.ws + WS_ACT);
    for (int i = gw; i < chunk; i += NGW) {
        const int row = c * chunk + i, r = mod_row(row);
        f32x4 f[4]; load_row_bf16(F0 + (size_t)row * D, lane, f);
#pragma unroll
        for (int k = 0; k < TOPK; ++k) { const float wk = RINFO[(size_t)row * 8 + k]; f32x4 o[4]; load_row_bf16(OUT2 + ((size_t)i * 8 + k) * D, lane, o);
#pragma unroll
            for (int j = 0; j < 4; ++j) f[j] += wk * o[j]; }
        const float rf = rsqrtf(row_sumsq(f) * (1.0f / D) + RMS_EPS);
        float* xp = row < NLAT ? F.out + (size_t)row * D : XC + (size_t)(row - NLAT) * D;
        f32x4 x[4]; load_row_f32(xp, lane, x);
        const float* gate = modp(F, l, r, 5); const float* gp = F.in[I_GPOSTFFN] + l * D;
#pragma unroll
        for (int j = 0; j < 4; ++j) { const int cc = 4 * lane + 256 * j; x[j] = x[j] + *(const f32x4*)(gate + cc) * (f[j] * rf * *(const f32x4*)(gp + cc)); }
        store_row_f32(xp, lane, x);
        if (l == 0) {
            const float rx = rsqrtf(row_sumsq(x) * (1.0f / D) + RMS_EPS);
            norm_mod(x, rx, F.in[I_GPREMIX] + D, modp(F, 1, r, 0), modp(F, 1, r, 1), lane);
            store_row_bf16(ACT + (size_t)row * D, lane, x);
        }
    }
}

constexpr int PH_PRO_A = 0, PH_PRO_B = 1, PH_L0 = 2, PH_PER_LAYER = 14, N_PHASES = PH_L0 + 2 * PH_PER_LAYER;
__global__ void __launch_bounds__(NTHREADS, 2) fwd(Args args) {
    extern __shared__ __attribute__((aligned(16))) unsigned char lds_raw[];
    Frame F;
    F.lds = (LAS unsigned char*)lds_raw;
    F.tid = threadIdx.x; F.lane = F.tid & 63; F.wave = __builtin_amdgcn_readfirstlane(F.tid >> 6);
    F.G = gridDim.x; F.bid = blockIdx.x; F.in = args.in; F.out = args.out; F.ws = args.ws;
    volatile LAS unsigned* MISC = (volatile LAS unsigned*)(F.lds + MISC_OFF);
    for (int u = F.tid; u < (LDS_BYTES - LDSCTL_OFF) / 4; u += NTHREADS) ((LAS unsigned*)(F.lds + LDSCTL_OFF))[u] = 0u;
    __syncthreads();
    const int lo = args.ph_lo, hi = args.ph_hi;
    XcdBarrier bar; bar.bar = (unsigned*)(F.ws + WS_CTL) + CW_BAR; bar.x = 0; bar.st = nullptr;
    if (hi - lo > 1) bar = xcd_barrier_post((unsigned*)(F.ws + WS_CTL) + CW_BAR, MISC + 8);
#ifndef EN_MASK
#define EN_MASK 0x3ff
#endif
#define EN(b) (((EN_MASK) >> (b)) & 1)
#define IN(k) (lo <= (k) && (k) < hi)
#define SEAM(k) do { if (IN(k) && IN((k) + 1)) xcd_barrier(bar); } while (0)
    LAS int* TPRE = (LAS int*)(F.lds + TBL_OFF); LAS int* TCNT = TPRE + 272; LAS int* THSB = TCNT + 272; LAS int* TTMP = THSB + 272;

    if (EN(0) && IN(PH_PRO_A)) { const Frame P_ = fresh(F); phase_pro_a(P_); } SEAM(PH_PRO_A);
    if (EN(1) && IN(PH_PRO_B)) { const Frame P_ = fresh(F); phase_pro_b(P_); } SEAM(PH_PRO_B);
#pragma unroll 1
    for (int l = 0; l < 2; ++l) {
        const int P = PH_L0 + l * PH_PER_LAYER;
        const int ntok = (l == 0) ? NTOK : NLAT;
        if (EN(2) && IN(P + 0)) {
            const Frame Q = fresh(F);
            pg8::DenseOrder S; S.init((const bf16*)(Q.ws + WS_ACT), (const bf16*)(Q.ws + WS_WIN) + (size_t)l * PW * D, NTOK, PW, D, Q.G, Q.bid);
            pg8::EpiBf16 E{(bf16*)(Q.ws + WS_PJ), PW};
            pg8::gemm_phase<pg8::EpiBf16, pg8::DenseOrder, false>(Q.lds, Q.tid, D, S, E);
        } SEAM(P + 0);
        if (EN(3) && IN(P + 1)) { const Frame P_ = fresh(F); phase_post(P_, l); } SEAM(P + 1);
        if (EN(4) && IN(P + 2)) { const Frame P_ = fresh(F); phase_attn_naive(P_, l); } SEAM(P + 2);
        if (EN(5) && IN(P + 3)) {
            const Frame Q = fresh(F);
            pg8::DenseOrder S; S.init((const bf16*)(Q.ws + WS_Y), (const bf16*)(Q.ws + WS_WOUT) + (size_t)l * D * D, ntok, D, D, Q.G, Q.bid);
            pg8::EpiBf16 E{(bf16*)(Q.ws + WS_Z), D};
            pg8::gemm_phase<pg8::EpiBf16, pg8::DenseOrder, false>(Q.lds, Q.tid, D, S, E);
        } SEAM(P + 3);
        if (EN(6) && IN(P + 4)) { const Frame P_ = fresh(F); phase_route(P_, l, ntok); } SEAM(P + 4);
        if (EN(7) && IN(P + 5)) {
            const Frame Q = fresh(F);
            moe_tables(Q, l, ntok, 0, NCHUNK * NEXP, true, TPRE, TCNT, THSB, TTMP);
            MoeSched S; S.pre = TPRE; S.cnt = TCNT; S.hsb = THSB; S.ng = NCHUNK * NEXP + 1; S.nct = 2; S.G = Q.G; S.c = Q.bid; S.K = D; S.g0 = 0;
            S.A = (const char*)(Q.ws + WS_ACT); S.Wr = (const char*)(Q.ws + WS_WE13); S.Wsh = (const char*)(Q.ws + WS_WSH13) + (size_t)l * 512 * D * 2; S.wstride = (size_t)512 * D * 2;
            S.lists = (const int*)(Q.ws + WS_LISTS); S.gatherA = true; S.shared_grp = NCHUNK * NEXP;
            pg8::EpiSwiglu E{(bf16*)(Q.ws + WS_HS)};
            pg8::gemm_phase<pg8::EpiSwiglu, MoeSched, true>(Q.lds, Q.tid, D, S, E);
        } SEAM(P + 5);
#pragma unroll 1
        for (int c = 0; c < NCHUNK; ++c) {
            if (EN(8) && IN(P + 6 + 2 * c)) {
                const Frame Q = fresh(F);
                moe_tables(Q, l, ntok, c * NEXP, NEXP, c == 0, TPRE, TCNT, THSB, TTMP);
                MoeSched S; S.pre = TPRE; S.cnt = TCNT; S.hsb = THSB; S.ng = NEXP + (c == 0 ? 1 : 0); S.nct = 4; S.G = Q.G; S.c = Q.bid; S.K = EH; S.g0 = c * NEXP;
                S.A = (const char*)(Q.ws + WS_HS); S.Wr = (const char*)(Q.ws + WS_WE2); S.Wsh = (const char*)(Q.ws + WS_WSH2) + (size_t)l * D * EH * 2; S.wstride = (size_t)D * EH * 2;
                S.lists = (const int*)(Q.ws + WS_LISTS); S.gatherA = false; S.shared_grp = (c == 0) ? NEXP : -1;
                pg8::EpiMoeOut E{(bf16*)(Q.ws + WS_OUT2), (bf16*)(Q.ws + WS_F0), c * (ntok / NCHUNK) * 8};
                pg8::gemm_phase<pg8::EpiMoeOut, MoeSched, false>(Q.lds, Q.tid, EH, S, E);
            } SEAM(P + 6 + 2 * c);
            if (EN(9) && IN(P + 7 + 2 * c)) {
                const Frame Q = fresh(F);
                phase_combine(Q, l, ntok, c);
                if (l == 0 && c == NCHUNK - 1) convert_experts(Q, 1, (LAS float*)(Q.lds + Q.wave * 16384));
            } SEAM(P + 7 + 2 * c);
        }
    }
#undef IN
#undef SEAM
}

extern "C" void kernel_launch(void* const* d_in, const int* in_sizes, int n_in, void* d_out, int out_size, void* d_ws, size_t ws_size, hipStream_t stream) {
    static int grid = 0;
    if (grid == 0) {
        if (n_in != 28 || in_sizes[0] != NLAT * D || out_size != NLAT * D || ws_size < WS_END) { fprintf(stderr, "kernel_launch: unexpected shapes or workspace (%zu < %zu)\n", ws_size, (size_t)WS_END); grid = -1; return; }
        int dev = 0, cus = 0, per_cu = 0;
        if (hipGetDevice(&dev) != hipSuccess || hipDeviceGetAttribute(&cus, hipDeviceAttributeMultiprocessorCount, dev) != hipSuccess) { grid = -1; return; }
        if (hipFuncSetAttribute((const void*)fwd, hipFuncAttributeMaxDynamicSharedMemorySize, LDS_BYTES) != hipSuccess) { fprintf(stderr, "kernel_launch: hipFuncSetAttribute failed\n"); grid = -1; return; }
        if (hipOccupancyMaxActiveBlocksPerMultiprocessor(&per_cu, (const void*)fwd, NTHREADS, LDS_BYTES) != hipSuccess || per_cu < 1) { fprintf(stderr, "kernel_launch: occupancy query says %d\n", per_cu); }
        (void)hipGetLastError();
        grid = cus;
    }
    if (grid < 0) return;
    if (hipMemsetAsync((char*)d_ws + WS_CTL, 0, CTL_ZERO_BYTES, stream) != hipSuccess) return;
    Args a{};
    for (int i = 0; i < 28; ++i) a.in[i] = (const float*)d_in[i];
    a.out = (float*)d_out; a.ws = (unsigned char*)d_ws;
#if MK_ONE_LAUNCH
    a.ph_lo = 0; a.ph_hi = N_PHASES;
    hipLaunchKernelGGL(fwd, dim3(grid), dim3(NTHREADS), LDS_BYTES, stream, a);
#else
    for (int p = 0; p < N_PHASES; ++p) { a.ph_lo = p; a.ph_hi = p + 1; hipLaunchKernelGGL(fwd, dim3(grid), dim3(NTHREADS), LDS_BYTES, stream, a); }
#endif
}
```

```cpp
#include <hip/hip_runtime.h>
#include <cstdio>
#include <cstdint>

#ifndef MK_ONE_LAUNCH
#define MK_ONE_LAUNCH 1
#endif

#define DI __device__ __forceinline__
#define LAS __attribute__((address_space(3)))
#define GAS __attribute__((address_space(1)))
typedef unsigned short bf16;
typedef short bf16x8 __attribute__((ext_vector_type(8)));
typedef float f32x4 __attribute__((ext_vector_type(4)));
typedef float f32x2 __attribute__((ext_vector_type(2)));
typedef unsigned u32x4 __attribute__((ext_vector_type(4)));
typedef unsigned u32x2 __attribute__((ext_vector_type(2)));

constexpr int D = 1024, NB = 2, SEQ = 16384, NLAT = NB * SEQ, CTXL = 256, NCTX = NB * CTXL, NTOK = NLAT + NCTX;
constexpr int PW = 2048, KEYS = CTXL + SEQ, QROWS = SEQ + CTXL;
constexpr int NEXP = 64, TOPK = 8, EH = 256, NCHUNK = 4, LCAP = NTOK / NCHUNK;
constexpr int NWAVES = 8, NTHREADS = 512;
constexpr float RMS_EPS = 1e-6f, LN_EPS = 1e-5f;
constexpr float LOG2E = 1.4426950408889634f;
constexpr float QA_SCALE = 0.125f * LOG2E;
constexpr float QC_SCALE = 0.17677669529663687f * LOG2E;

constexpr size_t MiB = 1u << 20;
constexpr size_t WS_CTL = 0, CTL_ZERO_BYTES = 1 * MiB;
constexpr size_t WS_MOD = 1 * MiB;
constexpr size_t WS_TAB = 1 * MiB + 256 * 1024;
constexpr size_t WS_TABC = WS_TAB + 32768, WS_SCAL = WS_TAB + 49152;
constexpr size_t WS_SGUW = 2 * MiB;
constexpr size_t WS_POOLW = 2 * MiB + 512 * 1024;
constexpr size_t WS_WIN = 8 * MiB;
constexpr size_t WS_WOUT = 16 * MiB;
constexpr size_t WS_WSH13 = 20 * MiB;
constexpr size_t WS_WSH2 = 22 * MiB;
constexpr size_t WS_XC = 24 * MiB;
constexpr size_t WS_RINFO = 26 * MiB;
constexpr size_t WS_LISTS = 28 * MiB;
constexpr size_t WS_WE13 = 40 * MiB;
constexpr size_t WS_WE2 = 104 * MiB;
constexpr size_t WS_ACT = 136 * MiB;
constexpr size_t WS_R = 201 * MiB;
constexpr size_t WS_PJ = WS_R;
constexpr size_t QA_BYTES = (size_t)NB * 4 * QROWS * 64 * 2, KA_BYTES = (size_t)NB * 2 * KEYS * 64 * 2;
constexpr size_t WS_QA = 331 * MiB, WS_KA = WS_QA + QA_BYTES, WS_VA = WS_KA + KA_BYTES, WS_QC = WS_VA + KA_BYTES;
constexpr size_t WS_KC = WS_QC + QA_BYTES, WS_VC = WS_KC + QA_BYTES;
constexpr size_t WS_Y = 413 * MiB, WS_Z = 478 * MiB;
static_assert(WS_VC + QA_BYTES <= WS_Y, "qkv region");
constexpr int HS_SH_BASE = NTOK * TOPK + NCHUNK * NEXP * 255;
constexpr size_t WS_HS = WS_R;
constexpr size_t WS_OUT2 = 380 * MiB;
constexpr size_t WS_F0 = 510 * MiB;
constexpr size_t WS_END = 575 * MiB;
static_assert(WS_HS + (size_t)(HS_SH_BASE + NTOK) * 512 <= WS_OUT2, "hs region");
constexpr int CW_TMO = 0, CW_BAR = 4096, CW_CNT = 16384;

constexpr int LDS_BYTES = 147456, LDS_SCRATCH = 141312, LDSCTL_OFF = LDS_SCRATCH;
constexpr int MISC_OFF = LDSCTL_OFF;
constexpr int TBL_OFF = LDSCTL_OFF + 128;

DI float bf2f(unsigned v) { return __uint_as_float(v << 16); }
DI unsigned f2bf(float f) { unsigned u = __float_as_uint(f); return (u + 0x7fffu + ((u >> 16) & 1u)) >> 16; }
DI unsigned pk2(float lo, float hi) { return f2bf(lo) | (f2bf(hi) << 16); }
DI float lo16(unsigned w) { return __uint_as_float(w << 16); }
DI float hi16(unsigned w) { return __uint_as_float(w & 0xffff0000u); }
DI float wave_sum(float v) {
#pragma unroll
    for (int o = 1; o < 64; o <<= 1) v += __shfl_xor(v, o);
    return v;
}
#define LDS_WAIT() asm volatile("s_waitcnt lgkmcnt(0)" ::: "memory")
#define VM_WAIT() asm volatile("s_waitcnt vmcnt(0)" ::: "memory")

namespace pg8 {
constexpr int BM = 256, BK = 64, HALF = 128, HTB = HALF * BK * 2, STAGE_BYTES = 8 * HTB, NXCD = 8, WGM = 8;
__host__ __device__ __forceinline__ int lds_byte(int r, int c) { const int st = (r >> 4) * 2 + (c >> 5), rr = r & 15, cc = c & 31, ob = rr * 64 + cc * 2; return st * 1024 + (ob ^ (((ob >> 9) & 1) << 5)); }
__host__ __device__ __forceinline__ void stage_rc(int b, int& R, int& C) { const int st = b / 1024, sb = b % 1024, swz = sb ^ (((sb >> 9) & 1) << 5); R = (st >> 1) * 16 + swz / 64; C = (st & 1) * 32 + (swz % 64) / 2; }
__host__ __device__ __forceinline__ int perm32(int rho) { const int n = rho >> 4, i = rho & 15; return 8 * (i >> 2) + 4 * n + (i & 3); }

struct Unit {
    const char* A;
    const char* B;
    const int* rows;
    int nvalid;
    int orow0;
    int pn;
    int aux;
};

struct DenseOrder {
    const bf16* A; const bf16* Bt; int K; int nM, nN, nwg, G, c;
    DI void init(const bf16* A_, const bf16* Bt_, int M, int N, int K_, int G_, int c_) { A = A_; Bt = Bt_; K = K_; nM = M / BM; nN = N / BM; nwg = nM * nN; G = G_; c = c_; }
    DI bool next(int i, Unit& u) const {
        const long L = (long)i * G + c; if (L >= nwg) return false;
        int wgid = (int)L; { const int q = nwg / NXCD, r = nwg % NXCD, xcd = wgid % NXCD, off = wgid / NXCD; wgid = (xcd < r ? xcd * (q + 1) : r * (q + 1) + (xcd - r) * q) + off; }
        const int nig = WGM * nN, gid = wgid / nig, fm = gid * WGM, gsz = (nM - fm) < WGM ? (nM - fm) : WGM;
        const int pm = fm + ((wgid % nig) % gsz), pn = (wgid % nig) / gsz;
        u.A = (const char*)A + (size_t)pm * BM * K * 2; u.B = (const char*)Bt + (size_t)pn * BM * K * 2; u.rows = nullptr; u.nvalid = BM; u.orow0 = pm * BM; u.pn = pn; u.aux = 0;
        return true;
    }
};

DI unsigned cvt_pk_bf16(float lo, float hi) { unsigned r; asm volatile("v_cvt_pk_bf16_f32 %0, %1, %2" : "=v"(r) : "v"(lo), "v"(hi)); return r; }

struct EpiBf16 {
    static constexpr bool PERM = true;
    bf16* O; int ldc;
    DI void operator()(const f32x4 (&acc)[2][2][4][2], const Unit& u, int wr, int wc, int fr, int fq) const {
        const int row0 = u.orow0 + wr * 64 + fr; const int col0 = u.pn * BM + wc * 32 + 8 * fq;
#pragma unroll
        for (int ai = 0; ai < 2; ++ai)
#pragma unroll
            for (int m = 0; m < 4; ++m) { bf16* rowp = O + (size_t)(row0 + ai * HALF + m * 16) * ldc + col0;
#pragma unroll
                for (int bj = 0; bj < 2; ++bj) { const f32x4 v0 = acc[ai][bj][m][0], v1 = acc[ai][bj][m][1];
                    u32x4 w; w.x = cvt_pk_bf16(v0[0], v0[1]); w.y = cvt_pk_bf16(v0[2], v0[3]); w.z = cvt_pk_bf16(v1[0], v1[1]); w.w = cvt_pk_bf16(v1[2], v1[3]);
                    *(u32x4*)(rowp + bj * HALF) = w; } }
    }
};
struct EpiSwiglu {
    static constexpr bool PERM = false;
    bf16* Hs;
    DI void operator()(const f32x4 (&acc)[2][2][4][2], const Unit& u, int wr, int wc, int fr, int fq) const {
        const int row0 = u.orow0 + wr * 64 + fr; const int f0 = u.pn * 128 + wc * 16 + 4 * fq;
#pragma unroll
        for (int ai = 0; ai < 2; ++ai)
#pragma unroll
            for (int m = 0; m < 4; ++m) { bf16* rowp = Hs + (size_t)(row0 + ai * HALF + m * 16) * EH + f0;
#pragma unroll
                for (int bj = 0; bj < 2; ++bj) { const f32x4 a = acc[ai][bj][m][0], b = acc[ai][bj][m][1]; float h[4];
#pragma unroll
                    for (int j = 0; j < 4; ++j) { const float s = a[j] * __builtin_amdgcn_rcpf(1.0f + __builtin_amdgcn_exp2f(-a[j] * LOG2E)); h[j] = s * b[j]; }
                    u32x2 w; w.x = cvt_pk_bf16(h[0], h[1]); w.y = cvt_pk_bf16(h[2], h[3]);
                    *(u32x2*)(rowp + bj * 64) = w; } }
    }
};
struct EpiMoeOut {
    static constexpr bool PERM = true;
    bf16* OUT2; bf16* F0; int ebase;
    DI void operator()(const f32x4 (&acc)[2][2][4][2], const Unit& u, int wr, int wc, int fr, int fq) const {
        const int col0 = u.pn * BM + wc * 32 + 8 * fq;
        const bool routed = u.rows != nullptr;
        bf16* base = routed ? OUT2 : F0;
        int drow[2][4];
#pragma unroll
        for (int ai = 0; ai < 2; ++ai)
#pragma unroll
            for (int m = 0; m < 4; ++m) { const int r = wr * 64 + fr + ai * HALF + m * 16;
                if (routed) drow[ai][m] = (r < u.nvalid) ? (u.rows[r] - ebase) : -1; else drow[ai][m] = u.orow0 + r; }
#pragma unroll
        for (int ai = 0; ai < 2; ++ai)
#pragma unroll
            for (int m = 0; m < 4; ++m) {
                if (drow[ai][m] >= 0) { bf16* rowp = base + (size_t)drow[ai][m] * D + col0;
#pragma unroll
                for (int bj = 0; bj < 2; ++bj) { const f32x4 v0 = acc[ai][bj][m][0], v1 = acc[ai][bj][m][1];
                    u32x4 w; w.x = cvt_pk_bf16(v0[0], v0[1]); w.y = cvt_pk_bf16(v0[2], v0[3]); w.z = cvt_pk_bf16(v1[0], v1[1]); w.w = cvt_pk_bf16(v1[2], v1[3]);
                    *(u32x4*)(rowp + bj * HALF) = w; } } }
    }
};

template <bool GATHER> DI void set_voff(const Unit& u, unsigned (&v)[2][2], const int (&Rr)[2], const int (&Cc)[2], int K) {
#pragma unroll
    for (int h = 0; h < 2; ++h)
#pragma unroll
        for (int i = 0; i < 2; ++i) {
            if (GATHER && u.rows) { const int r = h * HALF + Rr[i]; const int e = (r < u.nvalid) ? u.rows[r] : 0; v[h][i] = (unsigned)((e >> 3) * K + Cc[i]) * 2u; }
            else v[h][i] = (unsigned)((h * HALF + Rr[i]) * K + Cc[i]) * 2u;
        }
}

template <class Epi, class Sched, bool GATHER>
DI void gemm_phase(LAS unsigned char* lds, const int tid, const int K, const Sched& S, const Epi& E) {
    const int wid = __builtin_amdgcn_readfirstlane(tid >> 6), lane = tid & 63, wr = wid >> 2, wc = wid & 3, fr = lane & 15, fq = lane >> 4;
    const int nt = K / BK;
    int Rr[2], Cc[2]; unsigned voffB[2];
#pragma unroll
    for (int i = 0; i < 2; ++i) { int R, C; stage_rc(tid * 16 + i * 8192, R, C); const int Rb = Epi::PERM ? ((R & ~31) + perm32(R & 31)) : R; Rr[i] = R; Cc[i] = C; voffB[i] = (unsigned)(Rb * K + C) * 2u; }
    const size_t kstep = (size_t)(BK * 2);
    const size_t hstep = (size_t)HALF * K * 2;
    const unsigned ldsw = (unsigned)wid * 1024u;
    const int aoff = lds_byte(wr * 64 + fr, fq * 8), boff = lds_byte(wc * 32 + fr, fq * 8);
#define PG8_SA(b, h) (((b) * 2 + (h)) * HTB)
#define PG8_SB(b, h) ((4 + (b) * 2 + (h)) * HTB)
#define PG8_STAGE(bufoff, gbase, voff) do { _Pragma("unroll") for (int _i = 0; _i < 2; ++_i) \
        __builtin_amdgcn_global_load_lds((const unsigned*)((const char*)(gbase) + (voff)[_i]), (LAS unsigned*)(lds + (bufoff) + ldsw + _i * 8192), 16, 0, 0); } while (0)
#define PG8_LDA(dst, b, h) do { _Pragma("unroll") for (int m = 0; m < 4; ++m) _Pragma("unroll") for (int k = 0; k < 2; ++k) dst[m][k] = *(const LAS bf16x8*)(lds + PG8_SA(b, h) + aoff + m * 2048 + k * 1024); } while (0)
#define PG8_LDB(dst, b, h) do { _Pragma("unroll") for (int n = 0; n < 2; ++n) _Pragma("unroll") for (int k = 0; k < 2; ++k) dst[n][k] = *(const LAS bf16x8*)(lds + PG8_SB(b, h) + boff + n * 2048 + k * 1024); } while (0)
#define PG8_MMA(ai, bj, At, Bt) do { __builtin_amdgcn_s_setprio(1); _Pragma("unroll") for (int m = 0; m < 4; ++m) _Pragma("unroll") for (int n = 0; n < 2; ++n) _Pragma("unroll") for (int k = 0; k < 2; ++k) \
        acc[ai][bj][m][n] = __builtin_amdgcn_mfma_f32_16x16x32_bf16(Bt[n][k], At[m][k], acc[ai][bj][m][n], 0, 0, 0); __builtin_amdgcn_s_setprio(0); } while (0)
#define PG8_WAIT_V(n) asm volatile("s_waitcnt vmcnt(" #n ")" ::: "memory")
#define PG8_WAIT_L(n) asm volatile("s_waitcnt lgkmcnt(" #n ")" ::: "memory")
#define PG8_BAR __builtin_amdgcn_s_barrier()
#define PG8_SCHED __builtin_amdgcn_sched_barrier(0)
    Unit cur, nxt; int ui = 0;
    if (!S.next(0, cur)) return;
    f32x4 acc[2][2][4][2];
#pragma unroll
    for (int a = 0; a < 2; ++a)
#pragma unroll
        for (int b = 0; b < 2; ++b)
#pragma unroll
            for (int m = 0; m < 4; ++m)
#pragma unroll
                for (int n = 0; n < 2; ++n) acc[a][b][m][n] = (f32x4){0.f, 0.f, 0.f, 0.f};
    bf16x8 At[4][2], B0[2][2], B1[2][2];
    unsigned voC[2][2], voN[2][2];
    set_voff<GATHER>(cur, voC, Rr, Cc, K);
    const char* cA = cur.A; const char* cB = cur.B;
    PG8_STAGE(PG8_SB(0, 0), cB, voffB); PG8_STAGE(PG8_SB(0, 1), cB + hstep, voffB); PG8_STAGE(PG8_SA(0, 0), cA, voC[0]); PG8_STAGE(PG8_SA(0, 1), cA, voC[1]);
    if (wr == 1) PG8_BAR;
    PG8_WAIT_V(2); PG8_BAR;
    PG8_STAGE(PG8_SB(1, 0), cB + kstep, voffB); PG8_STAGE(PG8_SA(1, 0), cA + kstep, voC[0]); PG8_STAGE(PG8_SB(1, 1), cB + hstep + kstep, voffB);
    PG8_WAIT_V(6); PG8_BAR;
    for (;;) {
        const bool has_next = S.next(ui + 1, nxt);
        const char* nA = has_next ? nxt.A : cA; const char* nB = has_next ? nxt.B : cB;
        if (GATHER && has_next) set_voff<GATHER>(nxt, voN, Rr, Cc, K);
        else {
#pragma unroll
            for (int h = 0; h < 2; ++h)
#pragma unroll
                for (int i = 0; i < 2; ++i) voN[h][i] = voC[h][i]; }
#pragma unroll 1
        for (int t = 0; t < nt; t += 2) {
            const bool last = (t == nt - 2);
            const char* a1 = cA + (size_t)(t + 1) * kstep;
            const char* a2 = last ? nA : cA + (size_t)(t + 2) * kstep; const char* b2 = last ? nB : cB + (size_t)(t + 2) * kstep;
            const char* a3 = a2 + kstep; const char* b3 = b2 + kstep;
            unsigned vo2[2][2];
#pragma unroll
            for (int h = 0; h < 2; ++h)
#pragma unroll
                for (int i = 0; i < 2; ++i) vo2[h][i] = (GATHER && last) ? voN[h][i] : voC[h][i];
            PG8_LDB(B0, 0, 0); PG8_LDB(B1, 0, 1); PG8_SCHED; PG8_LDA(At, 0, 0); PG8_STAGE(PG8_SA(1, 1), a1, voC[1]);
            PG8_WAIT_V(8); PG8_WAIT_L(0); PG8_BAR; PG8_MMA(0, 0, At, B0); PG8_MMA(0, 1, At, B1); PG8_BAR; PG8_SCHED;
            PG8_LDA(At, 0, 1); PG8_STAGE(PG8_SB(0, 0), b2, voffB); PG8_STAGE(PG8_SB(0, 1), b2 + hstep, voffB); PG8_STAGE(PG8_SA(0, 0), a2, vo2[0]);
            PG8_WAIT_V(8); PG8_WAIT_L(0); PG8_BAR; PG8_MMA(1, 0, At, B0); PG8_MMA(1, 1, At, B1); PG8_BAR; PG8_SCHED;
            PG8_LDB(B0, 1, 0); PG8_LDB(B1, 1, 1); PG8_SCHED; PG8_LDA(At, 1, 0); PG8_STAGE(PG8_SA(0, 1), a2, vo2[1]);
            PG8_WAIT_V(8); PG8_WAIT_L(0); PG8_BAR; PG8_MMA(0, 0, At, B0); PG8_MMA(0, 1, At, B1); PG8_BAR; PG8_SCHED;
            PG8_LDA(At, 1, 1); PG8_STAGE(PG8_SB(1, 0), b3, voffB); PG8_STAGE(PG8_SB(1, 1), b3 + hstep, voffB); PG8_STAGE(PG8_SA(1, 0), a3, vo2[0]);
            PG8_WAIT_V(8); PG8_WAIT_L(0); PG8_BAR; PG8_MMA(1, 0, At, B0); PG8_MMA(1, 1, At, B1); PG8_BAR; PG8_SCHED;
        }
        if (wr == 0) PG8_BAR;
        E(acc, cur, wr, wc, fr, fq);
        if (!has_next) break;
#pragma unroll
        for (int a = 0; a < 2; ++a)
#pragma unroll
            for (int b = 0; b < 2; ++b)
#pragma unroll
                for (int m = 0; m < 4; ++m)
#pragma unroll
                    for (int n = 0; n < 2; ++n) acc[a][b][m][n] = (f32x4){0.f, 0.f, 0.f, 0.f};
        cur = nxt; cA = nA; cB = nB; ++ui;
#pragma unroll
        for (int h = 0; h < 2; ++h)
#pragma unroll
            for (int i = 0; i < 2; ++i) voC[h][i] = voN[h][i];
        if (wr == 1) PG8_BAR;
    }
    PG8_WAIT_V(0);
    PG8_BAR;
#undef PG8_SA
#undef PG8_SB
#undef PG8_STAGE
#undef PG8_LDA
#undef PG8_LDB
#undef PG8_MMA
#undef PG8_WAIT_V
#undef PG8_WAIT_L
#undef PG8_BAR
#undef PG8_SCHED
}
}

#define XB_TMO      128
#define XB_XCNT(j)  (256  + 64 * (j))
#define XB_XSUB(j)  (1280 + 64 * (j))
#define XB_XGEN(j)  (2304 + 64 * (j))
#define XB_TOP      3328
#define XB_TOPGEN   3392
#define XCD_BAR_WORDS 3456
#define XB_SPIN_CAP (1u << 18)
DI unsigned xb_ld(unsigned* p)              { return __hip_atomic_load(p, __ATOMIC_RELAXED, __HIP_MEMORY_SCOPE_AGENT); }
DI unsigned xb_add(unsigned* p, unsigned v) { return __hip_atomic_fetch_add(p, v, __ATOMIC_RELAXED, __HIP_MEMORY_SCOPE_AGENT); }
DI unsigned xb_xcc_id() { return (unsigned)__builtin_amdgcn_s_getreg((3 << 11) | 20) & 0xFu; }
#define XB_SPIN(cond, bar) do { unsigned _sp = 0; while (cond) { __builtin_amdgcn_s_sleep(1); \
    if ((++_sp & 255u) == 0u) { if (xb_ld(&(bar)[XB_TMO])) break; if (_sp > XB_SPIN_CAP) { atomicAdd(&(bar)[XB_TMO], 1u); break; } } } } while (0)
struct XcdBarrier { unsigned* bar; unsigned x; volatile LAS unsigned* st; };
DI XcdBarrier xcd_barrier_post(unsigned* bar, volatile LAS unsigned* st) {
    XcdBarrier b; b.bar = bar; b.x = xb_xcc_id(); b.st = st;
    if (threadIdx.x == 0) (void)xb_add(&bar[XB_XCNT(b.x)], 1u);
    return b;
}
DI void xcd_barrier_complete(unsigned* bar, unsigned x, unsigned& nloc, unsigned& nx) {
    const unsigned G = gridDim.x * gridDim.y * gridDim.z;
    unsigned sum, cnt, mine, sp = 0u;
    for (;;) {
        sum = 0u; cnt = 0u; mine = 0u;
#pragma unroll
        for (unsigned j = 0; j < 16; ++j) { const unsigned c = xb_ld(&bar[XB_XCNT(j)]); sum += c; cnt += (c > 0u) ? 1u : 0u; mine = (j == x) ? c : mine; }
        if (sum == G) break;
        __builtin_amdgcn_s_sleep(1);
        if ((++sp & 255u) == 0u) { if (xb_ld(&bar[XB_TMO])) break; if (sp > XB_SPIN_CAP) { atomicAdd(&bar[XB_TMO], 1u); break; } }
    }
    nloc = mine > 0u ? mine : 1u; nx = cnt > 0u ? cnt : 1u;
}
DI void xcd_barrier(const XcdBarrier& b) {
    asm volatile("s_waitcnt vmcnt(0)" ::: "memory");
    __syncthreads();
    if (threadIdx.x == 0) {
        unsigned* bar = b.bar;
        __builtin_amdgcn_s_waitcnt(0);
        unsigned nloc = b.st[0], nx = b.st[1];
        if (nloc == 0u) { xcd_barrier_complete(bar, b.x, nloc, nx); b.st[0] = nloc; b.st[1] = nx; }
        const unsigned old = xb_add(&bar[XB_XSUB(b.x)], 1u);
        const unsigned gen = old / nloc;
        if (old + 1u == (gen + 1u) * nloc) {
            __builtin_amdgcn_fence(__ATOMIC_RELEASE, "agent");
            asm volatile("s_waitcnt vmcnt(0)" ::: "memory");
            const unsigned og = xb_add(&bar[XB_TOP], 1u);
            const unsigned tg = og / nx;
            if (og + 1u == (tg + 1u) * nx) xb_add(&bar[XB_TOPGEN], 1u);
            else XB_SPIN(xb_ld(&bar[XB_TOPGEN]) == tg, bar);
            __builtin_amdgcn_fence(__ATOMIC_ACQUIRE, "agent");
            xb_add(&bar[XB_XGEN(b.x)], 1u);
            asm volatile("s_waitcnt vmcnt(0)" ::: "memory");
        } else {
            XB_SPIN(xb_ld(&bar[XB_XGEN(b.x)]) == gen, bar);
            __builtin_amdgcn_fence(__ATOMIC_ACQUIRE, "agent");
            asm volatile("s_waitcnt vmcnt(0)" ::: "memory");
        }
    }
    __syncthreads();
}

struct Args { const float* in[28]; float* out; unsigned char* ws; int ph_lo, ph_hi; };
enum { I_X = 0, I_C, I_CTX, I_CCTX, I_ADAW, I_ADAB, I_GPREMIX, I_GPOSTMIX, I_GPREFFN, I_GPOSTFFN, I_WIN, I_WOUT, I_AQG, I_AKG, I_POOLW, I_POOLS, I_LAMQK, I_CSUBLN,
       I_SGUW, I_SGUB, I_ROUTERW, I_ROUTERB, I_EW1, I_EW3, I_EW2, I_SW1, I_SW3, I_SW2 };

struct Frame {
    LAS unsigned char* lds;
    int tid, lane, wave, G, bid;
    const float* const* in; float* out; unsigned char* ws;
};

DI size_t opaque0() { unsigned z; asm volatile("s_mov_b32 %0, 0" : "=s"(z)); return (size_t)z; }
#ifdef NO_LAUNDER
DI Frame fresh(const Frame& F) { return F; }
#else
DI Frame fresh(const Frame& F) { Frame G = F; const size_t z = opaque0(); G.ws = F.ws + z; G.in = F.in + z; G.out = F.out + z; G.tid = F.tid + (int)z; G.lane = G.tid & 63; G.wave = __builtin_amdgcn_readfirstlane(G.tid >> 6); G.bid = F.bid + (int)z; G.G = F.G + (int)z; G.lds = F.lds + z; return G; }
#endif
DI void load_row_f32(const float* p, int lane, f32x4 (&v)[4]) {
#pragma unroll
    for (int j = 0; j < 4; ++j) v[j] = *(const f32x4*)(p + 4 * lane + 256 * j);
}
DI void load_row_bf16(const bf16* p, int lane, f32x4 (&v)[4]) {
#pragma unroll
    for (int j = 0; j < 4; ++j) { const u32x2 w = *(const u32x2*)(p + 4 * lane + 256 * j); v[j] = (f32x4){lo16(w.x), hi16(w.x), lo16(w.y), hi16(w.y)}; }
}
DI void store_row_f32(float* p, int lane, const f32x4 (&v)[4]) {
#pragma unroll
    for (int j = 0; j < 4; ++j) *(f32x4*)(p + 4 * lane + 256 * j) = v[j];
}
DI void store_row_bf16(bf16* p, int lane, const f32x4 (&v)[4]) {
#pragma unroll
    for (int j = 0; j < 4; ++j) { u32x2 w; w.x = pk2(v[j][0], v[j][1]); w.y = pk2(v[j][2], v[j][3]); *(u32x2*)(p + 4 * lane + 256 * j) = w; }
}
DI float row_sumsq(const f32x4 (&v)[4]) {
    float s = 0.f;
#pragma unroll
    for (int j = 0; j < 4; ++j) s += (v[j][0] * v[j][0] + v[j][1] * v[j][1]) + (v[j][2] * v[j][2] + v[j][3] * v[j][3]);
    return wave_sum(s);
}
DI void norm_mod(f32x4 (&v)[4], float rstd, const float* g, const float* shift, const float* scale, int lane) {
#pragma unroll
    for (int j = 0; j < 4; ++j) { const int c = 4 * lane + 256 * j; const f32x4 gg = *(const f32x4*)(g + c), sh = *(const f32x4*)(shift + c), sc = *(const f32x4*)(scale + c);
        v[j] = (v[j] * rstd * gg) * (1.0f + sc) + sh; }
}
DI const float* modp(const Frame& F, int l, int r, int j) { return (const float*)(F.ws + WS_MOD) + ((size_t)(l * 3 + r) * 6 + j) * D; }
DI int mod_row(int row) { return row < NLAT ? row / SEQ : 2; }

template <class RowMap>
DI void transpose_item(const float* W, int K, int N, bf16* WT, const RowMap& rm, LAS float* scr, int item, int lane) {
    const int nblk = N / 32, kb = item / nblk, nb = item % nblk, k0 = 64 * kb, n0 = 32 * nb;
#pragma unroll 8
    for (int i = 0; i < 32; ++i) { const int kk = 2 * i + (lane >> 5); scr[kk * 33 + (lane & 31)] = W[(size_t)(k0 + kk) * N + n0 + (lane & 31)]; }
    LDS_WAIT(); asm volatile("" ::: "memory");
    const int c = lane & 7;
#pragma unroll
    for (int j = 0; j < 4; ++j) { const int n = (lane >> 3) + 8 * j; const LAS float* s = scr + (8 * c) * 33 + n;
        u32x4 o; o.x = pk2(s[0 * 33], s[1 * 33]); o.y = pk2(s[2 * 33], s[3 * 33]); o.z = pk2(s[4 * 33], s[5 * 33]); o.w = pk2(s[6 * 33], s[7 * 33]);
        *(u32x4*)(WT + (size_t)rm(n0 + n) * K + k0 + 8 * c) = o; }
    LDS_WAIT(); asm volatile("" ::: "memory");
}
struct RowId { int off; DI int operator()(int n) const { return off + n; } };
struct RowW13 { int which; DI int operator()(int f) const { return ((f >> 4) << 5) + (f & 15) + 16 * which; } };

DI void convert_experts(const Frame& F, int l, LAS float* scr) {
    const int gw = F.bid * NWAVES + F.wave, NGW = F.G * NWAVES;
    bf16* WE13 = (bf16*)(F.ws + WS_WE13); bf16* WE2 = (bf16*)(F.ws + WS_WE2);
    constexpr int IT = 128;
    for (int it = gw; it < NEXP * 3 * IT; it += NGW) {
        const int e = it / (3 * IT), r = it % (3 * IT), m = r / IT, item = r % IT;
        const size_t eo = ((size_t)l * NEXP + e) * (size_t)(D * EH);
        if (m == 0) transpose_item(F.in[I_EW1] + eo, D, EH, WE13 + (size_t)e * 512 * D, RowW13{0}, scr, item, F.lane);
        else if (m == 1) transpose_item(F.in[I_EW3] + eo, D, EH, WE13 + (size_t)e * 512 * D, RowW13{1}, scr, item, F.lane);
        else transpose_item(F.in[I_EW2] + eo, EH, D, WE2 + (size_t)e * D * EH, RowId{0}, scr, item, F.lane);
    }
}

DI void phase_pro_a(const Frame& F) {
    LAS float* scrw = (LAS float*)(F.lds + F.wave * 16384);
    if (F.bid < 192) {
        const int l = F.bid / 96, cg = F.bid % 96, n = cg * 64 + F.lane;
        const float* W = F.in[I_ADAW] + (size_t)l * D * 6144;
        float a0 = 0.f, a1 = 0.f, a2 = 0.f;
        const int k0 = F.wave * 128;
#pragma unroll 8
        for (int k = k0; k < k0 + 128; ++k) {
            const float w = W[(size_t)k * 6144 + n];
            const float c0 = F.in[I_C][k], c1 = F.in[I_C][D + k], c2 = F.in[I_CCTX][k];
            a0 += w * (c0 / (1.0f + __expf(-c0))); a1 += w * (c1 / (1.0f + __expf(-c1))); a2 += w * (c2 / (1.0f + __expf(-c2)));
        }
        LAS float* red = (LAS float*)(F.lds + 131072);
        red[(F.wave * 3 + 0) * 64 + F.lane] = a0; red[(F.wave * 3 + 1) * 64 + F.lane] = a1; red[(F.wave * 3 + 2) * 64 + F.lane] = a2;
        __syncthreads();
        if (F.wave < 3) { float s = F.in[I_ADAB][l * 6144 + n];
#pragma unroll
            for (int w = 0; w < 8; ++w) s += red[(w * 3 + F.wave) * 64 + F.lane];
            ((float*)(F.ws + WS_MOD))[(size_t)(l * 3 + F.wave) * 6144 + n] = s; }
        __syncthreads();
    }
    const int gw = F.bid * NWAVES + F.wave, NGW = F.G * NWAVES;
    {
        constexpr int I_IN = 16 * 64, I_OUT = 16 * 32, I_S = 128;
        constexpr int PER_L = I_IN + I_OUT + 3 * I_S;
        for (int it = gw; it < 2 * PER_L; it += NGW) {
            const int l = it / PER_L; int r = it % PER_L;
            if (r < I_IN) { transpose_item(F.in[I_WIN] + (size_t)l * D * PW, D, PW, (bf16*)(F.ws + WS_WIN) + (size_t)l * PW * D, RowId{0}, scrw, r, F.lane); continue; } r -= I_IN;
            if (r < I_OUT) { transpose_item(F.in[I_WOUT] + (size_t)l * D * D, D, D, (bf16*)(F.ws + WS_WOUT) + (size_t)l * D * D, RowId{0}, scrw, r, F.lane); continue; } r -= I_OUT;
            bf16* S13 = (bf16*)(F.ws + WS_WSH13) + (size_t)l * 512 * D; bf16* S2 = (bf16*)(F.ws + WS_WSH2) + (size_t)l * D * EH;
            if (r < I_S) { transpose_item(F.in[I_SW1] + (size_t)l * D * EH, D, EH, S13, RowW13{0}, scrw, r, F.lane); continue; } r -= I_S;
            if (r < I_S) { transpose_item(F.in[I_SW3] + (size_t)l * D * EH, D, EH, S13, RowW13{1}, scrw, r, F.lane); continue; } r -= I_S;
            transpose_item(F.in[I_SW2] + (size_t)l * EH * D, EH, D, S2, RowId{0}, scrw, r, F.lane);
        }
    }
    convert_experts(F, 0, scrw);
    const int gt = F.bid * NTHREADS + F.tid, NGT = F.G * NTHREADS;
    for (int i = gt; i < 2 * 4 * 128 * 128; i += NGT) ((bf16*)(F.ws + WS_SGUW))[i] = (bf16)f2bf(F.in[I_SGUW][i]);
    for (int i = gt; i < 2 * 4 * 64 * 64; i += NGT) { const int lg = i / 4096, n = (i / 64) % 64, k = i % 64; ((bf16*)(F.ws + WS_POOLW))[i] = (bf16)f2bf(F.in[I_POOLW][(size_t)lg * 4096 + k * 64 + n]); }
    for (int i = gt; i < 256 * 16; i += NGT) { const int p = i / 16, f = i % 16; const float inv = powf(10000.0f, -(float)f / 16.0f); const float ang = (float)p * inv;
        ((float*)(F.ws + WS_TAB))[2 * i] = cosf(ang); ((float*)(F.ws + WS_TAB))[2 * i + 1] = sinf(ang); }
    for (int i = gt; i < 256 * 8; i += NGT) { const int p = i / 8, f = i % 8; const float inv = powf(10000.0f, -(float)f / 8.0f); const float ang = (float)p * inv;
        ((float*)(F.ws + WS_TABC))[2 * i] = cosf(ang); ((float*)(F.ws + WS_TABC))[2 * i + 1] = sinf(ang); }
    if (gt < 2) { const int l = gt; const float* lq = F.in[I_LAMQK] + l * 128; float s0 = 0.f, s1 = 0.f;
        for (int i = 0; i < 32; ++i) { s0 += lq[i] * lq[32 + i]; s1 += lq[64 + i] * lq[96 + i]; }
        const float lam_init = 0.8f - 0.6f * expf(-0.3f * (float)l);
        float* sc = (float*)(F.ws + WS_SCAL); sc[2 * l] = expf(s0) - expf(s1) + lam_init; sc[2 * l + 1] = lam_init; }
}

DI void phase_pro_b(const Frame& F) {
    const int gw = F.bid * NWAVES + F.wave, NGW = F.G * NWAVES;
    bf16* ACT = (bf16*)(F.ws + WS_ACT);
    for (int row = gw; row < NTOK; row += NGW) {
        const float* src = row < NLAT ? F.in[I_X] + (size_t)row * D : F.in[I_CTX] + (size_t)(row - NLAT) * D;
        f32x4 v[4]; load_row_f32(src, F.lane, v);
        const float rstd = rsqrtf(row_sumsq(v) * (1.0f / D) + RMS_EPS);
        const int r = mod_row(row);
        norm_mod(v, rstd, F.in[I_GPREMIX], modp(F, 0, r, 0), modp(F, 0, r, 1), F.lane);
        store_row_bf16(ACT + (size_t)row * D, F.lane, v);
    }
}

DI void rope8(float (&x)[8], int px, bool second, const float* tab) {
#pragma unroll
    for (int e = 0; e < 8; ++e) { const float p = __shfl_xor(x[e], px); const float c = tab[2 * e], s = tab[2 * e + 1]; x[e] = x[e] * c + (second ? p : -p) * s; }
}
DI void unpack8(const u32x4 w, float (&x)[8]) { x[0] = lo16(w.x); x[1] = hi16(w.x); x[2] = lo16(w.y); x[3] = hi16(w.y); x[4] = lo16(w.z); x[5] = hi16(w.z); x[6] = lo16(w.w); x[7] = hi16(w.w); }
DI u32x4 pack8(const float (&x)[8]) { u32x4 w; w.x = pk2(x[0], x[1]); w.y = pk2(x[2], x[3]); w.z = pk2(x[4], x[5]); w.w = pk2(x[6], x[7]); return w; }

DI void phase_post(const Frame& F, int l) {
    const bf16* PJ = (const bf16*)(F.ws + WS_PJ);
    bf16* QA = (bf16*)(F.ws + WS_QA); bf16* KA = (bf16*)(F.ws + WS_KA); bf16* VA = (bf16*)(F.ws + WS_VA);
    bf16* QC = (bf16*)(F.ws + WS_QC); bf16* KC = (bf16*)(F.ws + WS_KC); bf16* VC = (bf16*)(F.ws + WS_VC);
    bf16* Y = (bf16*)(F.ws + WS_Y);
    const float* tabA = (const float*)(F.ws + WS_TAB); const float* tabC = (const float*)(F.ws + WS_TABC);
    constexpr int DSTR = 264, VSTR = 136;
    LAS bf16* DIFF = (LAS bf16*)F.lds;
    LAS bf16* VCT = (LAS bf16*)(F.lds + 128 * DSTR * 2);
    const int lane = F.lane, w = F.wave;
    for (int u = F.bid; u < 260; u += F.G) {
        const bool is_ctx = u >= 256;
        int b, p0, row0, n;
        if (!is_ctx) { b = u / 128; p0 = (u % 128) * 128; row0 = b * SEQ + p0; n = SEQ; }
        else { const int cc = u - 256; b = cc / 2; p0 = (cc % 2) * 128; row0 = NLAT + b * CTXL + p0; n = CTXL; }
        const int seq0 = row0 - p0;
        for (int tt = 0; tt < 16; ++tt) {
            const int tl = 16 * w + tt, p = p0 + tl, row = row0 + tl;
            const int qpos = is_ctx ? SEQ + p : p, kpos = is_ctx ? p : CTXL + p;
            const int prow = p >> 6, pcol = p & 63;
            const bf16* pr = PJ + (size_t)row * PW;
            float x[8];
            {
                unpack8(*(const u32x4*)(pr + 8 * lane), x);
                float ss = 0.f;
#pragma unroll
                for (int e = 0; e < 8; ++e) ss += x[e] * x[e];
                ss += __shfl_xor(ss, 1); ss += __shfl_xor(ss, 2); ss += __shfl_xor(ss, 4);
                const int j8 = lane & 7;
                if (lane < 48) { const float rstd = rsqrtf(ss * (1.0f / 64.0f) + RMS_EPS); const float* g = (lane < 32 ? F.in[I_AQG] : F.in[I_AKG]) + l * 64 + 8 * j8;
#pragma unroll
                    for (int e = 0; e < 8; ++e) x[e] = x[e] * rstd * g[e]; }
                if (!is_ctx) { float xr[8];
#pragma unroll
                    for (int e = 0; e < 8; ++e) xr[e] = x[e];
                    rope8(xr, 2, (j8 & 2) != 0, tabA + ((size_t)((j8 & 4) ? pcol : prow) * 16 + 8 * (j8 & 1)) * 2);
                    if (lane < 48) {
#pragma unroll
                        for (int e = 0; e < 8; ++e) x[e] = xr[e]; } }
                if (lane < 32) {
#pragma unroll
                    for (int e = 0; e < 8; ++e) x[e] *= QA_SCALE; }
                bf16* dst;
                if (lane < 32) dst = QA + ((size_t)(b * 4 + (lane >> 3)) * QROWS + qpos) * 64 + 8 * j8;
                else if (lane < 48) dst = KA + ((size_t)(b * 2 + ((lane - 32) >> 3)) * KEYS + kpos) * 64 + 8 * j8;
                else dst = VA + ((size_t)(b * 2 + ((lane - 48) >> 3)) * KEYS + kpos) * 64 + 8 * j8;
                *(u32x4*)dst = pack8(x);
            }
            {
                const u32x4 own = *(const u32x4*)(pr + 512 + 8 * lane);
                unpack8(own, x);
                const int g = (lane >> 3) & 3, half = 1 << g;
                float acc[8];
#pragma unroll
                for (int e = 0; e < 8; ++e) acc[e] = 0.f;
                const int lo = max(p - half, 0), hi = min(p + half, n);
                for (int o = -8; o < 8; ++o) { const int q = p + o;
                    if (lane < 32 && q >= lo && q < hi) { float y[8]; unpack8(*(const u32x4*)(PJ + (size_t)(seq0 + q) * PW + 512 + 8 * lane), y);
#pragma unroll
                        for (int e = 0; e < 8; ++e) acc[e] += y[e]; } }
                if (lane < 32) { const float inv = 1.0f / (float)(hi - lo); float d[8];
#pragma unroll
                    for (int e = 0; e < 8; ++e) d[e] = acc[e] * inv - x[e];
                    *(LAS u32x4*)(DIFF + tl * DSTR + 8 * lane) = pack8(d); }
                const int j4 = lane & 3;
                if (!is_ctx) rope8(x, 1, (j4 & 1) != 0, tabC + ((size_t)((j4 & 2) ? pcol : prow) * 8) * 2);
                if (lane >= 32) {
#pragma unroll
                    for (int e = 0; e < 8; ++e) x[e] *= QC_SCALE;
                    const int hh = (lane - 32) >> 3, comp = ((lane - 32) >> 2) & 1;
                    *(u32x4*)(QC + ((size_t)((b * 4 + hh) * 2 + comp) * QROWS + qpos) * 32 + 8 * j4) = pack8(x); }
            }
            {
                const u32x4 own = *(const u32x4*)(pr + 1024 + 8 * lane);
                unpack8(own, x);
                const int j4 = lane & 3;
                if (!is_ctx) { float xr[8];
#pragma unroll
                    for (int e = 0; e < 8; ++e) xr[e] = x[e];
                    rope8(xr, 1, (j4 & 1) != 0, tabC + ((size_t)((j4 & 2) ? pcol : prow) * 8) * 2);
                    if (lane < 32) {
#pragma unroll
                        for (int e = 0; e < 8; ++e) x[e] = xr[e]; } }
                if (lane < 32) { const int hh = lane >> 3, comp = (lane >> 2) & 1;
                    *(u32x4*)(KC + ((size_t)((b * 4 + hh) * 2 + comp) * KEYS + kpos) * 32 + 8 * j4) = pack8(x); }
                else { const int hh = (lane - 32) >> 3;
                    *(u32x4*)(VC + ((size_t)(b * 4 + hh) * KEYS + kpos) * 64 + 8 * (lane & 7)) = own; }
            }
            {
                unpack8(*(const u32x4*)(pr + 1536 + 8 * lane), x);
                float s = 0.f;
#pragma unroll
                for (int e = 0; e < 8; ++e) s += x[e];
                s += __shfl_xor(s, 1); s += __shfl_xor(s, 2); s += __shfl_xor(s, 4); s += __shfl_xor(s, 8); s += __shfl_xor(s, 16);
                const float mu = s * (1.0f / 256.0f); float q = 0.f;
#pragma unroll
                for (int e = 0; e < 8; ++e) { x[e] -= mu; q += x[e] * x[e]; }
                q += __shfl_xor(q, 1); q += __shfl_xor(q, 2); q += __shfl_xor(q, 4); q += __shfl_xor(q, 8); q += __shfl_xor(q, 16);
                const float rstd = rsqrtf(q * (1.0f / 256.0f) + LN_EPS);
                if (lane >= 32) {
#pragma unroll
                    for (int e = 0; e < 8; ++e) VCT[(8 * (lane - 32) + e) * VSTR + tl] = (bf16)f2bf(x[e] * rstd); }
            }
        }
        LDS_WAIT(); __syncthreads();
        {
            const bf16* PWt = (const bf16*)(F.ws + WS_POOLW) + (size_t)l * 4 * 4096;
            const int fr = lane & 15, fq = lane >> 4;
#pragma unroll 1
            for (int g = 0; g < 4; ++g) {
                bf16x8 a[2];
#pragma unroll
                for (int ks = 0; ks < 2; ++ks) a[ks] = *(const LAS bf16x8*)(DIFF + (16 * w + fr) * DSTR + 64 * g + 32 * ks + 8 * fq);
#pragma unroll
                for (int nb = 0; nb < 4; ++nb) {
                    f32x4 acc = {0.f, 0.f, 0.f, 0.f};
#pragma unroll
                    for (int ks = 0; ks < 2; ++ks) { const bf16x8 bb = *(const bf16x8*)(PWt + (size_t)g * 4096 + (16 * nb + fr) * 64 + 32 * ks + 8 * fq);
                        acc = __builtin_amdgcn_mfma_f32_16x16x32_bf16(a[ks], bb, acc, 0, 0, 0); }
                    const int ch = 64 * g + 16 * nb + fr; const float sc = F.in[I_POOLS][l * 256 + ch];
#pragma unroll
                    for (int r = 0; r < 4; ++r) Y[(size_t)(row0 + 16 * w + 4 * fq + r) * D + 256 + ch] = (bf16)f2bf(acc[r] * sc);
                }
            }
        }
        {
            const bf16* SW = (const bf16*)(F.ws + WS_SGUW) + (size_t)l * 4 * 16384;
            const int fr = lane & 15, fq = lane >> 4;
#pragma unroll 1
            for (int h = 0; h < 4; ++h) {
                bf16x8 a[4];
#pragma unroll
                for (int ks = 0; ks < 4; ++ks) a[ks] = *(const bf16x8*)(SW + (size_t)h * 16384 + (16 * w + fr) * 128 + 32 * ks + 8 * fq);
#pragma unroll
                for (int nb = 0; nb < 4; ++nb) {
                    f32x4 acc = {0.f, 0.f, 0.f, 0.f};
                    const int ch = 64 * h + 16 * nb + fr;
#pragma unroll
                    for (int ks = 0; ks < 4; ++ks) { const bf16x8 bb = *(const LAS bf16x8*)(VCT + ch * VSTR + 32 * ks + 8 * fq);
                        acc = __builtin_amdgcn_mfma_f32_16x16x32_bf16(a[ks], bb, acc, 0, 0, 0); }
#pragma unroll
                    for (int r = 0; r < 4; ++r) { const int pp = 16 * w + 4 * fq + r; const float sv = acc[r] + F.in[I_SGUB][(l * 4 + h) * 128 + pp];
                        const float uu = bf2f(PJ[(size_t)(row0 + pp) * PW + 1536 + ch]);
                        Y[(size_t)(row0 + pp) * D + 768 + ch] = (bf16)f2bf(uu * sv); }
                }
            }
        }
        __syncthreads();
    }
}

template <int QD>
DI void attn_naive_pass(const Frame& F, const bf16* Qrow, const bf16* Kb, const bf16* Vb, int nkeys, float (&o)[64]) {
    LAS float* Ks = (LAS float*)F.lds;
    LAS float* Vs = (LAS float*)(F.lds + 2 * 64 * QD * 4);
    LAS float* MG = (LAS float*)(F.lds + 65536);
    const int r = F.tid & 255, half = F.tid >> 8;
    float q[QD];
#pragma unroll
    for (int i = 0; i < QD / 8; ++i) { float x[8]; unpack8(*(const u32x4*)(Qrow + 8 * i), x);
#pragma unroll
        for (int e = 0; e < 8; ++e) q[8 * i + e] = x[e]; }
#pragma unroll
    for (int d = 0; d < 64; ++d) o[d] = 0.f;
    float m = -1e30f, lsum = 0.f;
    const int kh = nkeys / 2, kbeg = half * kh, ntile = kh / 64;
    for (int t = 0; t < ntile; ++t) {
        __syncthreads();
        const int key0 = kbeg + t * 64;
        for (int pc = r; pc < 64 * QD / 8; pc += 256) { const int kk = pc / (QD / 8), c = pc % (QD / 8); float x[8]; unpack8(*(const u32x4*)(Kb + (size_t)(key0 + kk) * QD + 8 * c), x);
#pragma unroll
            for (int e = 0; e < 8; ++e) Ks[(half * 64 + kk) * QD + 8 * c + e] = x[e]; }
        for (int pc = r; pc < 512; pc += 256) { const int kk = pc / 8, c = pc % 8; float x[8]; unpack8(*(const u32x4*)(Vb + (size_t)(key0 + kk) * 64 + 8 * c), x);
#pragma unroll
            for (int e = 0; e < 8; ++e) Vs[(half * 64 + kk) * 64 + 8 * c + e] = x[e]; }
        __syncthreads();
#pragma unroll 2
        for (int j = 0; j < 64; ++j) {
            const LAS float* kr = Ks + (half * 64 + j) * QD; float s = 0.f;
#pragma unroll
            for (int d = 0; d < QD; ++d) s += q[d] * kr[d];
            if (s > m) { const float a = exp2f(m - s); lsum *= a;
#pragma unroll
                for (int d = 0; d < 64; ++d) o[d] *= a;
                m = s; }
            const float pp = exp2f(s - m); lsum += pp;
            const LAS float* vr = Vs + (half * 64 + j) * 64;
#pragma unroll
            for (int d = 0; d < 64; ++d) o[d] += pp * vr[d];
        }
    }
    __syncthreads();
    if (half == 1) { MG[r * 66] = m; MG[r * 66 + 1] = lsum;
#pragma unroll
        for (int d = 0; d < 64; ++d) MG[r * 66 + 2 + d] = o[d]; }
    __syncthreads();
    if (half == 0) { const float m1 = MG[r * 66], l1 = MG[r * 66 + 1]; const float mm = fmaxf(m, m1); const float a0 = exp2f(m - mm), a1 = exp2f(m1 - mm);
        const float inv = 1.0f / (lsum * a0 + l1 * a1);
#pragma unroll
        for (int d = 0; d < 64; ++d) o[d] = (o[d] * a0 + MG[r * 66 + 2 + d] * a1) * inv; }
    __syncthreads();
}
DI void phase_attn_naive(const Frame& F, int l) {
    const bf16* QA = (const bf16*)(F.ws + WS_QA); const bf16* KA = (const bf16*)(F.ws + WS_KA); const bf16* VA = (const bf16*)(F.ws + WS_VA);
    const bf16* QC = (const bf16*)(F.ws + WS_QC); const bf16* KC = (const bf16*)(F.ws + WS_KC); const bf16* VC = (const bf16*)(F.ws + WS_VC);
    bf16* Y = (bf16*)(F.ws + WS_Y);
    const float lam = ((const float*)(F.ws + WS_SCAL))[2 * l], lam_init = ((const float*)(F.ws + WS_SCAL))[2 * l + 1];
    const int r = F.tid & 255, half = F.tid >> 8;
    const int nqt = (l == 0) ? 65 : 64;
    const int nunits = 2 * NB * 4 * nqt;
    for (int u = F.bid; u < nunits; u += F.G) {
        const int kind = u / (NB * 4 * nqt), v = u % (NB * 4 * nqt), qt = v % nqt, bh = v / nqt, b = bh / 4, h = bh % 4;
        const int nkeys = (qt == 64) ? CTXL : KEYS;
        const int qpos = qt * 256 + r;
        const int orow = (qt == 64) ? NLAT + b * CTXL + r : b * SEQ + qt * 256 + r;
        float o[64];
        if (kind == 0) {
            attn_naive_pass<64>(F, QA + ((size_t)(b * 4 + h) * QROWS + qpos) * 64, KA + (size_t)(b * 2 + h / 2) * KEYS * 64, VA + (size_t)(b * 2 + h / 2) * KEYS * 64, nkeys, o);
            if (half == 0) {
#pragma unroll
                for (int i = 0; i < 8; ++i) { float x[8];
#pragma unroll
                    for (int e = 0; e < 8; ++e) x[e] = o[8 * i + e];
                    *(u32x4*)(Y + (size_t)orow * D + h * 64 + 8 * i) = pack8(x); } }
        } else {
            float o0[64];
            attn_naive_pass<32>(F, QC + ((size_t)((b * 4 + h) * 2 + 0) * QROWS + qpos) * 32, KC + (size_t)((b * 4 + h) * 2 + 0) * KEYS * 32, VC + (size_t)(b * 4 + h) * KEYS * 64, nkeys, o0);
            attn_naive_pass<32>(F, QC + ((size_t)((b * 4 + h) * 2 + 1) * QROWS + qpos) * 32, KC + (size_t)((b * 4 + h) * 2 + 1) * KEYS * 32, VC + (size_t)(b * 4 + h) * KEYS * 64, nkeys, o);
            if (half == 0) { float ss = 0.f;
#pragma unroll
                for (int d = 0; d < 64; ++d) { o[d] = o0[d] - lam * o[d]; ss += o[d] * o[d]; }
                const float rstd = rsqrtf(ss * (1.0f / 64.0f) + RMS_EPS) * (1.0f - lam_init);
#pragma unroll
                for (int i = 0; i < 8; ++i) { float x[8];
#pragma unroll
                    for (int e = 0; e < 8; ++e) x[e] = o[8 * i + e] * rstd * F.in[I_CSUBLN][l * 64 + 8 * i + e];
                    *(u32x4*)(Y + (size_t)orow * D + 512 + h * 64 + 8 * i) = pack8(x); } }
        }
    }
}

DI void phase_route(const Frame& F, int l, int ntok) {
    constexpr int TSTR = 1032;
    LAS float* TK = (LAS float*)F.lds;
    LAS float* LG = (LAS float*)(F.lds + 32 * TSTR * 4);
    const int lane = F.lane, w = F.wave;
    const bf16* Z = (const bf16*)(F.ws + WS_Z); bf16* T = (bf16*)(F.ws + WS_ACT);
    float* XC = (float*)(F.ws + WS_XC); float* RINFO = (float*)(F.ws + WS_RINFO); int* LISTS = (int*)(F.ws + WS_LISTS);
    unsigned* CNT = (unsigned*)(F.ws + WS_CTL) + CW_CNT;
    const int chunk = ntok / NCHUNK;
    const float* RW = F.in[I_ROUTERW] + (size_t)l * D * NEXP;
    for (int grp = F.bid; grp < ntok / 32; grp += F.G) {
        for (int tt = 0; tt < 4; ++tt) {
            const int ti = 4 * w + tt, row = grp * 32 + ti, r = mod_row(row);
            const float* src = row < NLAT ? (l == 0 ? F.in[I_X] : F.out) + (size_t)row * D : (l == 0 ? F.in[I_CTX] : XC) + (size_t)(row - NLAT) * D;
            float* dst = row < NLAT ? F.out + (size_t)row * D : XC + (size_t)(row - NLAT) * D;
            f32x4 z[4], x[4]; load_row_bf16(Z + (size_t)row * D, lane, z); load_row_f32(src, lane, x);
            const float rz = rsqrtf(row_sumsq(z) * (1.0f / D) + RMS_EPS);
            const float* gate = modp(F, l, r, 2); const float* gp = F.in[I_GPOSTMIX] + l * D;
#pragma unroll
            for (int j = 0; j < 4; ++j) { const int c = 4 * lane + 256 * j; x[j] = x[j] + *(const f32x4*)(gate + c) * (z[j] * rz * *(const f32x4*)(gp + c)); }
            store_row_f32(dst, lane, x);
            const float rx = rsqrtf(row_sumsq(x) * (1.0f / D) + RMS_EPS);
            norm_mod(x, rx, F.in[I_GPREFFN] + l * D, modp(F, l, r, 3), modp(F, l, r, 4), lane);
            store_row_bf16(T + (size_t)row * D, lane, x);
#pragma unroll
            for (int j = 0; j < 4; ++j) *(LAS f32x4*)(TK + ti * TSTR + 4 * lane + 256 * j) = x[j];
        }
        LDS_WAIT(); __syncthreads();
        {
            const int tb = w & 1, eb = w >> 1, fr = lane & 15, fq = lane >> 4;
            f32x4 acc = {0.f, 0.f, 0.f, 0.f};
            const LAS float* ap = TK + (16 * tb + fr) * TSTR + fq; const float* bp = RW + (size_t)fq * NEXP + 16 * eb + fr;
#pragma unroll 8
            for (int k0 = 0; k0 < D; k0 += 4) acc = __builtin_amdgcn_mfma_f32_16x16x4f32(ap[k0], bp[(size_t)k0 * NEXP], acc, 0, 0, 0);
#pragma unroll
            for (int rr = 0; rr < 4; ++rr) LG[(16 * tb + 4 * fq + rr) * 64 + 16 * eb + fr] = acc[rr];
        }
        LDS_WAIT(); __syncthreads();
        for (int tt = 0; tt < 4; ++tt) {
            const int ti = 4 * w + tt, row = grp * 32 + ti;
            const float logit = LG[ti * 64 + lane];
            const float score = 1.0f / (1.0f + __expf(-logit));
            const float sel = score + F.in[I_ROUTERB][l * NEXP + lane];
            float m1 = sel; m1 = fmaxf(m1, __shfl_xor(m1, 1)); m1 = fmaxf(m1, __shfl_xor(m1, 2)); m1 = fmaxf(m1, __shfl_xor(m1, 4));
            int i1 = (sel == m1) ? (lane & 7) : 8; i1 = min(i1, __shfl_xor(i1, 1)); i1 = min(i1, __shfl_xor(i1, 2)); i1 = min(i1, __shfl_xor(i1, 4));
            float s2 = ((lane & 7) == i1) ? -INFINITY : sel; s2 = fmaxf(s2, __shfl_xor(s2, 1)); s2 = fmaxf(s2, __shfl_xor(s2, 2)); s2 = fmaxf(s2, __shfl_xor(s2, 4));
            const float gs = m1 + s2; const int g = lane >> 3;
            int grank = 0;
#pragma unroll
            for (int g2 = 0; g2 < 8; ++g2) { const float o = __shfl(gs, 8 * g2); grank += (o > gs || (o == gs && g2 < g)) ? 1 : 0; }
            const float msel = (grank < 4) ? sel : -INFINITY;
            int rank = 0;
            for (int l2 = 0; l2 < 64; ++l2) { const float o = __shfl(msel, l2); rank += (o > msel || (o == msel && l2 < lane)) ? 1 : 0; }
            const bool chosen = (rank < TOPK) && (grank < 4);
            const float wsum = wave_sum(chosen ? score : 0.f);
            if (chosen) {
                const int c = row / chunk;
                const unsigned slot = atomicAdd(CNT + 16 * ((l * NCHUNK + c) * NEXP + lane), 1u);
                if (slot < (unsigned)LCAP) LISTS[(size_t)(c * NEXP + lane) * LCAP + slot] = row * 8 + rank;
                RINFO[(size_t)row * 8 + rank] = score / wsum * 2.5f;
            }
        }
        __syncthreads();
    }
}

struct MoeSched {
    const LAS int* pre; const LAS int* cnt; const LAS int* hsb;
    int ng, nct, G, c, K; int g0;
    const char* A; const char* Wr; const char* Wsh; size_t wstride; const int* lists;
    bool gatherA; int shared_grp;
    DI bool next(int i, pg8::Unit& u) const {
        const long L = (long)i * G + c; const int total = __builtin_amdgcn_readfirstlane(pre[ng]) * nct; if (L >= total) return false;
        const int tile = (int)(L / nct), ct = (int)(L % nct);
        int lo = 0, hi = ng;
        while (hi - lo > 1) { const int mid = (lo + hi) >> 1; if (__builtin_amdgcn_readfirstlane(pre[mid]) <= tile) lo = mid; else hi = mid; }
        const int g = lo, rt = tile - __builtin_amdgcn_readfirstlane(pre[g]);
        const int cg = __builtin_amdgcn_readfirstlane(cnt[g]), hb = __builtin_amdgcn_readfirstlane(hsb[g]);
        const bool sh = (g == shared_grp);
        u.pn = ct; u.nvalid = min(cg - rt * 256, 256); u.aux = g;
        u.rows = sh ? nullptr : lists + (size_t)(g0 + g) * LCAP + rt * 256;
        const char* Wb = sh ? Wsh : Wr + (size_t)((g0 + g) % NEXP) * wstride;
        u.B = Wb + (size_t)ct * 256 * K * 2;
        if (gatherA) { u.A = sh ? A + (size_t)rt * 256 * K * 2 : A; u.orow0 = hb + rt * 256; }
        else { u.A = A + (size_t)(hb + rt * 256) * K * 2; u.orow0 = rt * 256; }
        return true;
    }
};
DI void moe_tables(const Frame& F, int l, int ntok, int gbeg, int n, bool with_shared, LAS int* pre, LAS int* cnt, LAS int* hsb, LAS int* tmp) {
    const unsigned* CNT = (const unsigned*)(F.ws + WS_CTL) + CW_CNT;
    __syncthreads();
    if (F.tid < NCHUNK * NEXP) tmp[F.tid] = (int)min(__hip_atomic_load(CNT + 16 * (l * NCHUNK * NEXP + F.tid), __ATOMIC_RELAXED, __HIP_MEMORY_SCOPE_AGENT), (unsigned)LCAP);
    __syncthreads();
    if (F.tid == 0) {
        int hs = 0, p = 0;
        for (int g = 0; g < NCHUNK * NEXP; ++g) {
            const int c = tmp[g];
            const int tiles = (c + 255) >> 8;
            if (g >= gbeg && g < gbeg + n) { pre[g - gbeg] = p; cnt[g - gbeg] = c; hsb[g - gbeg] = hs; p += tiles; }
            hs += tiles * 256;
        }
        if (with_shared) { pre[n] = p; cnt[n] = ntok; hsb[n] = HS_SH_BASE; p += ntok / 256; pre[n + 1] = p; }
        else pre[n] = p;
    }
    __syncthreads();
}

DI void phase_combine(const Frame& F, int l, int ntok, int c) {
    const int gw = F.bid * NWAVES + F.wave, NGW = F.G * NWAVES, lane = F.lane;
    const int chunk = ntok / NCHUNK;
    const bf16* OUT2 = (const bf16*)(F.ws + WS_OUT2); const bf16* F0 = (const bf16*)(F.ws + WS_F0); const float* RINFO = (const float*)(F.ws + WS_RINFO);
    float* XC = (float*)(F.ws + WS_XC); bf16* ACT = (bf16*)(F.ws + WS_ACT);
    for (int i = gw; i < chunk; i += NGW) {
        const int row = c * chunk + i, r = mod_row(row);
        f32x4 f[4]; load_row_bf16(F0 + (size_t)row * D, lane, f);
#pragma unroll
        for (int k = 0; k < TOPK; ++k) { const float wk = RINFO[(size_t)row * 8 + k]; f32x4 o[4]; load_row_bf16(OUT2 + ((size_t)i * 8 + k) * D, lane, o);
#pragma unroll
            for (int j = 0; j < 4; ++j) f[j] += wk * o[j]; }
        const float rf = rsqrtf(row_sumsq(f) * (1.0f / D) + RMS_EPS);
        float* xp = row < NLAT ? F.out + (size_t)row * D : XC + (size_t)(row - NLAT) * D;
        f32x4 x[4]; load_row_f32(xp, lane, x);
        const float* gate = modp(F, l, r, 5); const float* gp = F.in[I_GPOSTFFN] + l * D;
#pragma unroll
        for (int j = 0; j < 4; ++j) { const int cc = 4 * lane + 256 * j; x[j] = x[j] + *(const f32x4*)(gate + cc) * (f[j] * rf * *(const f32x4*)(gp + cc)); }
        store_row_f32(xp, lane, x);
        if (l == 0) {
            const float rx = rsqrtf(row_sumsq(x) * (1.0f / D) + RMS_EPS);
            norm_mod(x, rx, F.in[I_GPREMIX] + D, modp(F, 1, r, 0), modp(F, 1, r, 1), lane);
            store_row_bf16(ACT + (size_t)row * D, lane, x);
        }
    }
}

constexpr int PH_PRO_A = 0, PH_PRO_B = 1, PH_L0 = 2, PH_PER_LAYER = 14, N_PHASES = PH_L0 + 2 * PH_PER_LAYER;
__global__ void __launch_bounds__(NTHREADS, 2) fwd(Args args) {
    extern __shared__ __attribute__((aligned(16))) unsigned char lds_raw[];
    Frame F;
    F.lds = (LAS unsigned char*)lds_raw;
    F.tid = threadIdx.x; F.lane = F.tid & 63; F.wave = __builtin_amdgcn_readfirstlane(F.tid >> 6);
    F.G = gridDim.x; F.bid = blockIdx.x; F.in = args.in; F.out = args.out; F.ws = args.ws;
    volatile LAS unsigned* MISC = (volatile LAS unsigned*)(F.lds + MISC_OFF);
    for (int u = F.tid; u < (LDS_BYTES - LDSCTL_OFF) / 4; u += NTHREADS) ((LAS unsigned*)(F.lds + LDSCTL_OFF))[u] = 0u;
    __syncthreads();
    const int lo = args.ph_lo, hi = args.ph_hi;
    XcdBarrier bar; bar.bar = (unsigned*)(F.ws + WS_CTL) + CW_BAR; bar.x = 0; bar.st = nullptr;
    if (hi - lo > 1) bar = xcd_barrier_post((unsigned*)(F.ws + WS_CTL) + CW_BAR, MISC + 8);
#ifndef EN_MASK
#define EN_MASK 0x3ff
#endif
#define EN(b) (((EN_MASK) >> (b)) & 1)
#define IN(k) (lo <= (k) && (k) < hi)
#define SEAM(k) do { if (IN(k) && IN((k) + 1)) xcd_barrier(bar); } while (0)
    LAS int* TPRE = (LAS int*)(F.lds + TBL_OFF); LAS int* TCNT = TPRE + 272; LAS int* THSB = TCNT + 272; LAS int* TTMP = THSB + 272;

    if (EN(0) && IN(PH_PRO_A)) { const Frame P_ = fresh(F); phase_pro_a(P_); } SEAM(PH_PRO_A);
    if (EN(1) && IN(PH_PRO_B)) { const Frame P_ = fresh(F); phase_pro_b(P_); } SEAM(PH_PRO_B);
#pragma unroll 1
    for (int l = 0; l < 2; ++l) {
        const int P = PH_L0 + l * PH_PER_LAYER;
        const int ntok = (l == 0) ? NTOK : NLAT;
        if (EN(2) && IN(P + 0)) {
            const Frame Q = fresh(F);
            pg8::DenseOrder S; S.init((const bf16*)(Q.ws + WS_ACT), (const bf16*)(Q.ws + WS_WIN) + (size_t)l * PW * D, NTOK, PW, D, Q.G, Q.bid);
            pg8::EpiBf16 E{(bf16*)(Q.ws + WS_PJ), PW};
            pg8::gemm_phase<pg8::EpiBf16, pg8::DenseOrder, false>(Q.lds, Q.tid, D, S, E);
        } SEAM(P + 0);
        if (EN(3) && IN(P + 1)) { const Frame P_ = fresh(F); phase_post(P_, l); } SEAM(P + 1);
        if (EN(4) && IN(P + 2)) { const Frame P_ = fresh(F); phase_attn_naive(P_, l); } SEAM(P + 2);
        if (EN(5) && IN(P + 3)) {
            const Frame Q = fresh(F);
            pg8::DenseOrder S; S.init((const bf16*)(Q.ws + WS_Y), (const bf16*)(Q.ws + WS_WOUT) + (size_t)l * D * D, ntok, D, D, Q.G, Q.bid);
            pg8::EpiBf16 E{(bf16*)(Q.ws + WS_Z), D};
            pg8::gemm_phase<pg8::EpiBf16, pg8::DenseOrder, false>(Q.lds, Q.tid, D, S, E);
        } SEAM(P + 3);
        if (EN(6) && IN(P + 4)) { const Frame P_ = fresh(F); phase_route(P_, l, ntok); } SEAM(P + 4);
        if (EN(7) && IN(P + 5)) {
            const Frame Q = fresh(F);
            moe_tables(Q, l, ntok, 0, NCHUNK * NEXP, true, TPRE, TCNT, THSB, TTMP);
            MoeSched S; S.pre = TPRE; S.cnt = TCNT; S.hsb = THSB; S.ng = NCHUNK * NEXP + 1; S.nct = 2; S.G = Q.G; S.c = Q.bid; S.K = D; S.g0 = 0;
            S.A = (const char*)(Q.ws + WS_ACT); S.Wr = (const char*)(Q.ws + WS_WE13); S.Wsh = (const char*)(Q.ws + WS_WSH13) + (size_t)l * 512 * D * 2; S.wstride = (size_t)512 * D * 2;
            S.lists = (const int*)(Q.ws + WS_LISTS); S.gatherA = true; S.shared_grp = NCHUNK * NEXP;
            pg8::EpiSwiglu E{(bf16*)(Q.ws + WS_HS)};
            pg8::gemm_phase<pg8::EpiSwiglu, MoeSched, true>(Q.lds, Q.tid, D, S, E);
        } SEAM(P + 5);
#pragma unroll 1
        for (int c = 0; c < NCHUNK; ++c) {
            if (EN(8) && IN(P + 6 + 2 * c)) {
                const Frame Q = fresh(F);
                moe_tables(Q, l, ntok, c * NEXP, NEXP, c == 0, TPRE, TCNT, THSB, TTMP);
                MoeSched S; S.pre = TPRE; S.cnt = TCNT; S.hsb = THSB; S.ng = NEXP + (c == 0 ? 1 : 0); S.nct = 4; S.G = Q.G; S.c = Q.bid; S.K = EH; S.g0 = c * NEXP;
                S.A = (const char*)(Q.ws + WS_HS); S.Wr = (const char*)(Q.ws + WS_WE2); S.Wsh = (const char*)(Q.ws + WS_WSH2) + (size_t)l * D * EH * 2; S.wstride = (size_t)D * EH * 2;
                S.lists = (const int*)(Q.ws + WS_LISTS); S.gatherA = false; S.shared_grp = (c == 0) ? NEXP : -1;
                pg8::EpiMoeOut E{(bf16*)(Q.ws + WS_OUT2), (bf16*)(Q.ws + WS_F0), c * (ntok / NCHUNK) * 8};
                pg8::gemm_phase<pg8::EpiMoeOut, MoeSched, false>(Q.lds, Q.tid, EH, S, E);
            } SEAM(P + 6 + 2 * c);
            if (EN(9) && IN(P + 7 + 2 * c)) {
                const Frame Q = fresh(F);
                phase_combine(Q, l, ntok, c);
                if (l == 0 && c == NCHUNK - 1) convert_experts(Q, 1, (LAS float*)(Q.lds + Q.wave * 16384));
            } SEAM(P + 7 + 2 * c);
        }
    }
#undef IN
#undef SEAM
}

extern "C" void kernel_launch(void* const* d_in, const int* in_sizes, int n_in, void* d_out, int out_size, void* d_ws, size_t ws_size, hipStream_t stream) {
    static int grid = 0;
    if (grid == 0) {
        if (n_in != 28 || in_sizes[0] != NLAT * D || out_size != NLAT * D || ws_size < WS_END) { fprintf(stderr, "kernel_launch: unexpected shapes or workspace (%zu < %zu)\n", ws_size, (size_t)WS_END); grid = -1; return; }
        int dev = 0, cus = 0, per_cu = 0;
        if (hipGetDevice(&dev) != hipSuccess || hipDeviceGetAttribute(&cus, hipDeviceAttributeMultiprocessorCount, dev) != hipSuccess) { grid = -1; return; }
        if (hipFuncSetAttribute((const void*)fwd, hipFuncAttributeMaxDynamicSharedMemorySize, LDS_BYTES) != hipSuccess) { fprintf(stderr, "kernel_launch: hipFuncSetAttribute failed\n"); grid = -1; return; }
        if (hipOccupancyMaxActiveBlocksPerMultiprocessor(&per_cu, (const void*)fwd, NTHREADS, LDS_BYTES) != hipSuccess || per_cu < 1) { fprintf(stderr, "kernel_launch: occupancy query says %d\n", per_cu); }
        (void)hipGetLastError();
        grid = cus;
    }
    if (grid < 0) return;
    if (hipMemsetAsync((char*)d_ws + WS_CTL, 0, CTL_ZERO_BYTES, stream) != hipSuccess) return;
    Args a{};
    for (int i = 0; i < 28; ++i) a.in[i] = (const float*)d_in[i];
    a.out = (float*)d_out; a.ws = (unsigned char*)d_ws;
#if MK_ONE_LAUNCH
    a.ph_lo = 0; a.ph_hi = N_PHASES;
    hipLaunchKernelGGL(fwd, dim3(grid), dim3(NTHREADS), LDS_BYTES, stream, a);
#else
    for (int p = 0; p < N_PHASES; ++p) { a.ph_lo = p; a.ph_hi = p + 1; hipLaunchKernelGGL(fwd, dim3(grid), dim3(NTHREADS), LDS_BYTES, stream, a); }
#endif
}
```

```cpp
#include <hip/hip_runtime.h>
#include <cstdio>
#include <cstdint>

#ifndef ATTN_NAIVE
#define ATTN_NAIVE 0
#endif
#ifndef MK_ONE_LAUNCH
#define MK_ONE_LAUNCH 1
#endif

#define DI __device__ __forceinline__
#define LAS __attribute__((address_space(3)))
#define GAS __attribute__((address_space(1)))
typedef unsigned short bf16;
typedef short bf16x8 __attribute__((ext_vector_type(8)));
typedef float f32x4 __attribute__((ext_vector_type(4)));
typedef float f32x2 __attribute__((ext_vector_type(2)));
typedef unsigned u32x4 __attribute__((ext_vector_type(4)));
typedef unsigned u32x2 __attribute__((ext_vector_type(2)));

constexpr int D = 1024, NB = 2, SEQ = 16384, NLAT = NB * SEQ, CTXL = 256, NCTX = NB * CTXL, NTOK = NLAT + NCTX;
constexpr int PW = 2048, KEYS = CTXL + SEQ, QROWS = SEQ + CTXL;
constexpr int NEXP = 64, TOPK = 8, EH = 256, NCHUNK = 4, LCAP = NTOK / NCHUNK;
constexpr int NWAVES = 8, NTHREADS = 512;
constexpr float RMS_EPS = 1e-6f, LN_EPS = 1e-5f;
constexpr float LOG2E = 1.4426950408889634f;
constexpr float QA_SCALE = 0.125f * LOG2E;
constexpr float QC_SCALE = 0.17677669529663687f * LOG2E;

constexpr size_t MiB = 1u << 20;
constexpr size_t WS_CTL = 0, CTL_ZERO_BYTES = 1 * MiB;
constexpr size_t WS_MOD = 1 * MiB;
constexpr size_t WS_TAB = 1 * MiB + 256 * 1024;
constexpr size_t WS_TABC = WS_TAB + 32768, WS_SCAL = WS_TAB + 49152;
constexpr size_t WS_SGUW = 2 * MiB;
constexpr size_t WS_POOLW = 2 * MiB + 512 * 1024;
constexpr size_t WS_WIN = 8 * MiB;
constexpr size_t WS_WOUT = 16 * MiB;
constexpr size_t WS_WSH13 = 20 * MiB;
constexpr size_t WS_WSH2 = 22 * MiB;
constexpr size_t WS_XC = 24 * MiB;
constexpr size_t WS_RINFO = 26 * MiB;
constexpr size_t WS_LISTS = 28 * MiB;
constexpr size_t WS_WE13 = 40 * MiB;
constexpr size_t WS_WE2 = 104 * MiB;
constexpr size_t WS_ACT = 136 * MiB;
constexpr size_t WS_R = 201 * MiB;
constexpr size_t WS_PJ = WS_R;
constexpr size_t QA_BYTES = (size_t)NB * 4 * QROWS * 64 * 2, KA_BYTES = (size_t)NB * 2 * KEYS * 64 * 2;
constexpr size_t WS_QA = 331 * MiB, WS_KA = WS_QA + QA_BYTES, WS_VA = WS_KA + KA_BYTES, WS_QC = WS_VA + KA_BYTES;
constexpr size_t WS_KC = WS_QC + QA_BYTES, WS_VC = WS_KC + QA_BYTES;
constexpr size_t WS_Y = 413 * MiB, WS_Z = 478 * MiB;
static_assert(WS_VC + QA_BYTES <= WS_Y, "qkv region");
constexpr int HS_SH_BASE = NTOK * TOPK + NCHUNK * NEXP * 255;
constexpr size_t WS_HS = WS_R;
constexpr size_t WS_OUT2 = 380 * MiB;
constexpr size_t WS_F0 = 510 * MiB;
constexpr size_t WS_END = 575 * MiB;
static_assert(WS_HS + (size_t)(HS_SH_BASE + NTOK) * 512 <= WS_OUT2, "hs region");
constexpr int CW_TMO = 0, CW_BAR = 4096, CW_CNT = 16384;
constexpr int CW_MAXK = 32768;

constexpr int LDS_BYTES = 147456, LDS_SCRATCH = 141312, LDSCTL_OFF = LDS_SCRATCH;
constexpr int MISC_OFF = LDSCTL_OFF;
constexpr int TBL_OFF = LDSCTL_OFF + 128;

DI float bf2f(unsigned v) { return __uint_as_float(v << 16); }
DI unsigned f2bf(float f) { unsigned u = __float_as_uint(f); return (u + 0x7fffu + ((u >> 16) & 1u)) >> 16; }
DI unsigned pk2(float lo, float hi) { return f2bf(lo) | (f2bf(hi) << 16); }
DI float lo16(unsigned w) { return __uint_as_float(w << 16); }
DI float hi16(unsigned w) { return __uint_as_float(w & 0xffff0000u); }
DI float wave_sum(float v) {
#pragma unroll
    for (int o = 1; o < 64; o <<= 1) v += __shfl_xor(v, o);
    return v;
}
#define LDS_WAIT() asm volatile("s_waitcnt lgkmcnt(0)" ::: "memory")
#define VM_WAIT() asm volatile("s_waitcnt vmcnt(0)" ::: "memory")

namespace pg8 {
constexpr int BM = 256, BK = 64, HALF = 128, HTB = HALF * BK * 2, STAGE_BYTES = 8 * HTB, NXCD = 8, WGM = 8;
__host__ __device__ __forceinline__ int lds_byte(int r, int c) { const int st = (r >> 4) * 2 + (c >> 5), rr = r & 15, cc = c & 31, ob = rr * 64 + cc * 2; return st * 1024 + (ob ^ (((ob >> 9) & 1) << 5)); }
__host__ __device__ __forceinline__ void stage_rc(int b, int& R, int& C) { const int st = b / 1024, sb = b % 1024, swz = sb ^ (((sb >> 9) & 1) << 5); R = (st >> 1) * 16 + swz / 64; C = (st & 1) * 32 + (swz % 64) / 2; }
__host__ __device__ __forceinline__ int perm32(int rho) { const int n = rho >> 4, i = rho & 15; return 8 * (i >> 2) + 4 * n + (i & 3); }

struct Unit {
    const char* A;
    const char* B;
    const int* rows;
    int nvalid;
    int orow0;
    int pn;
    int aux;
};

struct DenseOrder {
    const bf16* A; const bf16* Bt; int K; int nM, nN, nwg, G, c;
    DI void init(const bf16* A_, const bf16* Bt_, int M, int N, int K_, int G_, int c_) { A = A_; Bt = Bt_; K = K_; nM = M / BM; nN = N / BM; nwg = nM * nN; G = G_; c = c_; }
    DI bool next(int i, Unit& u) const {
        const long L = (long)i * G + c; if (L >= nwg) return false;
        int wgid = (int)L; { const int q = nwg / NXCD, r = nwg % NXCD, xcd = wgid % NXCD, off = wgid / NXCD; wgid = (xcd < r ? xcd * (q + 1) : r * (q + 1) + (xcd - r) * q) + off; }
        const int nig = WGM * nN, gid = wgid / nig, fm = gid * WGM, gsz = (nM - fm) < WGM ? (nM - fm) : WGM;
        const int pm = fm + ((wgid % nig) % gsz), pn = (wgid % nig) / gsz;
        u.A = (const char*)A + (size_t)pm * BM * K * 2; u.B = (const char*)Bt + (size_t)pn * BM * K * 2; u.rows = nullptr; u.nvalid = BM; u.orow0 = pm * BM; u.pn = pn; u.aux = 0;
        return true;
    }
};

DI unsigned cvt_pk_bf16(float lo, float hi) { unsigned r; asm volatile("v_cvt_pk_bf16_f32 %0, %1, %2" : "=v"(r) : "v"(lo), "v"(hi)); return r; }

struct EpiBf16 {
    static constexpr bool PERM = true;
    bf16* O; int ldc;
    DI void operator()(const f32x4 (&acc)[2][2][4][2], const Unit& u, int wr, int wc, int fr, int fq) const {
        const int row0 = u.orow0 + wr * 64 + fr; const int col0 = u.pn * BM + wc * 32 + 8 * fq;
#pragma unroll
        for (int ai = 0; ai < 2; ++ai)
#pragma unroll
            for (int m = 0; m < 4; ++m) { bf16* rowp = O + (size_t)(row0 + ai * HALF + m * 16) * ldc + col0;
#pragma unroll
                for (int bj = 0; bj < 2; ++bj) { const f32x4 v0 = acc[ai][bj][m][0], v1 = acc[ai][bj][m][1];
                    u32x4 w; w.x = cvt_pk_bf16(v0[0], v0[1]); w.y = cvt_pk_bf16(v0[2], v0[3]); w.z = cvt_pk_bf16(v1[0], v1[1]); w.w = cvt_pk_bf16(v1[2], v1[3]);
                    *(u32x4*)(rowp + bj * HALF) = w; } }
    }
};
struct EpiSwiglu {
    static constexpr bool PERM = false;
    bf16* Hs;
    DI void operator()(const f32x4 (&acc)[2][2][4][2], const Unit& u, int wr, int wc, int fr, int fq) const {
        const int row0 = u.orow0 + wr * 64 + fr; const int f0 = u.pn * 128 + wc * 16 + 4 * fq;
#pragma unroll
        for (int ai = 0; ai < 2; ++ai)
#pragma unroll
            for (int m = 0; m < 4; ++m) { bf16* rowp = Hs + (size_t)(row0 + ai * HALF + m * 16) * EH + f0;
#pragma unroll
                for (int bj = 0; bj < 2; ++bj) { const f32x4 a = acc[ai][bj][m][0], b = acc[ai][bj][m][1]; float h[4];
#pragma unroll
                    for (int j = 0; j < 4; ++j) { const float s = a[j] * __builtin_amdgcn_rcpf(1.0f + __builtin_amdgcn_exp2f(-a[j] * LOG2E)); h[j] = s * b[j]; }
                    u32x2 w; w.x = cvt_pk_bf16(h[0], h[1]); w.y = cvt_pk_bf16(h[2], h[3]);
                    *(u32x2*)(rowp + bj * 64) = w; } }
    }
};
struct EpiMoeOut {
    static constexpr bool PERM = true;
    bf16* OUT2; bf16* F0; int ebase;
    DI void operator()(const f32x4 (&acc)[2][2][4][2], const Unit& u, int wr, int wc, int fr, int fq) const {
        const int col0 = u.pn * BM + wc * 32 + 8 * fq;
        const bool routed = u.rows != nullptr;
        bf16* base = routed ? OUT2 : F0;
        int drow[2][4];
#pragma unroll
        for (int ai = 0; ai < 2; ++ai)
#pragma unroll
            for (int m = 0; m < 4; ++m) { const int r = wr * 64 + fr + ai * HALF + m * 16;
                if (routed) drow[ai][m] = (r < u.nvalid) ? (u.rows[r] - ebase) : -1; else drow[ai][m] = u.orow0 + r; }
#pragma unroll
        for (int ai = 0; ai < 2; ++ai)
#pragma unroll
            for (int m = 0; m < 4; ++m) {
                if (drow[ai][m] >= 0) { bf16* rowp = base + (size_t)drow[ai][m] * D + col0;
#pragma unroll
                for (int bj = 0; bj < 2; ++bj) { const f32x4 v0 = acc[ai][bj][m][0], v1 = acc[ai][bj][m][1];
                    u32x4 w; w.x = cvt_pk_bf16(v0[0], v0[1]); w.y = cvt_pk_bf16(v0[2], v0[3]); w.z = cvt_pk_bf16(v1[0], v1[1]); w.w = cvt_pk_bf16(v1[2], v1[3]);
                    *(u32x4*)(rowp + bj * HALF) = w; } } }
    }
};

template <bool GATHER> DI void set_voff(const Unit& u, unsigned (&v)[2][2], const int (&Rr)[2], const int (&Cc)[2], int K) {
#pragma unroll
    for (int h = 0; h < 2; ++h)
#pragma unroll
        for (int i = 0; i < 2; ++i) {
            if (GATHER && u.rows) { const int r = h * HALF + Rr[i]; const int e = (r < u.nvalid) ? u.rows[r] : 0; v[h][i] = (unsigned)((e >> 3) * K + Cc[i]) * 2u; }
            else v[h][i] = (unsigned)((h * HALF + Rr[i]) * K + Cc[i]) * 2u;
        }
}

template <class Epi, class Sched, bool GATHER>
DI void gemm_phase(LAS unsigned char* lds, const int tid, const int K, const Sched& S, const Epi& E) {
    const int wid = __builtin_amdgcn_readfirstlane(tid >> 6), lane = tid & 63, wr = wid >> 2, wc = wid & 3, fr = lane & 15, fq = lane >> 4;
    const int nt = K / BK;
    int Rr[2], Cc[2]; unsigned voffB[2];
#pragma unroll
    for (int i = 0; i < 2; ++i) { int R, C; stage_rc(tid * 16 + i * 8192, R, C); const int Rb = Epi::PERM ? ((R & ~31) + perm32(R & 31)) : R; Rr[i] = R; Cc[i] = C; voffB[i] = (unsigned)(Rb * K + C) * 2u; }
    const size_t kstep = (size_t)(BK * 2);
    const size_t hstep = (size_t)HALF * K * 2;
    const unsigned ldsw = (unsigned)wid * 1024u;
    const int aoff = lds_byte(wr * 64 + fr, fq * 8), boff = lds_byte(wc * 32 + fr, fq * 8);
#define PG8_SA(b, h) (((b) * 2 + (h)) * HTB)
#define PG8_SB(b, h) ((4 + (b) * 2 + (h)) * HTB)
#define PG8_STAGE(bufoff, gbase, voff) do { _Pragma("unroll") for (int _i = 0; _i < 2; ++_i) \
        __builtin_amdgcn_global_load_lds((const unsigned*)((const char*)(gbase) + (voff)[_i]), (LAS unsigned*)(lds + (bufoff) + ldsw + _i * 8192), 16, 0, 0); } while (0)
#define PG8_LDA(dst, b, h) do { _Pragma("unroll") for (int m = 0; m < 4; ++m) _Pragma("unroll") for (int k = 0; k < 2; ++k) dst[m][k] = *(const LAS bf16x8*)(lds + PG8_SA(b, h) + aoff + m * 2048 + k * 1024); } while (0)
#define PG8_LDB(dst, b, h) do { _Pragma("unroll") for (int n = 0; n < 2; ++n) _Pragma("unroll") for (int k = 0; k < 2; ++k) dst[n][k] = *(const LAS bf16x8*)(lds + PG8_SB(b, h) + boff + n * 2048 + k * 1024); } while (0)
#define PG8_MMA(ai, bj, At, Bt) do { __builtin_amdgcn_s_setprio(1); _Pragma("unroll") for (int m = 0; m < 4; ++m) _Pragma("unroll") for (int n = 0; n < 2; ++n) _Pragma("unroll") for (int k = 0; k < 2; ++k) \
        acc[ai][bj][m][n] = __builtin_amdgcn_mfma_f32_16x16x32_bf16(Bt[n][k], At[m][k], acc[ai][bj][m][n], 0, 0, 0); __builtin_amdgcn_s_setprio(0); } while (0)
#define PG8_WAIT_V(n) asm volatile("s_waitcnt vmcnt(" #n ")" ::: "memory")
#define PG8_WAIT_L(n) asm volatile("s_waitcnt lgkmcnt(" #n ")" ::: "memory")
#define PG8_BAR __builtin_amdgcn_s_barrier()
#define PG8_SCHED __builtin_amdgcn_sched_barrier(0)
    Unit cur, nxt; int ui = 0;
    if (!S.next(0, cur)) return;
    f32x4 acc[2][2][4][2];
#pragma unroll
    for (int a = 0; a < 2; ++a)
#pragma unroll
        for (int b = 0; b < 2; ++b)
#pragma unroll
            for (int m = 0; m < 4; ++m)
#pragma unroll
                for (int n = 0; n < 2; ++n) acc[a][b][m][n] = (f32x4){0.f, 0.f, 0.f, 0.f};
    bf16x8 At[4][2], B0[2][2], B1[2][2];
    unsigned voC[2][2], voN[2][2];
    set_voff<GATHER>(cur, voC, Rr, Cc, K);
    const char* cA = cur.A; const char* cB = cur.B;
    PG8_STAGE(PG8_SB(0, 0), cB, voffB); PG8_STAGE(PG8_SB(0, 1), cB + hstep, voffB); PG8_STAGE(PG8_SA(0, 0), cA, voC[0]); PG8_STAGE(PG8_SA(0, 1), cA, voC[1]);
    if (wr == 1) PG8_BAR;
    PG8_WAIT_V(2); PG8_BAR;
    PG8_STAGE(PG8_SB(1, 0), cB + kstep, voffB); PG8_STAGE(PG8_SA(1, 0), cA + kstep, voC[0]); PG8_STAGE(PG8_SB(1, 1), cB + hstep + kstep, voffB);
    PG8_WAIT_V(6); PG8_BAR;
    for (;;) {
        const bool has_next = S.next(ui + 1, nxt);
        const char* nA = has_next ? nxt.A : cA; const char* nB = has_next ? nxt.B : cB;
        if (GATHER && has_next) set_voff<GATHER>(nxt, voN, Rr, Cc, K);
        else {
#pragma unroll
            for (int h = 0; h < 2; ++h)
#pragma unroll
                for (int i = 0; i < 2; ++i) voN[h][i] = voC[h][i]; }
#pragma unroll 1
        for (int t = 0; t < nt; t += 2) {
            const bool last = (t == nt - 2);
            const char* a1 = cA + (size_t)(t + 1) * kstep;
            const char* a2 = last ? nA : cA + (size_t)(t + 2) * kstep; const char* b2 = last ? nB : cB + (size_t)(t + 2) * kstep;
            const char* a3 = a2 + kstep; const char* b3 = b2 + kstep;
            unsigned vo2[2][2];
#pragma unroll
            for (int h = 0; h < 2; ++h)
#pragma unroll
                for (int i = 0; i < 2; ++i) vo2[h][i] = (GATHER && last) ? voN[h][i] : voC[h][i];
            PG8_LDB(B0, 0, 0); PG8_LDB(B1, 0, 1); PG8_SCHED; PG8_LDA(At, 0, 0); PG8_STAGE(PG8_SA(1, 1), a1, voC[1]);
            PG8_WAIT_V(8); PG8_WAIT_L(0); PG8_BAR; PG8_MMA(0, 0, At, B0); PG8_MMA(0, 1, At, B1); PG8_BAR; PG8_SCHED;
            PG8_LDA(At, 0, 1); PG8_STAGE(PG8_SB(0, 0), b2, voffB); PG8_STAGE(PG8_SB(0, 1), b2 + hstep, voffB); PG8_STAGE(PG8_SA(0, 0), a2, vo2[0]);
            PG8_WAIT_V(8); PG8_WAIT_L(0); PG8_BAR; PG8_MMA(1, 0, At, B0); PG8_MMA(1, 1, At, B1); PG8_BAR; PG8_SCHED;
            PG8_LDB(B0, 1, 0); PG8_LDB(B1, 1, 1); PG8_SCHED; PG8_LDA(At, 1, 0); PG8_STAGE(PG8_SA(0, 1), a2, vo2[1]);
            PG8_WAIT_V(8); PG8_WAIT_L(0); PG8_BAR; PG8_MMA(0, 0, At, B0); PG8_MMA(0, 1, At, B1); PG8_BAR; PG8_SCHED;
            PG8_LDA(At, 1, 1); PG8_STAGE(PG8_SB(1, 0), b3, voffB); PG8_STAGE(PG8_SB(1, 1), b3 + hstep, voffB); PG8_STAGE(PG8_SA(1, 0), a3, vo2[0]);
            PG8_WAIT_V(8); PG8_WAIT_L(0); PG8_BAR; PG8_MMA(1, 0, At, B0); PG8_MMA(1, 1, At, B1); PG8_BAR; PG8_SCHED;
        }
        if (wr == 0) PG8_BAR;
        E(acc, cur, wr, wc, fr, fq);
        if (!has_next) break;
#pragma unroll
        for (int a = 0; a < 2; ++a)
#pragma unroll
            for (int b = 0; b < 2; ++b)
#pragma unroll
                for (int m = 0; m < 4; ++m)
#pragma unroll
                    for (int n = 0; n < 2; ++n) acc[a][b][m][n] = (f32x4){0.f, 0.f, 0.f, 0.f};
        cur = nxt; cA = nA; cB = nB; ++ui;
#pragma unroll
        for (int h = 0; h < 2; ++h)
#pragma unroll
            for (int i = 0; i < 2; ++i) voC[h][i] = voN[h][i];
        if (wr == 1) PG8_BAR;
    }
    PG8_WAIT_V(0);
    PG8_BAR;
#undef PG8_SA
#undef PG8_SB
#undef PG8_STAGE
#undef PG8_LDA
#undef PG8_LDB
#undef PG8_MMA
#undef PG8_WAIT_V
#undef PG8_WAIT_L
#undef PG8_BAR
#undef PG8_SCHED
}
}

#define XB_TMO      128
#define XB_XCNT(j)  (256  + 64 * (j))
#define XB_XSUB(j)  (1280 + 64 * (j))
#define XB_XGEN(j)  (2304 + 64 * (j))
#define XB_TOP      3328
#define XB_TOPGEN   3392
#define XCD_BAR_WORDS 3456
#define XB_SPIN_CAP (1u << 18)
DI unsigned xb_ld(unsigned* p)              { return __hip_atomic_load(p, __ATOMIC_RELAXED, __HIP_MEMORY_SCOPE_AGENT); }
DI unsigned xb_add(unsigned* p, unsigned v) { return __hip_atomic_fetch_add(p, v, __ATOMIC_RELAXED, __HIP_MEMORY_SCOPE_AGENT); }
DI unsigned xb_xcc_id() { return (unsigned)__builtin_amdgcn_s_getreg((3 << 11) | 20) & 0xFu; }
#define XB_SPIN(cond, bar) do { unsigned _sp = 0; while (cond) { __builtin_amdgcn_s_sleep(1); \
    if ((++_sp & 255u) == 0u) { if (xb_ld(&(bar)[XB_TMO])) break; if (_sp > XB_SPIN_CAP) { atomicAdd(&(bar)[XB_TMO], 1u); break; } } } } while (0)
struct XcdBarrier { unsigned* bar; unsigned x; volatile LAS unsigned* st; };
DI XcdBarrier xcd_barrier_post(unsigned* bar, volatile LAS unsigned* st) {
    XcdBarrier b; b.bar = bar; b.x = xb_xcc_id(); b.st = st;
    if (threadIdx.x == 0) (void)xb_add(&bar[XB_XCNT(b.x)], 1u);
    return b;
}
DI void xcd_barrier_complete(unsigned* bar, unsigned x, unsigned& nloc, unsigned& nx) {
    const unsigned G = gridDim.x * gridDim.y * gridDim.z;
    unsigned sum, cnt, mine, sp = 0u;
    for (;;) {
        sum = 0u; cnt = 0u; mine = 0u;
#pragma unroll
        for (unsigned j = 0; j < 16; ++j) { const unsigned c = xb_ld(&bar[XB_XCNT(j)]); sum += c; cnt += (c > 0u) ? 1u : 0u; mine = (j == x) ? c : mine; }
        if (sum == G) break;
        __builtin_amdgcn_s_sleep(1);
        if ((++sp & 255u) == 0u) { if (xb_ld(&bar[XB_TMO])) break; if (sp > XB_SPIN_CAP) { atomicAdd(&bar[XB_TMO], 1u); break; } }
    }
    nloc = mine > 0u ? mine : 1u; nx = cnt > 0u ? cnt : 1u;
}
DI void xcd_barrier(const XcdBarrier& b) {
    asm volatile("s_waitcnt vmcnt(0)" ::: "memory");
    __syncthreads();
    if (threadIdx.x == 0) {
        unsigned* bar = b.bar;
        __builtin_amdgcn_s_waitcnt(0);
        unsigned nloc = b.st[0], nx = b.st[1];
        if (nloc == 0u) { xcd_barrier_complete(bar, b.x, nloc, nx); b.st[0] = nloc; b.st[1] = nx; }
        const unsigned old = xb_add(&bar[XB_XSUB(b.x)], 1u);
        const unsigned gen = old / nloc;
        if (old + 1u == (gen + 1u) * nloc) {
            __builtin_amdgcn_fence(__ATOMIC_RELEASE, "agent");
            asm volatile("s_waitcnt vmcnt(0)" ::: "memory");
            const unsigned og = xb_add(&bar[XB_TOP], 1u);
            const unsigned tg = og / nx;
            if (og + 1u == (tg + 1u) * nx) xb_add(&bar[XB_TOPGEN], 1u);
            else XB_SPIN(xb_ld(&bar[XB_TOPGEN]) == tg, bar);
            __builtin_amdgcn_fence(__ATOMIC_ACQUIRE, "agent");
            xb_add(&bar[XB_XGEN(b.x)], 1u);
            asm volatile("s_waitcnt vmcnt(0)" ::: "memory");
        } else {
            XB_SPIN(xb_ld(&bar[XB_XGEN(b.x)]) == gen, bar);
            __builtin_amdgcn_fence(__ATOMIC_ACQUIRE, "agent");
            asm volatile("s_waitcnt vmcnt(0)" ::: "memory");
        }
    }
    __syncthreads();
}

struct Args { const float* in[28]; float* out; unsigned char* ws; int ph_lo, ph_hi; };
enum { I_X = 0, I_C, I_CTX, I_CCTX, I_ADAW, I_ADAB, I_GPREMIX, I_GPOSTMIX, I_GPREFFN, I_GPOSTFFN, I_WIN, I_WOUT, I_AQG, I_AKG, I_POOLW, I_POOLS, I_LAMQK, I_CSUBLN,
       I_SGUW, I_SGUB, I_ROUTERW, I_ROUTERB, I_EW1, I_EW3, I_EW2, I_SW1, I_SW3, I_SW2 };

struct Frame {
    LAS unsigned char* lds;
    int tid, lane, wave, G, bid;
    const float* const* in; float* out; unsigned char* ws;
};

DI size_t opaque0() { unsigned z; asm volatile("s_mov_b32 %0, 0" : "=s"(z)); return (size_t)z; }
#ifdef NO_LAUNDER
DI Frame fresh(const Frame& F) { return F; }
#else
DI Frame fresh(const Frame& F) { Frame G = F; const size_t z = opaque0(); G.ws = F.ws + z; G.in = F.in + z; G.out = F.out + z; G.tid = F.tid + (int)z; G.lane = G.tid & 63; G.wave = __builtin_amdgcn_readfirstlane(G.tid >> 6); G.bid = F.bid + (int)z; G.G = F.G + (int)z; G.lds = F.lds + z; return G; }
#endif
DI void load_row_f32(const float* p, int lane, f32x4 (&v)[4]) {
#pragma unroll
    for (int j = 0; j < 4; ++j) v[j] = *(const f32x4*)(p + 4 * lane + 256 * j);
}
DI void load_row_bf16(const bf16* p, int lane, f32x4 (&v)[4]) {
#pragma unroll
    for (int j = 0; j < 4; ++j) { const u32x2 w = *(const u32x2*)(p + 4 * lane + 256 * j); v[j] = (f32x4){lo16(w.x), hi16(w.x), lo16(w.y), hi16(w.y)}; }
}
DI void store_row_f32(float* p, int lane, const f32x4 (&v)[4]) {
#pragma unroll
    for (int j = 0; j < 4; ++j) *(f32x4*)(p + 4 * lane + 256 * j) = v[j];
}
DI void store_row_bf16(bf16* p, int lane, const f32x4 (&v)[4]) {
#pragma unroll
    for (int j = 0; j < 4; ++j) { u32x2 w; w.x = pk2(v[j][0], v[j][1]); w.y = pk2(v[j][2], v[j][3]); *(u32x2*)(p + 4 * lane + 256 * j) = w; }
}
DI float row_sumsq(const f32x4 (&v)[4]) {
    float s = 0.f;
#pragma unroll
    for (int j = 0; j < 4; ++j) s += (v[j][0] * v[j][0] + v[j][1] * v[j][1]) + (v[j][2] * v[j][2] + v[j][3] * v[j][3]);
    return wave_sum(s);
}
DI void norm_mod(f32x4 (&v)[4], float rstd, const float* g, const float* shift, const float* scale, int lane) {
#pragma unroll
    for (int j = 0; j < 4; ++j) { const int c = 4 * lane + 256 * j; const f32x4 gg = *(const f32x4*)(g + c), sh = *(const f32x4*)(shift + c), sc = *(const f32x4*)(scale + c);
        v[j] = (v[j] * rstd * gg) * (1.0f + sc) + sh; }
}
DI const float* modp(const Frame& F, int l, int r, int j) { return (const float*)(F.ws + WS_MOD) + ((size_t)(l * 3 + r) * 6 + j) * D; }
DI int mod_row(int row) { return row < NLAT ? row / SEQ : 2; }

template <class RowMap>
DI void transpose_item(const float* W, int K, int N, bf16* WT, const RowMap& rm, LAS float* scr, int item, int lane) {
    const int nblk = N / 32, kb = item / nblk, nb = item % nblk, k0 = 64 * kb, n0 = 32 * nb;
#pragma unroll 8
    for (int i = 0; i < 32; ++i) { const int kk = 2 * i + (lane >> 5); scr[kk * 33 + (lane & 31)] = W[(size_t)(k0 + kk) * N + n0 + (lane & 31)]; }
    LDS_WAIT(); asm volatile("" ::: "memory");
    const int c = lane & 7;
#pragma unroll
    for (int j = 0; j < 4; ++j) { const int n = (lane >> 3) + 8 * j; const LAS float* s = scr + (8 * c) * 33 + n;
        u32x4 o; o.x = pk2(s[0 * 33], s[1 * 33]); o.y = pk2(s[2 * 33], s[3 * 33]); o.z = pk2(s[4 * 33], s[5 * 33]); o.w = pk2(s[6 * 33], s[7 * 33]);
        *(u32x4*)(WT + (size_t)rm(n0 + n) * K + k0 + 8 * c) = o; }
    LDS_WAIT(); asm volatile("" ::: "memory");
}
struct RowId { int off; DI int operator()(int n) const { return off + n; } };
struct RowW13 { int which; DI int operator()(int f) const { return ((f >> 4) << 5) + (f & 15) + 16 * which; } };

DI void convert_experts(const Frame& F, int l, LAS float* scr) {
    const int gw = F.bid * NWAVES + F.wave, NGW = F.G * NWAVES;
    bf16* WE13 = (bf16*)(F.ws + WS_WE13); bf16* WE2 = (bf16*)(F.ws + WS_WE2);
    constexpr int IT = 128;
    for (int it = gw; it < NEXP * 3 * IT; it += NGW) {
        const int e = it / (3 * IT), r = it % (3 * IT), m = r / IT, item = r % IT;
        const size_t eo = ((size_t)l * NEXP + e) * (size_t)(D * EH);
        if (m == 0) transpose_item(F.in[I_EW1] + eo, D, EH, WE13 + (size_t)e * 512 * D, RowW13{0}, scr, item, F.lane);
        else if (m == 1) transpose_item(F.in[I_EW3] + eo, D, EH, WE13 + (size_t)e * 512 * D, RowW13{1}, scr, item, F.lane);
        else transpose_item(F.in[I_EW2] + eo, EH, D, WE2 + (size_t)e * D * EH, RowId{0}, scr, item, F.lane);
    }
}

DI void phase_pro_a(const Frame& F) {
    LAS float* scrw = (LAS float*)(F.lds + F.wave * 16384);
    if (F.bid < 192) {
        const int l = F.bid / 96, cg = F.bid % 96, n = cg * 64 + F.lane;
        const float* W = F.in[I_ADAW] + (size_t)l * D * 6144;
        float a0 = 0.f, a1 = 0.f, a2 = 0.f;
        const int k0 = F.wave * 128;
#pragma unroll 8
        for (int k = k0; k < k0 + 128; ++k) {
            const float w = W[(size_t)k * 6144 + n];
            const float c0 = F.in[I_C][k], c1 = F.in[I_C][D + k], c2 = F.in[I_CCTX][k];
            a0 += w * (c0 / (1.0f + __expf(-c0))); a1 += w * (c1 / (1.0f + __expf(-c1))); a2 += w * (c2 / (1.0f + __expf(-c2)));
        }
        LAS float* red = (LAS float*)(F.lds + 131072);
        red[(F.wave * 3 + 0) * 64 + F.lane] = a0; red[(F.wave * 3 + 1) * 64 + F.lane] = a1; red[(F.wave * 3 + 2) * 64 + F.lane] = a2;
        __syncthreads();
        if (F.wave < 3) { float s = F.in[I_ADAB][l * 6144 + n];
#pragma unroll
            for (int w = 0; w < 8; ++w) s += red[(w * 3 + F.wave) * 64 + F.lane];
            ((float*)(F.ws + WS_MOD))[(size_t)(l * 3 + F.wave) * 6144 + n] = s; }
        __syncthreads();
    }
    const int gw = F.bid * NWAVES + F.wave, NGW = F.G * NWAVES;
    {
        constexpr int I_IN = 16 * 64, I_OUT = 16 * 32, I_S = 128;
        constexpr int PER_L = I_IN + I_OUT + 3 * I_S;
        for (int it = gw; it < 2 * PER_L; it += NGW) {
            const int l = it / PER_L; int r = it % PER_L;
            if (r < I_IN) { transpose_item(F.in[I_WIN] + (size_t)l * D * PW, D, PW, (bf16*)(F.ws + WS_WIN) + (size_t)l * PW * D, RowId{0}, scrw, r, F.lane); continue; } r -= I_IN;
            if (r < I_OUT) { transpose_item(F.in[I_WOUT] + (size_t)l * D * D, D, D, (bf16*)(F.ws + WS_WOUT) + (size_t)l * D * D, RowId{0}, scrw, r, F.lane); continue; } r -= I_OUT;
            bf16* S13 = (bf16*)(F.ws + WS_WSH13) + (size_t)l * 512 * D; bf16* S2 = (bf16*)(F.ws + WS_WSH2) + (size_t)l * D * EH;
            if (r < I_S) { transpose_item(F.in[I_SW1] + (size_t)l * D * EH, D, EH, S13, RowW13{0}, scrw, r, F.lane); continue; } r -= I_S;
            if (r < I_S) { transpose_item(F.in[I_SW3] + (size_t)l * D * EH, D, EH, S13, RowW13{1}, scrw, r, F.lane); continue; } r -= I_S;
            transpose_item(F.in[I_SW2] + (size_t)l * EH * D, EH, D, S2, RowId{0}, scrw, r, F.lane);
        }
    }
    convert_experts(F, 0, scrw);
    const int gt = F.bid * NTHREADS + F.tid, NGT = F.G * NTHREADS;
    for (int i = gt; i < 2 * 4 * 128 * 128; i += NGT) ((bf16*)(F.ws + WS_SGUW))[i] = (bf16)f2bf(F.in[I_SGUW][i]);
    for (int i = gt; i < 2 * 4 * 64 * 64; i += NGT) { const int lg = i / 4096, n = (i / 64) % 64, k = i % 64; ((bf16*)(F.ws + WS_POOLW))[i] = (bf16)f2bf(F.in[I_POOLW][(size_t)lg * 4096 + k * 64 + n]); }
    for (int i = gt; i < 256 * 16; i += NGT) { const int p = i / 16, f = i % 16; const float inv = powf(10000.0f, -(float)f / 16.0f); const float ang = (float)p * inv;
        ((float*)(F.ws + WS_TAB))[2 * i] = cosf(ang); ((float*)(F.ws + WS_TAB))[2 * i + 1] = sinf(ang); }
    for (int i = gt; i < 256 * 8; i += NGT) { const int p = i / 8, f = i % 8; const float inv = powf(10000.0f, -(float)f / 8.0f); const float ang = (float)p * inv;
        ((float*)(F.ws + WS_TABC))[2 * i] = cosf(ang); ((float*)(F.ws + WS_TABC))[2 * i + 1] = sinf(ang); }
    if (gt < 2) { const int l = gt; const float* lq = F.in[I_LAMQK] + l * 128; float s0 = 0.f, s1 = 0.f;
        for (int i = 0; i < 32; ++i) { s0 += lq[i] * lq[32 + i]; s1 += lq[64 + i] * lq[96 + i]; }
        const float lam_init = 0.8f - 0.6f * expf(-0.3f * (float)l);
        float* sc = (float*)(F.ws + WS_SCAL); sc[4 * l] = expf(s0) - expf(s1) + lam_init; sc[4 * l + 1] = lam_init;
        float gq = 0.f, gk = 0.f; for (int i = 0; i < 64; ++i) { gq = fmaxf(gq, fabsf(F.in[I_AQG][l * 64 + i])); gk = fmaxf(gk, fabsf(F.in[I_AKG][l * 64 + i])); }
        sc[4 * l + 2] = fminf(8.0f * gq * gk * LOG2E * 1.01f + 0.01f, 100.0f); }
}

DI void phase_pro_b(const Frame& F) {
    const int gw = F.bid * NWAVES + F.wave, NGW = F.G * NWAVES;
    bf16* ACT = (bf16*)(F.ws + WS_ACT);
    for (int row = gw; row < NTOK; row += NGW) {
        const float* src = row < NLAT ? F.in[I_X] + (size_t)row * D : F.in[I_CTX] + (size_t)(row - NLAT) * D;
        f32x4 v[4]; load_row_f32(src, F.lane, v);
        const float rstd = rsqrtf(row_sumsq(v) * (1.0f / D) + RMS_EPS);
        const int r = mod_row(row);
        norm_mod(v, rstd, F.in[I_GPREMIX], modp(F, 0, r, 0), modp(F, 0, r, 1), F.lane);
        store_row_bf16(ACT + (size_t)row * D, F.lane, v);
    }
}

DI void rope8(float (&x)[8], int px, bool second, const float* tab) {
#pragma unroll
    for (int e = 0; e < 8; ++e) { const float p = __shfl_xor(x[e], px); const float c = tab[2 * e], s = tab[2 * e + 1]; x[e] = x[e] * c + (second ? p : -p) * s; }
}
DI void unpack8(const u32x4 w, float (&x)[8]) { x[0] = lo16(w.x); x[1] = hi16(w.x); x[2] = lo16(w.y); x[3] = hi16(w.y); x[4] = lo16(w.z); x[5] = hi16(w.z); x[6] = lo16(w.w); x[7] = hi16(w.w); }
DI u32x4 pack8(const float (&x)[8]) { u32x4 w; w.x = pk2(x[0], x[1]); w.y = pk2(x[2], x[3]); w.z = pk2(x[4], x[5]); w.w = pk2(x[6], x[7]); return w; }

DI void phase_post(const Frame& F, int l) {
    const bf16* PJ = (const bf16*)(F.ws + WS_PJ);
    bf16* QA = (bf16*)(F.ws + WS_QA); bf16* KA = (bf16*)(F.ws + WS_KA); bf16* VA = (bf16*)(F.ws + WS_VA);
    bf16* QC = (bf16*)(F.ws + WS_QC); bf16* KC = (bf16*)(F.ws + WS_KC); bf16* VC = (bf16*)(F.ws + WS_VC);
    bf16* Y = (bf16*)(F.ws + WS_Y);
    const float* tabA = (const float*)(F.ws + WS_TAB); const float* tabC = (const float*)(F.ws + WS_TABC);
    constexpr int DSTR = 264, VSTR = 136;
    LAS bf16* DIFF = (LAS bf16*)F.lds;
    LAS bf16* VCT = (LAS bf16*)(F.lds + 128 * DSTR * 2);
    const int lane = F.lane, w = F.wave;
    for (int u = F.bid; u < 260; u += F.G) {
        const bool is_ctx = u >= 256;
        int b, p0, row0, n;
        if (!is_ctx) { b = u / 128; p0 = (u % 128) * 128; row0 = b * SEQ + p0; n = SEQ; }
        else { const int cc = u - 256; b = cc / 2; p0 = (cc % 2) * 128; row0 = NLAT + b * CTXL + p0; n = CTXL; }
        const int seq0 = row0 - p0;
        float kmax2 = 0.f;
        for (int tt = 0; tt < 16; ++tt) {
            const int tl = 16 * w + tt, p = p0 + tl, row = row0 + tl;
            const int qpos = is_ctx ? SEQ + p : p, kpos = is_ctx ? p : CTXL + p;
            const int prow = p >> 6, pcol = p & 63;
            const bf16* pr = PJ + (size_t)row * PW;
            float x[8];
            {
                unpack8(*(const u32x4*)(pr + 8 * lane), x);
                float ss = 0.f;
#pragma unroll
                for (int e = 0; e < 8; ++e) ss += x[e] * x[e];
                ss += __shfl_xor(ss, 1); ss += __shfl_xor(ss, 2); ss += __shfl_xor(ss, 4);
                const int j8 = lane & 7;
                if (lane < 48) { const float rstd = rsqrtf(ss * (1.0f / 64.0f) + RMS_EPS); const float* g = (lane < 32 ? F.in[I_AQG] : F.in[I_AKG]) + l * 64 + 8 * j8;
#pragma unroll
                    for (int e = 0; e < 8; ++e) x[e] = x[e] * rstd * g[e]; }
                if (!is_ctx) { float xr[8];
#pragma unroll
                    for (int e = 0; e < 8; ++e) xr[e] = x[e];
                    rope8(xr, 2, (j8 & 2) != 0, tabA + ((size_t)((j8 & 4) ? pcol : prow) * 16 + 8 * (j8 & 1)) * 2);
                    if (lane < 48) {
#pragma unroll
                        for (int e = 0; e < 8; ++e) x[e] = xr[e]; } }
                if (lane < 32) {
#pragma unroll
                    for (int e = 0; e < 8; ++e) x[e] *= QA_SCALE; }
                bf16* dst;
                if (lane < 32) dst = QA + ((size_t)(b * 4 + (lane >> 3)) * QROWS + qpos) * 64 + 8 * j8;
                else if (lane < 48) dst = KA + ((size_t)(b * 2 + ((lane - 32) >> 3)) * KEYS + kpos) * 64 + 8 * j8;
                else dst = VA + ((size_t)(b * 2 + ((lane - 48) >> 3)) * KEYS + kpos) * 64 + 8 * j8;
                *(u32x4*)dst = pack8(x);
            }
            {
                const u32x4 own = *(const u32x4*)(pr + 512 + 8 * lane);
                unpack8(own, x);
                const int g = (lane >> 3) & 3, half = 1 << g;
                float acc[8];
#pragma unroll
                for (int e = 0; e < 8; ++e) acc[e] = 0.f;
                const int lo = max(p - half, 0), hi = min(p + half, n);
                for (int o = -8; o < 8; ++o) { const int q = p + o;
                    if (lane < 32 && q >= lo && q < hi) { float y[8]; unpack8(*(const u32x4*)(PJ + (size_t)(seq0 + q) * PW + 512 + 8 * lane), y);
#pragma unroll
                        for (int e = 0; e < 8; ++e) acc[e] += y[e]; } }
                if (lane < 32) { const float inv = 1.0f / (float)(hi - lo); float d[8];
#pragma unroll
                    for (int e = 0; e < 8; ++e) d[e] = acc[e] * inv - x[e];
                    *(LAS u32x4*)(DIFF + tl * DSTR + 8 * lane) = pack8(d); }
                const int j4 = lane & 3;
                if (!is_ctx) rope8(x, 1, (j4 & 1) != 0, tabC + ((size_t)((j4 & 2) ? pcol : prow) * 8) * 2);
                if (lane >= 32) {
#pragma unroll
                    for (int e = 0; e < 8; ++e) x[e] *= QC_SCALE;
                    const int hh = (lane - 32) >> 3;
                    *(u32x4*)(QC + ((size_t)(b * 4 + hh) * QROWS + qpos) * 64 + 8 * (lane & 7)) = pack8(x); }
            }
            {
                const u32x4 own = *(const u32x4*)(pr + 1024 + 8 * lane);
                unpack8(own, x);
                const int j4 = lane & 3;
                if (!is_ctx) { float xr[8];
#pragma unroll
                    for (int e = 0; e < 8; ++e) xr[e] = x[e];
                    rope8(xr, 1, (j4 & 1) != 0, tabC + ((size_t)((j4 & 2) ? pcol : prow) * 8) * 2);
                    if (lane < 32) {
#pragma unroll
                        for (int e = 0; e < 8; ++e) x[e] = xr[e]; } }
                { float n2 = 0.f;
#pragma unroll
                    for (int e = 0; e < 8; ++e) n2 += x[e] * x[e];
                    n2 += __shfl_xor(n2, 1); n2 += __shfl_xor(n2, 2); kmax2 = fmaxf(kmax2, n2); }
                if (lane < 32) { const int hh = lane >> 3;
                    *(u32x4*)(KC + ((size_t)(b * 4 + hh) * KEYS + kpos) * 64 + 8 * (lane & 7)) = pack8(x); }
                else { const int hh = (lane - 32) >> 3;
                    *(u32x4*)(VC + ((size_t)(b * 4 + hh) * KEYS + kpos) * 64 + 8 * (lane & 7)) = own; }
            }
            {
                unpack8(*(const u32x4*)(pr + 1536 + 8 * lane), x);
                float s = 0.f;
#pragma unroll
                for (int e = 0; e < 8; ++e) s += x[e];
                s += __shfl_xor(s, 1); s += __shfl_xor(s, 2); s += __shfl_xor(s, 4); s += __shfl_xor(s, 8); s += __shfl_xor(s, 16);
                const float mu = s * (1.0f / 256.0f); float q = 0.f;
#pragma unroll
                for (int e = 0; e < 8; ++e) { x[e] -= mu; q += x[e] * x[e]; }
                q += __shfl_xor(q, 1); q += __shfl_xor(q, 2); q += __shfl_xor(q, 4); q += __shfl_xor(q, 8); q += __shfl_xor(q, 16);
                const float rstd = rsqrtf(q * (1.0f / 256.0f) + LN_EPS);
                if (lane >= 32) {
#pragma unroll
                    for (int e = 0; e < 8; ++e) VCT[(8 * (lane - 32) + e) * VSTR + tl] = (bf16)f2bf(x[e] * rstd); }
            }
        }
        if (lane < 32 && (lane & 3) == 0) atomicMax((int*)(F.ws + WS_CTL) + CW_MAXK + 16 * (((l * 2 + b) * 4 + (lane >> 3)) * 2 + ((lane >> 2) & 1)), __float_as_int(kmax2));
        LDS_WAIT(); __syncthreads();
        {
            const bf16* PWt = (const bf16*)(F.ws + WS_POOLW) + (size_t)l * 4 * 4096;
            const int fr = lane & 15, fq = lane >> 4;
#pragma unroll 1
            for (int g = 0; g < 4; ++g) {
                bf16x8 a[2];
#pragma unroll
                for (int ks = 0; ks < 2; ++ks) a[ks] = *(const LAS bf16x8*)(DIFF + (16 * w + fr) * DSTR + 64 * g + 32 * ks + 8 * fq);
#pragma unroll
                for (int nb = 0; nb < 4; ++nb) {
                    f32x4 acc = {0.f, 0.f, 0.f, 0.f};
#pragma unroll
                    for (int ks = 0; ks < 2; ++ks) { const bf16x8 bb = *(const bf16x8*)(PWt + (size_t)g * 4096 + (16 * nb + fr) * 64 + 32 * ks + 8 * fq);
                        acc = __builtin_amdgcn_mfma_f32_16x16x32_bf16(a[ks], bb, acc, 0, 0, 0); }
                    const int ch = 64 * g + 16 * nb + fr; const float sc = F.in[I_POOLS][l * 256 + ch];
#pragma unroll
                    for (int r = 0; r < 4; ++r) Y[(size_t)(row0 + 16 * w + 4 * fq + r) * D + 256 + ch] = (bf16)f2bf(acc[r] * sc);
                }
            }
        }
        {
            const bf16* SW = (const bf16*)(F.ws + WS_SGUW) + (size_t)l * 4 * 16384;
            const int fr = lane & 15, fq = lane >> 4;
#pragma unroll 1
            for (int h = 0; h < 4; ++h) {
                bf16x8 a[4];
#pragma unroll
                for (int ks = 0; ks < 4; ++ks) a[ks] = *(const bf16x8*)(SW + (size_t)h * 16384 + (16 * w + fr) * 128 + 32 * ks + 8 * fq);
#pragma unroll
                for (int nb = 0; nb < 4; ++nb) {
                    f32x4 acc = {0.f, 0.f, 0.f, 0.f};
                    const int ch = 64 * h + 16 * nb + fr;
#pragma unroll
                    for (int ks = 0; ks < 4; ++ks) { const bf16x8 bb = *(const LAS bf16x8*)(VCT + ch * VSTR + 32 * ks + 8 * fq);
                        acc = __builtin_amdgcn_mfma_f32_16x16x32_bf16(a[ks], bb, acc, 0, 0, 0); }
#pragma unroll
                    for (int r = 0; r < 4; ++r) { const int pp = 16 * w + 4 * fq + r; const float sv = acc[r] + F.in[I_SGUB][(l * 4 + h) * 128 + pp];
                        const float uu = bf2f(PJ[(size_t)(row0 + pp) * PW + 1536 + ch]);
                        Y[(size_t)(row0 + pp) * D + 768 + ch] = (bf16)f2bf(uu * sv); }
                }
            }
        }
        __syncthreads();
    }
}

template <int QD>
DI void attn_naive_pass(const Frame& F, const bf16* Qrow, const bf16* Kb, const bf16* Vb, int nkeys, float (&o)[64]) {
    LAS float* Ks = (LAS float*)F.lds;
    LAS float* Vs = (LAS float*)(F.lds + 2 * 64 * QD * 4);
    LAS float* MG = (LAS float*)(F.lds + 65536);
    const int r = F.tid & 255, half = F.tid >> 8;
    float q[QD];
#pragma unroll
    for (int i = 0; i < QD / 8; ++i) { float x[8]; unpack8(*(const u32x4*)(Qrow + 8 * i), x);
#pragma unroll
        for (int e = 0; e < 8; ++e) q[8 * i + e] = x[e]; }
#pragma unroll
    for (int d = 0; d < 64; ++d) o[d] = 0.f;
    float m = -1e30f, lsum = 0.f;
    const int kh = nkeys / 2, kbeg = half * kh, ntile = kh / 64;
    for (int t = 0; t < ntile; ++t) {
        __syncthreads();
        const int key0 = kbeg + t * 64;
        for (int pc = r; pc < 64 * QD / 8; pc += 256) { const int kk = pc / (QD / 8), c = pc % (QD / 8); float x[8]; unpack8(*(const u32x4*)(Kb + (size_t)(key0 + kk) * 64 + 8 * c), x);
#pragma unroll
            for (int e = 0; e < 8; ++e) Ks[(half * 64 + kk) * QD + 8 * c + e] = x[e]; }
        for (int pc = r; pc < 512; pc += 256) { const int kk = pc / 8, c = pc % 8; float x[8]; unpack8(*(const u32x4*)(Vb + (size_t)(key0 + kk) * 64 + 8 * c), x);
#pragma unroll
            for (int e = 0; e < 8; ++e) Vs[(half * 64 + kk) * 64 + 8 * c + e] = x[e]; }
        __syncthreads();
#pragma unroll 2
        for (int j = 0; j < 64; ++j) {
            const LAS float* kr = Ks + (half * 64 + j) * QD; float s = 0.f;
#pragma unroll
            for (int d = 0; d < QD; ++d) s += q[d] * kr[d];
            if (s > m) { const float a = exp2f(m - s); lsum *= a;
#pragma unroll
                for (int d = 0; d < 64; ++d) o[d] *= a;
                m = s; }
            const float pp = exp2f(s - m); lsum += pp;
            const LAS float* vr = Vs + (half * 64 + j) * 64;
#pragma unroll
            for (int d = 0; d < 64; ++d) o[d] += pp * vr[d];
        }
    }
    __syncthreads();
    if (half == 1) { MG[r * 66] = m; MG[r * 66 + 1] = lsum;
#pragma unroll
        for (int d = 0; d < 64; ++d) MG[r * 66 + 2 + d] = o[d]; }
    __syncthreads();
    if (half == 0) { const float m1 = MG[r * 66], l1 = MG[r * 66 + 1]; const float mm = fmaxf(m, m1); const float a0 = exp2f(m - mm), a1 = exp2f(m1 - mm);
        const float inv = 1.0f / (lsum * a0 + l1 * a1);
#pragma unroll
        for (int d = 0; d < 64; ++d) o[d] = (o[d] * a0 + MG[r * 66 + 2 + d] * a1) * inv; }
    __syncthreads();
}
DI void phase_attn_naive(const Frame& F, int l) {
    const bf16* QA = (const bf16*)(F.ws + WS_QA); const bf16* KA = (const bf16*)(F.ws + WS_KA); const bf16* VA = (const bf16*)(F.ws + WS_VA);
    const bf16* QC = (const bf16*)(F.ws + WS_QC); const bf16* KC = (const bf16*)(F.ws + WS_KC); const bf16* VC = (const bf16*)(F.ws + WS_VC);
    bf16* Y = (bf16*)(F.ws + WS_Y);
    const float lam = ((const float*)(F.ws + WS_SCAL))[4 * l], lam_init = ((const float*)(F.ws + WS_SCAL))[4 * l + 1];
    const int r = F.tid & 255, half = F.tid >> 8;
    const int nqt = (l == 0) ? 65 : 64;
    const int nunits = 2 * NB * 4 * nqt;
    for (int u = F.bid; u < nunits; u += F.G) {
        const int kind = u / (NB * 4 * nqt), v = u % (NB * 4 * nqt), qt = v % nqt, bh = v / nqt, b = bh / 4, h = bh % 4;
        const int nkeys = (qt == 64) ? CTXL : KEYS;
        const int qpos = qt * 256 + r;
        const int orow = (qt == 64) ? NLAT + b * CTXL + r : b * SEQ + qt * 256 + r;
        float o[64];
        if (kind == 0) {
            attn_naive_pass<64>(F, QA + ((size_t)(b * 4 + h) * QROWS + qpos) * 64, KA + (size_t)(b * 2 + h / 2) * KEYS * 64, VA + (size_t)(b * 2 + h / 2) * KEYS * 64, nkeys, o);
            if (half == 0) {
#pragma unroll
                for (int i = 0; i < 8; ++i) { float x[8];
#pragma unroll
                    for (int e = 0; e < 8; ++e) x[e] = o[8 * i + e];
                    *(u32x4*)(Y + (size_t)orow * D + h * 64 + 8 * i) = pack8(x); } }
        } else {
            float o0[64];
            attn_naive_pass<32>(F, QC + ((size_t)(b * 4 + h) * QROWS + qpos) * 64, KC + (size_t)(b * 4 + h) * KEYS * 64, VC + (size_t)(b * 4 + h) * KEYS * 64, nkeys, o0);
            attn_naive_pass<32>(F, QC + ((size_t)(b * 4 + h) * QROWS + qpos) * 64 + 32, KC + (size_t)(b * 4 + h) * KEYS * 64 + 32, VC + (size_t)(b * 4 + h) * KEYS * 64, nkeys, o);
            if (half == 0) { float ss = 0.f;
#pragma unroll
                for (int d = 0; d < 64; ++d) { o[d] = o0[d] - lam * o[d]; ss += o[d] * o[d]; }
                const float rstd = rsqrtf(ss * (1.0f / 64.0f) + RMS_EPS) * (1.0f - lam_init);
#pragma unroll
                for (int i = 0; i < 8; ++i) { float x[8];
#pragma unroll
                    for (int e = 0; e < 8; ++e) x[e] = o[8 * i + e] * rstd * F.in[I_CSUBLN][l * 64 + 8 * i + e];
                    *(u32x4*)(Y + (size_t)orow * D + 512 + h * 64 + 8 * i) = pack8(x); } }
        }
    }
}


typedef float f32x16 __attribute__((ext_vector_type(16)));
typedef short s16x4 __attribute__((ext_vector_type(4)));
typedef __bf16 bf16x2_t __attribute__((ext_vector_type(2)));
DI unsigned cvtpk_s(float lo, float hi) { f32x2 v = {lo, hi}; bf16x2_t b = __builtin_convertvector(v, bf16x2_t); return __builtin_bit_cast(unsigned, b); }
DI s16x4 vtr(const LAS unsigned char* p) { return __builtin_bit_cast(s16x4, __builtin_amdgcn_ds_read_tr16_b64_v4i16((LAS s16x4*)p)); }
constexpr int ATT_KSTR = 144, ATT_KB = 64 * ATT_KSTR, ATT_VB = 64 * 128, ATT_BUF = ATT_KB + ATT_VB;
DI void softmax_block(const f32x16& S, float& lsum, bf16x8 (&P)[2]) {
    float p[16];
#pragma unroll
    for (int r = 0; r < 16; ++r) { p[r] = __builtin_amdgcn_exp2f(S[r]); lsum += p[r]; }
#pragma unroll
    for (int st = 0; st < 2; ++st) { u32x4 w; w.x = cvtpk_s(p[8 * st + 0], p[8 * st + 1]); w.y = cvtpk_s(p[8 * st + 2], p[8 * st + 3]); w.z = cvtpk_s(p[8 * st + 4], p[8 * st + 5]); w.w = cvtpk_s(p[8 * st + 6], p[8 * st + 7]);
        P[st] = __builtin_bit_cast(bf16x8, w); }
}
DI void pv_tile(f32x16 (&O)[2], const LAS unsigned char* vbase0, const LAS unsigned char* vbase1, const bf16x8 (&P0)[2], const bf16x8 (&P1)[2]) {
#pragma unroll
    for (int kb = 0; kb < 2; ++kb)
#pragma unroll
        for (int st = 0; st < 2; ++st) {
            const int ro = (32 * kb + 16 * st) * 128;
            const s16x4 a0 = vtr(vbase0 + ro), a1 = vtr(vbase0 + ro + 8 * 128), b0 = vtr(vbase1 + ro), b1 = vtr(vbase1 + ro + 8 * 128);
            const bf16x8 v0 = {a0[0], a0[1], a0[2], a0[3], a1[0], a1[1], a1[2], a1[3]}, v1 = {b0[0], b0[1], b0[2], b0[3], b1[0], b1[1], b1[2], b1[3]};
            const bf16x8 pp = kb == 0 ? P0[st] : P1[st];
            O[0] = __builtin_amdgcn_mfma_f32_32x32x16_bf16(v0, pp, O[0], 0, 0, 0);
            O[1] = __builtin_amdgcn_mfma_f32_32x32x16_bf16(v1, pp, O[1], 0, 0, 0);
        }
}
template <int KIND>
DI void attn_unit(const Frame& F, const bf16* Qb, const bf16* Kb, const bf16* Vb, int ntiles, float bound_in, bf16* Yb, float lam, const float* gain, float post) {
    const int lane = F.lane, w = F.wave, tid = F.tid, q32 = lane & 31, h = lane >> 5;
    LAS unsigned char* lds = F.lds;
    bf16x8 qf[4];
#pragma unroll
    for (int kk = 0; kk < 4; ++kk) qf[kk] = *(const bf16x8*)(Qb + (size_t)(32 * w + q32) * 64 + 16 * kk + 8 * h);
    float bound = bound_in;
    if (KIND == 1) {
        float n0 = 0.f, n1 = 0.f;
#pragma unroll
        for (int kk = 0; kk < 4; ++kk)
#pragma unroll
            for (int e = 0; e < 8; ++e) { const float v = bf2f((unsigned short)qf[kk][e]); if (kk < 2) n0 += v * v; else n1 += v * v; }
        n0 += __shfl_xor(n0, 32); n1 += __shfl_xor(n1, 32);
        bound = sqrtf(fmaxf(n0, n1)) * bound_in * 1.01f + 0.01f;
    }
    f32x16 cinit;
#pragma unroll
    for (int r = 0; r < 16; ++r) cinit[r] = -bound;
    asm volatile("" : "+v"(cinit));
    f32x16 O0[2], O1[2];
#pragma unroll
    for (int db = 0; db < 2; ++db)
#pragma unroll
        for (int r = 0; r < 16; ++r) { O0[db][r] = 0.f; O1[db][r] = 0.f; }
    float l0 = 0.f, l1 = 0.f;
    const int srow = tid >> 3, sc = tid & 7;
    const unsigned kw = (unsigned)(srow * ATT_KSTR + sc * 16), vw = (unsigned)(ATT_KB + srow * 128 + ((sc ^ (((srow >> 1) & 1) << 2)) * 16));
    const bf16* kg = Kb + (size_t)srow * 64 + sc * 8; const bf16* vg = Vb + (size_t)srow * 64 + sc * 8;
    const unsigned kr = (unsigned)(q32 * ATT_KSTR + 16 * h);
    const int qq = (lane & 15) >> 2, pp4 = lane & 3, dsub = (lane >> 4) & 1, sw = (qq >> 1) & 1;
    const unsigned vr0 = (unsigned)(ATT_KB + (4 * h + qq) * 128 + ((0 ^ sw) * 64) + (16 * dsub + 4 * pp4) * 2);
    const unsigned vr1 = (unsigned)(ATT_KB + (4 * h + qq) * 128 + ((1 ^ sw) * 64) + (16 * dsub + 4 * pp4) * 2);
    u32x4 kreg = *(const u32x4*)kg, vreg = *(const u32x4*)vg;
    *(LAS u32x4*)(lds + kw) = kreg; *(LAS u32x4*)(lds + vw) = vreg;
    if (ntiles > 1) { kreg = *(const u32x4*)(kg + 64 * 64); vreg = *(const u32x4*)(vg + 64 * 64); }
#pragma unroll 1
    for (int t = 0; t < ntiles; ++t) {
        __syncthreads();
        const unsigned cb = (unsigned)((t & 1) * ATT_BUF), nb = (unsigned)(((t + 1) & 1) * ATT_BUF);
        if (t + 1 < ntiles) {
            *(LAS u32x4*)(lds + nb + kw) = kreg; *(LAS u32x4*)(lds + nb + vw) = vreg;
            if (t + 2 < ntiles) { kreg = *(const u32x4*)(kg + (size_t)(t + 2) * 64 * 64); vreg = *(const u32x4*)(vg + (size_t)(t + 2) * 64 * 64); }
        }
        const LAS unsigned char* kp = lds + cb + kr;
        if (KIND == 0) {
            f32x16 S0 = cinit, S1 = cinit;
#pragma unroll
            for (int kk = 0; kk < 4; ++kk) {
                const bf16x8 a0 = *(const LAS bf16x8*)(kp + 32 * kk), a1 = *(const LAS bf16x8*)(kp + 32 * ATT_KSTR + 32 * kk);
                S0 = __builtin_amdgcn_mfma_f32_32x32x16_bf16(a0, qf[kk], S0, 0, 0, 0);
                S1 = __builtin_amdgcn_mfma_f32_32x32x16_bf16(a1, qf[kk], S1, 0, 0, 0);
            }
            bf16x8 P0[2], P1[2];
            softmax_block(S0, l0, P0); softmax_block(S1, l0, P1);
            pv_tile(O0, lds + cb + vr0, lds + cb + vr1, P0, P1);
        } else {
#pragma unroll
            for (int c = 0; c < 2; ++c) {
                f32x16 S0 = cinit, S1 = cinit;
#pragma unroll
                for (int k2 = 0; k2 < 2; ++k2) { const int kk = 2 * c + k2;
                    const bf16x8 a0 = *(const LAS bf16x8*)(kp + 32 * kk), a1 = *(const LAS bf16x8*)(kp + 32 * ATT_KSTR + 32 * kk);
                    S0 = __builtin_amdgcn_mfma_f32_32x32x16_bf16(a0, qf[kk], S0, 0, 0, 0);
                    S1 = __builtin_amdgcn_mfma_f32_32x32x16_bf16(a1, qf[kk], S1, 0, 0, 0);
                }
                bf16x8 P0[2], P1[2];
                if (c == 0) { softmax_block(S0, l0, P0); softmax_block(S1, l0, P1); pv_tile(O0, lds + cb + vr0, lds + cb + vr1, P0, P1); }
                else { softmax_block(S0, l1, P0); softmax_block(S1, l1, P1); pv_tile(O1, lds + cb + vr0, lds + cb + vr1, P0, P1); }
                __builtin_amdgcn_sched_barrier(0);
            }
        }
    }
    l0 += __shfl_xor(l0, 32);
    bf16* yrow = Yb + (size_t)(32 * w + q32) * D;
    if (KIND == 0) {
        const float inv = 1.0f / l0;
#pragma unroll
        for (int db = 0; db < 2; ++db)
#pragma unroll
            for (int g = 0; g < 4; ++g) { u32x2 o; o.x = pk2(O0[db][4 * g] * inv, O0[db][4 * g + 1] * inv); o.y = pk2(O0[db][4 * g + 2] * inv, O0[db][4 * g + 3] * inv);
                *(u32x2*)(yrow + 32 * db + 8 * g + 4 * h) = o; }
    } else {
        l1 += __shfl_xor(l1, 32);
        const float i0 = 1.0f / l0, i1 = lam / l1; float ss = 0.f;
#pragma unroll
        for (int db = 0; db < 2; ++db)
#pragma unroll
            for (int r = 0; r < 16; ++r) { const float v = O0[db][r] * i0 - O1[db][r] * i1; O0[db][r] = v; ss += v * v; }
        ss += __shfl_xor(ss, 32);
        const float rstd = rsqrtf(ss * (1.0f / 64.0f) + RMS_EPS) * post;
#pragma unroll
        for (int db = 0; db < 2; ++db)
#pragma unroll
            for (int g = 0; g < 4; ++g) { const f32x4 gg = *(const f32x4*)(gain + 32 * db + 8 * g + 4 * h); u32x2 o;
                o.x = pk2(O0[db][4 * g] * rstd * gg[0], O0[db][4 * g + 1] * rstd * gg[1]); o.y = pk2(O0[db][4 * g + 2] * rstd * gg[2], O0[db][4 * g + 3] * rstd * gg[3]);
                *(u32x2*)(yrow + 32 * db + 8 * g + 4 * h) = o; }
    }
    __syncthreads();
}
DI void phase_attn(const Frame& F, int l) {
    const bf16* QA = (const bf16*)(F.ws + WS_QA); const bf16* KA = (const bf16*)(F.ws + WS_KA); const bf16* VA = (const bf16*)(F.ws + WS_VA);
    const bf16* QC = (const bf16*)(F.ws + WS_QC); const bf16* KC = (const bf16*)(F.ws + WS_KC); const bf16* VC = (const bf16*)(F.ws + WS_VC);
    bf16* Y = (bf16*)(F.ws + WS_Y);
    const float* sc = (const float*)(F.ws + WS_SCAL);
    const float lam = sc[4 * l], lam_init = sc[4 * l + 1], boundA = sc[4 * l + 2];
    const int* MAXK = (const int*)(F.ws + WS_CTL) + CW_MAXK;
    const int nmain = 2 * NB * 4 * 64, nctx = (l == 0) ? 2 * NB * 4 : 0;
    for (int u = F.bid; u < nmain + nctx; u += F.G) {
        int kind, b, h, qt;
        if (u < nmain) { kind = u / (NB * 4 * 64); const int v = u % (NB * 4 * 64); b = v / 256; h = (v / 64) % 4; qt = v % 64; }
        else { const int v = u - nmain; kind = v / (NB * 4); b = (v / 4) % NB; h = v % 4; qt = 64; }
        const int ntiles = (qt == 64) ? CTXL / 64 : KEYS / 64;
        const int orow0 = (qt == 64) ? NLAT + b * CTXL : b * SEQ + qt * 256;
        if (kind == 0) attn_unit<0>(F, QA + ((size_t)(b * 4 + h) * QROWS + qt * 256) * 64, KA + (size_t)(b * 2 + h / 2) * KEYS * 64, VA + (size_t)(b * 2 + h / 2) * KEYS * 64, ntiles, boundA,
                                    Y + (size_t)orow0 * D + h * 64, 0.f, nullptr, 0.f);
        else { const int mi = ((l * 2 + b) * 4 + h) * 2; const float mk = sqrtf(fmaxf(__int_as_float(MAXK[16 * mi]), __int_as_float(MAXK[16 * (mi + 1)])));
            attn_unit<1>(F, QC + ((size_t)(b * 4 + h) * QROWS + qt * 256) * 64, KC + (size_t)(b * 4 + h) * KEYS * 64, VC + (size_t)(b * 4 + h) * KEYS * 64, ntiles, mk,
                         Y + (size_t)orow0 * D + 512 + h * 64, lam, F.in[I_CSUBLN] + l * 64, 1.0f - lam_init); }
    }
}

DI void phase_route(const Frame& F, int l, int ntok) {
    constexpr int TSTR = 1032;
    LAS float* TK = (LAS float*)F.lds;
    LAS float* LG = (LAS float*)(F.lds + 32 * TSTR * 4);
    const int lane = F.lane, w = F.wave;
    const bf16* Z = (const bf16*)(F.ws + WS_Z); bf16* T = (bf16*)(F.ws + WS_ACT);
    float* XC = (float*)(F.ws + WS_XC); float* RINFO = (float*)(F.ws + WS_RINFO); int* LISTS = (int*)(F.ws + WS_LISTS);
    unsigned* CNT = (unsigned*)(F.ws + WS_CTL) + CW_CNT;
    const int chunk = ntok / NCHUNK;
    const float* RW = F.in[I_ROUTERW] + (size_t)l * D * NEXP;
    for (int grp = F.bid; grp < ntok / 32; grp += F.G) {
        for (int tt = 0; tt < 4; ++tt) {
            const int ti = 4 * w + tt, row = grp * 32 + ti, r = mod_row(row);
            const float* src = row < NLAT ? (l == 0 ? F.in[I_X] : F.out) + (size_t)row * D : (l == 0 ? F.in[I_CTX] : XC) + (size_t)(row - NLAT) * D;
            float* dst = row < NLAT ? F.out + (size_t)row * D : XC + (size_t)(row - NLAT) * D;
            f32x4 z[4], x[4]; load_row_bf16(Z + (size_t)row * D, lane, z); load_row_f32(src, lane, x);
            const float rz = rsqrtf(row_sumsq(z) * (1.0f / D) + RMS_EPS);
            const float* gate = modp(F, l, r, 2); const float* gp = F.in[I_GPOSTMIX] + l * D;
#pragma unroll
            for (int j = 0; j < 4; ++j) { const int c = 4 * lane + 256 * j; x[j] = x[j] + *(const f32x4*)(gate + c) * (z[j] * rz * *(const f32x4*)(gp + c)); }
            store_row_f32(dst, lane, x);
            const float rx = rsqrtf(row_sumsq(x) * (1.0f / D) + RMS_EPS);
            norm_mod(x, rx, F.in[I_GPREFFN] + l * D, modp(F, l, r, 3), modp(F, l, r, 4), lane);
            store_row_bf16(T + (size_t)row * D, lane, x);
#pragma unroll
            for (int j = 0; j < 4; ++j) *(LAS f32x4*)(TK + ti * TSTR + 4 * lane + 256 * j) = x[j];
        }
        LDS_WAIT(); __syncthreads();
        {
            const int tb = w & 1, eb = w >> 1, fr = lane & 15, fq = lane >> 4;
            f32x4 acc = {0.f, 0.f, 0.f, 0.f};
            const LAS float* ap = TK + (16 * tb + fr) * TSTR + fq; const float* bp = RW + (size_t)fq * NEXP + 16 * eb + fr;
#pragma unroll 8
            for (int k0 = 0; k0 < D; k0 += 4) acc = __builtin_amdgcn_mfma_f32_16x16x4f32(ap[k0], bp[(size_t)k0 * NEXP], acc, 0, 0, 0);
#pragma unroll
            for (int rr = 0; rr < 4; ++rr) LG[(16 * tb + 4 * fq + rr) * 64 + 16 * eb + fr] = acc[rr];
        }
        LDS_WAIT(); __syncthreads();
        for (int tt = 0; tt < 4; ++tt) {
            const int ti = 4 * w + tt, row = grp * 32 + ti;
            const float logit = LG[ti * 64 + lane];
            const float score = 1.0f / (1.0f + __expf(-logit));
            const float sel = score + F.in[I_ROUTERB][l * NEXP + lane];
            float m1 = sel; m1 = fmaxf(m1, __shfl_xor(m1, 1)); m1 = fmaxf(m1, __shfl_xor(m1, 2)); m1 = fmaxf(m1, __shfl_xor(m1, 4));
            int i1 = (sel == m1) ? (lane & 7) : 8; i1 = min(i1, __shfl_xor(i1, 1)); i1 = min(i1, __shfl_xor(i1, 2)); i1 = min(i1, __shfl_xor(i1, 4));
            float s2 = ((lane & 7) == i1) ? -INFINITY : sel; s2 = fmaxf(s2, __shfl_xor(s2, 1)); s2 = fmaxf(s2, __shfl_xor(s2, 2)); s2 = fmaxf(s2, __shfl_xor(s2, 4));
            const float gs = m1 + s2; const int g = lane >> 3;
            int grank = 0;
#pragma unroll
            for (int g2 = 0; g2 < 8; ++g2) { const float o = __shfl(gs, 8 * g2); grank += (o > gs || (o == gs && g2 < g)) ? 1 : 0; }
            const float msel = (grank < 4) ? sel : -INFINITY;
            int rank = 0;
            for (int l2 = 0; l2 < 64; ++l2) { const float o = __shfl(msel, l2); rank += (o > msel || (o == msel && l2 < lane)) ? 1 : 0; }
            const bool chosen = (rank < TOPK) && (grank < 4);
            const float wsum = wave_sum(chosen ? score : 0.f);
            if (chosen) {
                const int c = row / chunk;
                const unsigned slot = atomicAdd(CNT + 16 * ((l * NCHUNK + c) * NEXP + lane), 1u);
                if (slot < (unsigned)LCAP) LISTS[(size_t)(c * NEXP + lane) * LCAP + slot] = row * 8 + rank;
                RINFO[(size_t)row * 8 + rank] = score / wsum * 2.5f;
            }
        }
        __syncthreads();
    }
}

struct MoeSched {
    const LAS int* pre; const LAS int* cnt; const LAS int* hsb;
    int ng, nct, G, c, K; int g0;
    const char* A; const char* Wr; const char* Wsh; size_t wstride; const int* lists;
    bool gatherA; int shared_grp;
    DI bool next(int i, pg8::Unit& u) const {
        const long L = (long)i * G + c; const int total = __builtin_amdgcn_readfirstlane(pre[ng]) * nct; if (L >= total) return false;
        const int tile = (int)(L / nct), ct = (int)(L % nct);
        int lo = 0, hi = ng;
        while (hi - lo > 1) { const int mid = (lo + hi) >> 1; if (__builtin_amdgcn_readfirstlane(pre[mid]) <= tile) lo = mid; else hi = mid; }
        const int g = lo, rt = tile - __builtin_amdgcn_readfirstlane(pre[g]);
        const int cg = __builtin_amdgcn_readfirstlane(cnt[g]), hb = __builtin_amdgcn_readfirstlane(hsb[g]);
        const bool sh = (g == shared_grp);
        u.pn = ct; u.nvalid = min(cg - rt * 256, 256); u.aux = g;
        u.rows = sh ? nullptr : lists + (size_t)(g0 + g) * LCAP + rt * 256;
        const char* Wb = sh ? Wsh : Wr + (size_t)((g0 + g) % NEXP) * wstride;
        u.B = Wb + (size_t)ct * 256 * K * 2;
        if (gatherA) { u.A = sh ? A + (size_t)rt * 256 * K * 2 : A; u.orow0 = hb + rt * 256; }
        else { u.A = A + (size_t)(hb + rt * 256) * K * 2; u.orow0 = rt * 256; }
        return true;
    }
};
DI void moe_tables(const Frame& F, int l, int ntok, int gbeg, int n, bool with_shared, LAS int* pre, LAS int* cnt, LAS int* hsb, LAS int* tmp) {
    const unsigned* CNT = (const unsigned*)(F.ws + WS_CTL) + CW_CNT;
    __syncthreads();
    if (F.tid < NCHUNK * NEXP) tmp[F.tid] = (int)min(__hip_atomic_load(CNT + 16 * (l * NCHUNK * NEXP + F.tid), __ATOMIC_RELAXED, __HIP_MEMORY_SCOPE_AGENT), (unsigned)LCAP);
    __syncthreads();
    if (F.tid == 0) {
        int hs = 0, p = 0;
        for (int g = 0; g < NCHUNK * NEXP; ++g) {
            const int c = tmp[g];
            const int tiles = (c + 255) >> 8;
            if (g >= gbeg && g < gbeg + n) { pre[g - gbeg] = p; cnt[g - gbeg] = c; hsb[g - gbeg] = hs; p += tiles; }
            hs += tiles * 256;
        }
        if (with_shared) { pre[n] = p; cnt[n] = ntok; hsb[n] = HS_SH_BASE; p += ntok / 256; pre[n + 1] = p; }
        else pre[n] = p;
    }
    __syncthreads();
}

DI void phase_combine(const Frame& F, int l, int ntok, int c) {
    const int gw = F.bid * NWAVES + F.wave, NGW = F.G * NWAVES, lane = F.lane;
    const int chunk = ntok / NCHUNK;
    const bf16* OUT2 = (const bf16*)(F.ws + WS_OUT2); const bf16* F0 = (const bf16*)(F.ws + WS_F0); const float* RINFO = (const float*)(F.ws + WS_RINFO);
    float* XC = (float*)(F.ws + WS_XC); bf16* ACT = (bf16*)(F.ws + WS_ACT);
    for (int i = gw; i < chunk; i += NGW) {
        const int row = c * chunk + i, r = mod_row(row);
        f32x4 f[4]; load_row_bf16(F0 + (size_t)row * D, lane, f);
#pragma unroll
        for (int k = 0; k < TOPK; ++k) { const float wk = RINFO[(size_t)row * 8 + k]; f32x4 o[4]; load_row_bf16(OUT2 + ((size_t)i * 8 + k) * D, lane, o);
#pragma unroll
            for (int j = 0; j < 4; ++j) f[j] += wk * o[j]; }
        const float rf = rsqrtf(row_sumsq(f) * (1.0f / D) + RMS_EPS);
        float* xp = row < NLAT ? F.out + (size_t)row * D : XC + (size_t)(row - NLAT) * D;
        f32x4 x[4]; load_row_f32(xp, lane, x);
        const float* gate = modp(F, l, r, 5); const float* gp = F.in[I_GPOSTFFN] + l * D;
#pragma unroll
        for (int j = 0; j < 4; ++j) { const int cc = 4 * lane + 256 * j; x[j] = x[j] + *(const f32x4*)(gate + cc) * (f[j] * rf * *(const f32x4*)(gp + cc)); }
        store_row_f32(xp, lane, x);
        if (l == 0) {
            const float rx = rsqrtf(row_sumsq(x) * (1.0f / D) + RMS_EPS);
            norm_mod(x, rx, F.in[I_GPREMIX] + D, modp(F, 1, r, 0), modp(F, 1, r, 1), lane);
            store_row_bf16(ACT + (size_t)row * D, lane, x);
        }
    }
}

constexpr int PH_PRO_A = 0, PH_PRO_B = 1, PH_L0 = 2, PH_PER_LAYER = 14, N_PHASES = PH_L0 + 2 * PH_PER_LAYER;
__global__ void __launch_bounds__(NTHREADS, 2) fwd(Args args) {
    extern __shared__ __attribute__((aligned(16))) unsigned char lds_raw[];
    Frame F;
    F.lds = (LAS unsigned char*)lds_raw;
    F.tid = threadIdx.x; F.lane = F.tid & 63; F.wave = __builtin_amdgcn_readfirstlane(F.tid >> 6);
    F.G = gridDim.x; F.bid = blockIdx.x; F.in = args.in; F.out = args.out; F.ws = args.ws;
    volatile LAS unsigned* MISC = (volatile LAS unsigned*)(F.lds + MISC_OFF);
    for (int u = F.tid; u < (LDS_BYTES - LDSCTL_OFF) / 4; u += NTHREADS) ((LAS unsigned*)(F.lds + LDSCTL_OFF))[u] = 0u;
    __syncthreads();
    const int lo = args.ph_lo, hi = args.ph_hi;
    XcdBarrier bar; bar.bar = (unsigned*)(F.ws + WS_CTL) + CW_BAR; bar.x = 0; bar.st = nullptr;
    if (hi - lo > 1) bar = xcd_barrier_post((unsigned*)(F.ws + WS_CTL) + CW_BAR, MISC + 8);
#ifndef EN_MASK
#define EN_MASK 0x3ff
#endif
#define EN(b) (((EN_MASK) >> (b)) & 1)
#define IN(k) (lo <= (k) && (k) < hi)
#define SEAM(k) do { if (IN(k) && IN((k) + 1)) xcd_barrier(bar); } while (0)
    LAS int* TPRE = (LAS int*)(F.lds + TBL_OFF); LAS int* TCNT = TPRE + 272; LAS int* THSB = TCNT + 272; LAS int* TTMP = THSB + 272;

    if (EN(0) && IN(PH_PRO_A)) { const Frame P_ = fresh(F); phase_pro_a(P_); } SEAM(PH_PRO_A);
    if (EN(1) && IN(PH_PRO_B)) { const Frame P_ = fresh(F); phase_pro_b(P_); } SEAM(PH_PRO_B);
#pragma unroll 1
    for (int l = 0; l < 2; ++l) {
        const int P = PH_L0 + l * PH_PER_LAYER;
        const int ntok = (l == 0) ? NTOK : NLAT;
        if (EN(2) && IN(P + 0)) {
            const Frame Q = fresh(F);
            pg8::DenseOrder S; S.init((const bf16*)(Q.ws + WS_ACT), (const bf16*)(Q.ws + WS_WIN) + (size_t)l * PW * D, NTOK, PW, D, Q.G, Q.bid);
            pg8::EpiBf16 E{(bf16*)(Q.ws + WS_PJ), PW};
            pg8::gemm_phase<pg8::EpiBf16, pg8::DenseOrder, false>(Q.lds, Q.tid, D, S, E);
        } SEAM(P + 0);
        if (EN(3) && IN(P + 1)) { const Frame P_ = fresh(F); phase_post(P_, l); } SEAM(P + 1);
        if (EN(4) && IN(P + 2)) { const Frame P_ = fresh(F);
#if ATTN_NAIVE
            phase_attn_naive(P_, l);
#else
            phase_attn(P_, l);
#endif
        } SEAM(P + 2);
        if (EN(5) && IN(P + 3)) {
            const Frame Q = fresh(F);
            pg8::DenseOrder S; S.init((const bf16*)(Q.ws + WS_Y), (const bf16*)(Q.ws + WS_WOUT) + (size_t)l * D * D, ntok, D, D, Q.G, Q.bid);
            pg8::EpiBf16 E{(bf16*)(Q.ws + WS_Z), D};
            pg8::gemm_phase<pg8::EpiBf16, pg8::DenseOrder, false>(Q.lds, Q.tid, D, S, E);
        } SEAM(P + 3);
        if (EN(6) && IN(P + 4)) { const Frame P_ = fresh(F); phase_route(P_, l, ntok); } SEAM(P + 4);
        if (EN(7) && IN(P + 5)) {
            const Frame Q = fresh(F);
            moe_tables(Q, l, ntok, 0, NCHUNK * NEXP, true, TPRE, TCNT, THSB, TTMP);
            MoeSched S; S.pre = TPRE; S.cnt = TCNT; S.hsb = THSB; S.ng = NCHUNK * NEXP + 1; S.nct = 2; S.G = Q.G; S.c = Q.bid; S.K = D; S.g0 = 0;
            S.A = (const char*)(Q.ws + WS_ACT); S.Wr = (const char*)(Q.ws + WS_WE13); S.Wsh = (const char*)(Q.ws + WS_WSH13) + (size_t)l * 512 * D * 2; S.wstride = (size_t)512 * D * 2;
            S.lists = (const int*)(Q.ws + WS_LISTS); S.gatherA = true; S.shared_grp = NCHUNK * NEXP;
            pg8::EpiSwiglu E{(bf16*)(Q.ws + WS_HS)};
            pg8::gemm_phase<pg8::EpiSwiglu, MoeSched, true>(Q.lds, Q.tid, D, S, E);
        } SEAM(P + 5);
#pragma unroll 1
        for (int c = 0; c < NCHUNK; ++c) {
            if (EN(8) && IN(P + 6 + 2 * c)) {
                const Frame Q = fresh(F);
                moe_tables(Q, l, ntok, c * NEXP, NEXP, c == 0, TPRE, TCNT, THSB, TTMP);
                MoeSched S; S.pre = TPRE; S.cnt = TCNT; S.hsb = THSB; S.ng = NEXP + (c == 0 ? 1 : 0); S.nct = 4; S.G = Q.G; S.c = Q.bid; S.K = EH; S.g0 = c * NEXP;
                S.A = (const char*)(Q.ws + WS_HS); S.Wr = (const char*)(Q.ws + WS_WE2); S.Wsh = (const char*)(Q.ws + WS_WSH2) + (size_t)l * D * EH * 2; S.wstride = (size_t)D * EH * 2;
                S.lists = (const int*)(Q.ws + WS_LISTS); S.gatherA = false; S.shared_grp = (c == 0) ? NEXP : -1;
                pg8::EpiMoeOut E{(bf16*)(Q.ws + WS_OUT2), (bf16*)(Q.ws + WS_F0), c * (ntok / NCHUNK) * 8};
                pg8::gemm_phase<pg8::EpiMoeOut, MoeSched, false>(Q.lds, Q.tid, EH, S, E);
            } SEAM(P + 6 + 2 * c);
            if (EN(9) && IN(P + 7 + 2 * c)) {
                const Frame Q = fresh(F);
                phase_combine(Q, l, ntok, c);
                if (l == 0 && c == NCHUNK - 1) convert_experts(Q, 1, (LAS float*)(Q.lds + Q.wave * 16384));
            } SEAM(P + 7 + 2 * c);
        }
    }
#undef IN
#undef SEAM
}

extern "C" void kernel_launch(void* const* d_in, const int* in_sizes, int n_in, void* d_out, int out_size, void* d_ws, size_t ws_size, hipStream_t stream) {
    static int grid = 0;
    if (grid == 0) {
        if (n_in != 28 || in_sizes[0] != NLAT * D || out_size != NLAT * D || ws_size < WS_END) { fprintf(stderr, "kernel_launch: unexpected shapes or workspace (%zu < %zu)\n", ws_size, (size_t)WS_END); grid = -1; return; }
        int dev = 0, cus = 0, per_cu = 0;
        if (hipGetDevice(&dev) != hipSuccess || hipDeviceGetAttribute(&cus, hipDeviceAttributeMultiprocessorCount, dev) != hipSuccess) { grid = -1; return; }
        if (hipFuncSetAttribute((const void*)fwd, hipFuncAttributeMaxDynamicSharedMemorySize, LDS_BYTES) != hipSuccess) { fprintf(stderr, "kernel_launch: hipFuncSetAttribute failed\n"); grid = -1; return; }
        if (hipOccupancyMaxActiveBlocksPerMultiprocessor(&per_cu, (const void*)fwd, NTHREADS, LDS_BYTES) != hipSuccess || per_cu < 1) { fprintf(stderr, "kernel_launch: occupancy query says %d\n", per_cu); }
        (void)hipGetLastError();
        grid = cus;
    }
    if (grid < 0) return;
    if (hipMemsetAsync((char*)d_ws + WS_CTL, 0, CTL_ZERO_BYTES, stream) != hipSuccess) return;
    Args a{};
    for (int i = 0; i < 28; ++i) a.in[i] = (const float*)d_in[i];
    a.out = (float*)d_out; a.ws = (unsigned char*)d_ws;
#if MK_ONE_LAUNCH
    a.ph_lo = 0; a.ph_hi = N_PHASES;
    hipLaunchKernelGGL(fwd, dim3(grid), dim3(NTHREADS), LDS_BYTES, stream, a);
#else
    for (int p = 0; p < N_PHASES; ++p) { a.ph_lo = p; a.ph_hi = p + 1; hipLaunchKernelGGL(fwd, dim3(grid), dim3(NTHREADS), LDS_BYTES, stream, a); }
#endif
}
```

```cpp
#include <hip/hip_runtime.h>
#include <cstdio>
#include <cstdint>

#ifndef ATTN_NAIVE
#define ATTN_NAIVE 0
#endif
#ifndef MK_ONE_LAUNCH
#define MK_ONE_LAUNCH 1
#endif

#define DI __device__ __forceinline__
#define LAS __attribute__((address_space(3)))
#define GAS __attribute__((address_space(1)))
typedef unsigned short bf16;
typedef short bf16x8 __attribute__((ext_vector_type(8)));
typedef float f32x4 __attribute__((ext_vector_type(4)));
typedef float f32x2 __attribute__((ext_vector_type(2)));
typedef unsigned u32x4 __attribute__((ext_vector_type(4)));
typedef unsigned u32x2 __attribute__((ext_vector_type(2)));

constexpr int D = 1024, NB = 2, SEQ = 16384, NLAT = NB * SEQ, CTXL = 256, NCTX = NB * CTXL, NTOK = NLAT + NCTX;
constexpr int PW = 2048, KEYS = CTXL + SEQ, QROWS = SEQ + CTXL;
constexpr int NEXP = 64, TOPK = 8, EH = 256, NCHUNK = 2, LCAP = NTOK / NCHUNK;
constexpr int NWAVES = 8, NTHREADS = 512;
constexpr float RMS_EPS = 1e-6f, LN_EPS = 1e-5f;
constexpr float LOG2E = 1.4426950408889634f;
constexpr float QA_SCALE = 0.125f * LOG2E;
constexpr float QC_SCALE = 0.17677669529663687f * LOG2E;

constexpr size_t MiB = 1u << 20;
constexpr size_t WS_CTL = 0, CTL_ZERO_BYTES = 1 * MiB;
constexpr size_t WS_MOD = 1 * MiB;
constexpr size_t WS_TAB = 1 * MiB + 256 * 1024;
constexpr size_t WS_TABC = WS_TAB + 32768, WS_SCAL = WS_TAB + 49152;
constexpr size_t WS_RWT = 1 * MiB + 512 * 1024;
constexpr size_t WS_SGUW = 2 * MiB;
constexpr size_t WS_POOLW = 2 * MiB + 512 * 1024;
constexpr size_t WS_WIN = 8 * MiB;
constexpr size_t WS_WOUT = 16 * MiB;
constexpr size_t WS_WSH13 = 20 * MiB;
constexpr size_t WS_WSH2 = 22 * MiB;
constexpr size_t WS_XC = 24 * MiB;
constexpr size_t WS_RINFO = 26 * MiB;
constexpr size_t WS_LISTS = 28 * MiB;
constexpr size_t WS_WE13 = 40 * MiB;
constexpr size_t WS_WE2 = 104 * MiB;
constexpr size_t WS_ACT = 136 * MiB;
constexpr size_t WS_R = 201 * MiB;
constexpr size_t WS_PJ = WS_R;
constexpr size_t QA_BYTES = (size_t)NB * 4 * QROWS * 64 * 2, KA_BYTES = (size_t)NB * 2 * KEYS * 64 * 2;
constexpr size_t WS_QA = 331 * MiB, WS_KA = WS_QA + QA_BYTES, WS_VA = WS_KA + KA_BYTES, WS_QC = WS_VA + KA_BYTES;
constexpr size_t WS_KC = WS_QC + QA_BYTES, WS_VC = WS_KC + QA_BYTES;
constexpr size_t WS_Y = 413 * MiB, WS_Z = 478 * MiB;
static_assert(WS_VC + QA_BYTES <= WS_Y, "qkv region");
constexpr int HS_SH_BASE = NTOK * TOPK + NCHUNK * NEXP * 255;
constexpr size_t WS_HS = WS_R;
constexpr size_t WS_OUT2 = 380 * MiB;
constexpr size_t WS_F0 = 510 * MiB;
constexpr size_t WS_END = 575 * MiB;
static_assert(WS_HS + (size_t)(HS_SH_BASE + NTOK) * 512 <= WS_OUT2, "hs region");
constexpr int CW_TMO = 0, CW_BAR = 4096, CW_CNT = 16384;
constexpr int CW_MAXK = 32768;

constexpr int LDS_BYTES = 155648, LDS_SCRATCH = 141312, LDSCTL_OFF = LDS_SCRATCH;
constexpr int MISC_OFF = LDSCTL_OFF;
constexpr int TBL_OFF = LDSCTL_OFF + 128;

DI float bf2f(unsigned v) { return __uint_as_float(v << 16); }
DI unsigned f2bf(float f) { unsigned u = __float_as_uint(f); return (u + 0x7fffu + ((u >> 16) & 1u)) >> 16; }
DI unsigned pk2(float lo, float hi) { return f2bf(lo) | (f2bf(hi) << 16); }
DI float lo16(unsigned w) { return __uint_as_float(w << 16); }
DI float hi16(unsigned w) { return __uint_as_float(w & 0xffff0000u); }
template <int M> DI float shx(float v) { static_assert(M == 1 || M == 2 || M == 4 || M == 8 || M == 16, "xor mask inside 32 lanes"); return __int_as_float(__builtin_amdgcn_ds_swizzle(__float_as_int(v), (M << 10) | 0x1f)); }
template <int M> DI int shx(int v) { static_assert(M == 1 || M == 2 || M == 4 || M == 8 || M == 16, "xor mask inside 32 lanes"); return __builtin_amdgcn_ds_swizzle(v, (M << 10) | 0x1f); }
DI float xadd32(float v) { const auto rr = __builtin_amdgcn_permlane32_swap(__float_as_uint(v), __float_as_uint(v), false, false); return __uint_as_float(rr[0]) + __uint_as_float(rr[1]); }
DI float rdlane(float v, int l) { return __int_as_float(__builtin_amdgcn_readlane(__float_as_int(v), l)); }
DI int rdlane(int v, int l) { return __builtin_amdgcn_readlane(v, l); }
DI float wave_sum(float v) {
    v += shx<1>(v); v += shx<2>(v); v += shx<4>(v); v += shx<8>(v); v += shx<16>(v);
    return xadd32(v);
}
#define LDS_WAIT() asm volatile("s_waitcnt lgkmcnt(0)" ::: "memory")
#define VM_WAIT() asm volatile("s_waitcnt vmcnt(0)" ::: "memory")

namespace pg8 {
constexpr int BM = 256, BK = 64, HALF = 128, HTB = HALF * BK * 2, STAGE_BYTES = 8 * HTB, NXCD = 8, WGM = 8;
__host__ __device__ __forceinline__ int lds_byte(int r, int c) { const int st = (r >> 4) * 2 + (c >> 5), rr = r & 15, cc = c & 31, ob = rr * 64 + cc * 2; return st * 1024 + (ob ^ (((ob >> 9) & 1) << 5)); }
__host__ __device__ __forceinline__ void stage_rc(int b, int& R, int& C) { const int st = b / 1024, sb = b % 1024, swz = sb ^ (((sb >> 9) & 1) << 5); R = (st >> 1) * 16 + swz / 64; C = (st & 1) * 32 + (swz % 64) / 2; }
__host__ __device__ __forceinline__ int perm32(int rho) { const int n = rho >> 4, i = rho & 15; return 8 * (i >> 2) + 4 * n + (i & 3); }

struct Unit {
    const char* A;
    const char* B;
    const int* rows;
    int nvalid;
    int orow0;
    int pn;
    int aux;
};

struct DenseOrder {
    const bf16* A; const bf16* Bt; int K; int nM, nN, nwg, G, c;
    DI void init(const void* A_, const void* Bt_, int M, int N, int KB_, int G_, int c_) { A = (const bf16*)A_; Bt = (const bf16*)Bt_; K = KB_;     nM = M / BM; nN = N / BM; nwg = nM * nN; G = G_; c = c_; }
    DI bool next(int i, Unit& u) const {
        const long L = (long)i * G + c; if (L >= nwg) return false;
        int wgid = (int)L; { const int q = nwg / NXCD, r = nwg % NXCD, xcd = wgid % NXCD, off = wgid / NXCD; wgid = (xcd < r ? xcd * (q + 1) : r * (q + 1) + (xcd - r) * q) + off; }
        const int nig = WGM * nN, gid = wgid / nig, fm = gid * WGM, gsz = (nM - fm) < WGM ? (nM - fm) : WGM;
        const int pm = fm + ((wgid % nig) % gsz), pn = (wgid % nig) / gsz;
        u.A = (const char*)A + (size_t)pm * BM * K; u.B = (const char*)Bt + (size_t)pn * BM * K; u.rows = nullptr; u.nvalid = BM; u.orow0 = pm * BM; u.pn = pn; u.aux = 0;
        return true;
    }
};

DI unsigned cvt_pk_bf16(float lo, float hi) { unsigned r; asm volatile("v_cvt_pk_bf16_f32 %0, %1, %2" : "=v"(r) : "v"(lo), "v"(hi)); return r; }

struct EpiBf16 {
    static constexpr bool PERM = true;
    bf16* O; int ldc;
    DI void operator()(const f32x4 (&acc)[2][2][4][2], const Unit& u, int wr, int wc, int fr, int fq) const {
        const int row0 = u.orow0 + wr * 64 + fr; const int col0 = u.pn * BM + wc * 32 + 8 * fq;
#pragma unroll
        for (int ai = 0; ai < 2; ++ai)
#pragma unroll
            for (int m = 0; m < 4; ++m) { bf16* rowp = O + (size_t)(row0 + ai * HALF + m * 16) * ldc + col0;
#pragma unroll
                for (int bj = 0; bj < 2; ++bj) { const f32x4 v0 = acc[ai][bj][m][0], v1 = acc[ai][bj][m][1];
                    u32x4 w; w.x = cvt_pk_bf16(v0[0], v0[1]); w.y = cvt_pk_bf16(v0[2], v0[3]); w.z = cvt_pk_bf16(v1[0], v1[1]); w.w = cvt_pk_bf16(v1[2], v1[3]);
                    *(u32x4*)(rowp + bj * HALF) = w; } }
    }
};
struct EpiSwiglu {
    static constexpr bool PERM = false; static constexpr float WINV = 1.0f / 32.0f, HSCALE = 8.0f;
    unsigned char* Hs;
    DI void operator()(const f32x4 (&acc)[2][2][4][2], const Unit& u, int wr, int wc, int fr, int fq) const {
        const int row0 = u.orow0 + wr * 64 + fr; const int f0 = u.pn * 128 + wc * 32 + 8 * fq;
#pragma unroll
        for (int ai = 0; ai < 2; ++ai)
#pragma unroll
            for (int m = 0; m < 4; ++m) { unsigned char* rowp = Hs + (size_t)(row0 + ai * HALF + m * 16) * EH + f0; u32x2 w;
#pragma unroll
                for (int bj = 0; bj < 2; ++bj) { const f32x4 a = acc[ai][bj][m][0], b = acc[ai][bj][m][1]; float h[4];
#pragma unroll
                    for (int j = 0; j < 4; ++j) { const float a1 = a[j] * WINV, a3 = b[j] * (WINV * HSCALE); const float s = a1 * __builtin_amdgcn_rcpf(1.0f + __builtin_amdgcn_exp2f(-a1 * LOG2E)); h[j] = s * a3; }
#pragma unroll
                    for (int j = 0; j < 4; ++j) h[j] = __builtin_amdgcn_fmed3f(h[j], -448.0f, 448.0f);
                    int wv = 0; wv = __builtin_amdgcn_cvt_pk_fp8_f32(h[0], h[1], wv, false); wv = __builtin_amdgcn_cvt_pk_fp8_f32(h[2], h[3], wv, true);
                    if (bj == 0) w.x = (unsigned)wv; else w.y = (unsigned)wv; }
                *(u32x2*)rowp = w; }
    }
};
struct EpiMoeOut {
    static constexpr bool PERM = true;
    bf16* OUT2; bf16* F0; int ebase;
    DI void operator()(const f32x4 (&acc)[2][2][4][2], const Unit& u, int wr, int wc, int fr, int fq) const {
        const int col0 = u.pn * BM + wc * 32 + 8 * fq;
        const bool routed = u.rows != nullptr;
        bf16* base = routed ? OUT2 : F0;
        int drow[2][4];
        if (routed) {
#pragma unroll
            for (int ai = 0; ai < 2; ++ai)
#pragma unroll
                for (int m = 0; m < 4; ++m) { const int r = wr * 64 + fr + ai * HALF + m * 16; drow[ai][m] = u.rows[min(r, u.nvalid - 1)]; }
#pragma unroll
            for (int ai = 0; ai < 2; ++ai)
#pragma unroll
                for (int m = 0; m < 4; ++m) { const int r = wr * 64 + fr + ai * HALF + m * 16; drow[ai][m] = (r < u.nvalid) ? drow[ai][m] - ebase : -1; }
        } else {
#pragma unroll
            for (int ai = 0; ai < 2; ++ai)
#pragma unroll
                for (int m = 0; m < 4; ++m) drow[ai][m] = u.orow0 + wr * 64 + fr + ai * HALF + m * 16;
        }
        if (routed) {
            unsigned char* base8 = (unsigned char*)OUT2;
#pragma unroll
            for (int ai = 0; ai < 2; ++ai)
#pragma unroll
                for (int m = 0; m < 4; ++m) {
                    if (drow[ai][m] >= 0) { unsigned char* rowp = base8 + (size_t)drow[ai][m] * D + u.pn * BM + wc * 64 + 16 * fq; u32x4 w;
#pragma unroll
                    for (int bj = 0; bj < 2; ++bj) { const f32x4 v0 = acc[ai][bj][m][0] * (16.0f / 256.0f), v1 = acc[ai][bj][m][1] * (16.0f / 256.0f); int w0 = 0, w1 = 0;
                        w0 = __builtin_amdgcn_cvt_pk_fp8_f32(v0[0], v0[1], w0, false); w0 = __builtin_amdgcn_cvt_pk_fp8_f32(v0[2], v0[3], w0, true);
                        w1 = __builtin_amdgcn_cvt_pk_fp8_f32(v1[0], v1[1], w1, false); w1 = __builtin_amdgcn_cvt_pk_fp8_f32(v1[2], v1[3], w1, true);
                        if (bj == 0) { w.x = (unsigned)w0; w.y = (unsigned)w1; } else { w.z = (unsigned)w0; w.w = (unsigned)w1; } }
                    *(u32x4*)rowp = w; } }
        } else {
#pragma unroll
        for (int ai = 0; ai < 2; ++ai)
#pragma unroll
            for (int m = 0; m < 4; ++m) {
                bf16* rowp = base + (size_t)drow[ai][m] * D + col0;
#pragma unroll
                for (int bj = 0; bj < 2; ++bj) { const f32x4 v0 = acc[ai][bj][m][0] * (1.0f / 256.0f), v1 = acc[ai][bj][m][1] * (1.0f / 256.0f);
                    u32x4 w; w.x = cvt_pk_bf16(v0[0], v0[1]); w.y = cvt_pk_bf16(v0[2], v0[3]); w.z = cvt_pk_bf16(v1[0], v1[1]); w.w = cvt_pk_bf16(v1[2], v1[3]);
                    *(u32x4*)(rowp + bj * HALF) = w; } }
        }
    }
};

template <bool GATHER, bool PERMB> DI void set_voff(const Unit& u, unsigned (&v)[2][2], unsigned (&vB)[2], int wid, int KB) {
    unsigned lane_s; asm volatile("v_mbcnt_lo_u32_b32 %0, -1, 0\n\tv_mbcnt_hi_u32_b32 %0, -1, %0" : "=v"(lane_s));
    const int tid = wid * 64 + (int)lane_s;
#pragma unroll
    for (int i = 0; i < 2; ++i) {
        int R, C; stage_rc(tid * 16 + i * 8192, R, C); const int Rb = PERMB ? ((R & ~31) + perm32(R & 31)) : R; vB[i] = (unsigned)(Rb * KB + C * 2);
#pragma unroll
        for (int h = 0; h < 2; ++h) {
            if (GATHER && u.rows) { const int r = h * HALF + R; const int e = u.rows[min(r, u.nvalid - 1)]; v[h][i] = (unsigned)((e >> 3) * KB + C * 2); }
            else v[h][i] = (unsigned)((h * HALF + R) * KB + C * 2);
        }
    }
}

template <class Epi, class Sched, bool GATHER, bool FP8 = false, int WSCALE = 0x7f7f7f7f>
DI void gemm_phase(LAS unsigned char* lds, const int tid, const int KB, const Sched& S, const Epi& E, const unsigned char* wsbase) {
    const char* wsb_ = (const char*)wsbase; const __amdgpu_buffer_rsrc_t rs_ = __builtin_amdgcn_make_buffer_rsrc((void*)wsbase, 0, 0x7fffffff, 0x00020000);
    const int wid = __builtin_amdgcn_readfirstlane(tid >> 6), lane = tid & 63, wr = wid >> 2, wc = wid & 3, fr = lane & 15, fq = lane >> 4;
    const int nt = KB / (BK * 2);
    unsigned voffB[2];
    const size_t kstep = (size_t)(BK * 2);
    const size_t hstep = (size_t)HALF * KB;
    const unsigned ldsw = (unsigned)wid * 1024u;
    const int aoff = lds_byte(wr * 64 + fr, fq * 8), boff = lds_byte(wc * 32 + fr, fq * 8);
#define PG8_SA(b, h) (((b) * 2 + (h)) * HTB)
#define PG8_SB(b, h) ((4 + (b) * 2 + (h)) * HTB)
#define PG8_STAGE(bufoff, gbase, voff) do { const int so_ = (int)(unsigned)((const char*)(gbase) - wsb_); _Pragma("unroll") for (int _i = 0; _i < 2; ++_i) \
        __builtin_amdgcn_raw_ptr_buffer_load_lds(rs_, (LAS unsigned*)(lds + (bufoff) + ldsw + _i * 8192), 16, (int)(voff)[_i], so_, 0, 0); } while (0)
#define PG8_LDA(dst, b, h) do { _Pragma("unroll") for (int m = 0; m < 4; ++m) { const i32x4_ lo_ = *(const LAS i32x4_*)(lds + PG8_SA(b, h) + aoff + m * 2048), hi_ = *(const LAS i32x4_*)(lds + PG8_SA(b, h) + aoff + m * 2048 + 1024); \
        dst[m] = __builtin_shufflevector(lo_, hi_, 0, 1, 2, 3, 4, 5, 6, 7); } } while (0)
#define PG8_LDB(dst, b, h) do { _Pragma("unroll") for (int n = 0; n < 2; ++n) { const i32x4_ lo_ = *(const LAS i32x4_*)(lds + PG8_SB(b, h) + boff + n * 2048), hi_ = *(const LAS i32x4_*)(lds + PG8_SB(b, h) + boff + n * 2048 + 1024); \
        dst[n] = __builtin_shufflevector(lo_, hi_, 0, 1, 2, 3, 4, 5, 6, 7); } } while (0)
#define PG8_MMA(ai, bj, At, Bt) do { __builtin_amdgcn_s_setprio(1); _Pragma("unroll") for (int m = 0; m < 4; ++m) _Pragma("unroll") for (int n = 0; n < 2; ++n) { \
        if constexpr (FP8) acc[ai][bj][m][n] = __builtin_amdgcn_mfma_scale_f32_16x16x128_f8f6f4(Bt[n], At[m], acc[ai][bj][m][n], 0, 0, 0, 0, 0, 0); \
        else { const bf16x8 b0_ = __builtin_bit_cast(bf16x8, __builtin_shufflevector(Bt[n], Bt[n], 0, 1, 2, 3)), b1_ = __builtin_bit_cast(bf16x8, __builtin_shufflevector(Bt[n], Bt[n], 4, 5, 6, 7)); \
               const bf16x8 a0_ = __builtin_bit_cast(bf16x8, __builtin_shufflevector(At[m], At[m], 0, 1, 2, 3)), a1_ = __builtin_bit_cast(bf16x8, __builtin_shufflevector(At[m], At[m], 4, 5, 6, 7)); \
               acc[ai][bj][m][n] = __builtin_amdgcn_mfma_f32_16x16x32_bf16(b0_, a0_, acc[ai][bj][m][n], 0, 0, 0); acc[ai][bj][m][n] = __builtin_amdgcn_mfma_f32_16x16x32_bf16(b1_, a1_, acc[ai][bj][m][n], 0, 0, 0); } } \
        __builtin_amdgcn_s_setprio(0); } while (0)
#define PG8_WAIT_V(n) asm volatile("s_waitcnt vmcnt(" #n ")" ::: "memory")
#define PG8_WAIT_L(n) asm volatile("s_waitcnt lgkmcnt(" #n ")" ::: "memory")
#define PG8_BAR __builtin_amdgcn_s_barrier()
#define PG8_SCHED __builtin_amdgcn_sched_barrier(0)
    Unit cur, nxt; int ui = 0;
    if (!S.next(0, cur)) return;
    f32x4 acc[2][2][4][2];
#pragma unroll
    for (int a = 0; a < 2; ++a)
#pragma unroll
        for (int b = 0; b < 2; ++b)
#pragma unroll
            for (int m = 0; m < 4; ++m)
#pragma unroll
                for (int n = 0; n < 2; ++n) acc[a][b][m][n] = (f32x4){0.f, 0.f, 0.f, 0.f};
    typedef int i32x4_ __attribute__((ext_vector_type(4))); typedef int v8i_ __attribute__((ext_vector_type(8)));
    v8i_ At[4], B0[2], B1[2];
    unsigned voC[2][2];
    set_voff<GATHER, Epi::PERM>(cur, voC, voffB, wid, KB);
    LAS u32x4* const park = (LAS u32x4*)(lds + STAGE_BYTES) + tid;
    const char* cA = cur.A; const char* cB = cur.B;
    PG8_STAGE(PG8_SB(0, 0), cB, voffB); PG8_STAGE(PG8_SB(0, 1), cB + hstep, voffB); PG8_STAGE(PG8_SA(0, 0), cA, voC[0]); PG8_STAGE(PG8_SA(0, 1), cA, voC[1]);
    if (wr == 1) PG8_BAR;
    PG8_WAIT_V(2); PG8_BAR;
    PG8_STAGE(PG8_SB(1, 0), cB + kstep, voffB); PG8_STAGE(PG8_SA(1, 0), cA + kstep, voC[0]); PG8_STAGE(PG8_SB(1, 1), cB + hstep + kstep, voffB);
    PG8_WAIT_V(6); PG8_BAR;
    for (;;) {
        const bool has_next = S.next(ui + 1, nxt);
        const char* nA = has_next ? nxt.A : cA; const char* nB = has_next ? nxt.B : cB;
        if constexpr (GATHER) {
            unsigned vb_[2], voN[2][2];
            if (has_next) set_voff<GATHER, Epi::PERM>(nxt, voN, vb_, wid, KB);
            else {
#pragma unroll
                for (int h = 0; h < 2; ++h)
#pragma unroll
                    for (int i = 0; i < 2; ++i) voN[h][i] = voC[h][i]; }
            u32x4 pk_; pk_.x = voN[0][0]; pk_.y = voN[0][1]; pk_.z = voN[1][0]; pk_.w = voN[1][1]; *park = pk_;
        }
#pragma unroll 1
        for (int t = 0; t < nt; t += 2) {
            const bool last = (t == nt - 2);
            const char* a1 = cA + (size_t)(t + 1) * kstep;
            const char* a2 = last ? nA : cA + (size_t)(t + 2) * kstep; const char* b2 = last ? nB : cB + (size_t)(t + 2) * kstep;
            const char* a3 = a2 + kstep; const char* b3 = b2 + kstep;
            unsigned vo2[2][2];
            if constexpr (GATHER) { const u32x4 pk_ = *park; vo2[0][0] = last ? pk_.x : voC[0][0]; vo2[0][1] = last ? pk_.y : voC[0][1]; vo2[1][0] = last ? pk_.z : voC[1][0]; vo2[1][1] = last ? pk_.w : voC[1][1]; }
            else {
#pragma unroll
                for (int h = 0; h < 2; ++h)
#pragma unroll
                    for (int i = 0; i < 2; ++i) vo2[h][i] = voC[h][i]; }
            PG8_LDB(B0, 0, 0); PG8_LDB(B1, 0, 1); PG8_SCHED; PG8_LDA(At, 0, 0); PG8_STAGE(PG8_SA(1, 1), a1, voC[1]);
            PG8_WAIT_V(8); PG8_WAIT_L(0); PG8_BAR; PG8_MMA(0, 0, At, B0); PG8_MMA(0, 1, At, B1); PG8_BAR; PG8_SCHED;
            PG8_LDA(At, 0, 1); PG8_STAGE(PG8_SB(0, 0), b2, voffB); PG8_STAGE(PG8_SB(0, 1), b2 + hstep, voffB); PG8_STAGE(PG8_SA(0, 0), a2, vo2[0]);
            PG8_WAIT_V(8); PG8_WAIT_L(0); PG8_BAR; PG8_MMA(1, 0, At, B0); PG8_MMA(1, 1, At, B1); PG8_BAR; PG8_SCHED;
            PG8_LDB(B0, 1, 0); PG8_LDB(B1, 1, 1); PG8_SCHED; PG8_LDA(At, 1, 0); PG8_STAGE(PG8_SA(0, 1), a2, vo2[1]);
            PG8_WAIT_V(8); PG8_WAIT_L(0); PG8_BAR; PG8_MMA(0, 0, At, B0); PG8_MMA(0, 1, At, B1); PG8_BAR; PG8_SCHED;
            PG8_LDA(At, 1, 1); PG8_STAGE(PG8_SB(1, 0), b3, voffB); PG8_STAGE(PG8_SB(1, 1), b3 + hstep, voffB); PG8_STAGE(PG8_SA(1, 0), a3, vo2[0]);
            PG8_WAIT_V(8); PG8_WAIT_L(0); PG8_BAR; PG8_MMA(1, 0, At, B0); PG8_MMA(1, 1, At, B1); PG8_BAR; PG8_SCHED;
        }
        if (wr == 0) PG8_BAR;
        { unsigned lane_e; asm volatile("v_mbcnt_lo_u32_b32 %0, -1, 0\n\tv_mbcnt_hi_u32_b32 %0, -1, %0" : "=v"(lane_e));
          E(acc, cur, wr, wc, (int)(lane_e & 15u), (int)(lane_e >> 4)); }
        if (!has_next) break;
#pragma unroll
        for (int a = 0; a < 2; ++a)
#pragma unroll
            for (int b = 0; b < 2; ++b)
#pragma unroll
                for (int m = 0; m < 4; ++m)
#pragma unroll
                    for (int n = 0; n < 2; ++n) acc[a][b][m][n] = (f32x4){0.f, 0.f, 0.f, 0.f};
        cur = nxt; cA = nA; cB = nB; ++ui;
        if constexpr (GATHER) { const u32x4 pk_ = *park; voC[0][0] = pk_.x; voC[0][1] = pk_.y; voC[1][0] = pk_.z; voC[1][1] = pk_.w; }
        if (wr == 1) PG8_BAR;
    }
    PG8_WAIT_V(0);
    PG8_BAR;
#undef PG8_SA
#undef PG8_SB
#undef PG8_STAGE
#undef PG8_LDA
#undef PG8_LDB
#undef PG8_MMA
#undef PG8_WAIT_V
#undef PG8_WAIT_L
#undef PG8_BAR
#undef PG8_SCHED
}
}

#define XB_TMO      128
#define XB_XCNT(j)  (256  + 64 * (j))
#define XB_XSUB(j)  (1280 + 64 * (j))
#define XB_XGEN(j)  (2304 + 64 * (j))
#define XB_TOP      3328
#define XB_TOPGEN   3392
#define XCD_BAR_WORDS 3456
#define XB_SPIN_CAP (1u << 18)
DI unsigned xb_ld(unsigned* p)              { return __hip_atomic_load(p, __ATOMIC_RELAXED, __HIP_MEMORY_SCOPE_AGENT); }
DI unsigned xb_add(unsigned* p, unsigned v) { return __hip_atomic_fetch_add(p, v, __ATOMIC_RELAXED, __HIP_MEMORY_SCOPE_AGENT); }
DI unsigned xb_xcc_id() { return (unsigned)__builtin_amdgcn_s_getreg((3 << 11) | 20) & 0xFu; }
#define XB_SPIN(cond, bar) do { unsigned _sp = 0; while (cond) { __builtin_amdgcn_s_sleep(1); \
    if ((++_sp & 255u) == 0u) { if (xb_ld(&(bar)[XB_TMO])) break; if (_sp > XB_SPIN_CAP) { atomicAdd(&(bar)[XB_TMO], 1u); break; } } } } while (0)
struct XcdBarrier { unsigned* bar; unsigned x; volatile LAS unsigned* st; };
DI XcdBarrier xcd_barrier_post(unsigned* bar, volatile LAS unsigned* st, const bool leader) {
    XcdBarrier b; b.bar = bar; b.x = xb_xcc_id(); b.st = st;
    if (leader) (void)xb_add(&bar[XB_XCNT(b.x)], 1u);
    return b;
}
DI void xcd_barrier_complete(unsigned* bar, unsigned x, unsigned& nloc, unsigned& nx) {
    const unsigned G = gridDim.x * gridDim.y * gridDim.z;
    unsigned sum, cnt, mine, sp = 0u;
    for (;;) {
        sum = 0u; cnt = 0u; mine = 0u;
#pragma unroll
        for (unsigned j = 0; j < 16; ++j) { const unsigned c = xb_ld(&bar[XB_XCNT(j)]); sum += c; cnt += (c > 0u) ? 1u : 0u; mine = (j == x) ? c : mine; }
        if (sum == G) break;
        __builtin_amdgcn_s_sleep(1);
        if ((++sp & 255u) == 0u) { if (xb_ld(&bar[XB_TMO])) break; if (sp > XB_SPIN_CAP) { atomicAdd(&bar[XB_TMO], 1u); break; } }
    }
    nloc = mine > 0u ? mine : 1u; nx = cnt > 0u ? cnt : 1u;
}
DI void xcd_barrier(const XcdBarrier& b, const bool leader) {
    asm volatile("s_waitcnt vmcnt(0)" ::: "memory");
    __syncthreads();
    if (leader) {
        unsigned* bar = b.bar;
        __builtin_amdgcn_s_waitcnt(0);
        unsigned nloc = b.st[0], nx = b.st[1];
        if (nloc == 0u) { xcd_barrier_complete(bar, b.x, nloc, nx); b.st[0] = nloc; b.st[1] = nx; }
        const unsigned old = xb_add(&bar[XB_XSUB(b.x)], 1u);
        const unsigned gen = old / nloc;
        if (old + 1u == (gen + 1u) * nloc) {
            __builtin_amdgcn_fence(__ATOMIC_RELEASE, "agent");
            asm volatile("s_waitcnt vmcnt(0)" ::: "memory");
            const unsigned og = xb_add(&bar[XB_TOP], 1u);
            const unsigned tg = og / nx;
            if (og + 1u == (tg + 1u) * nx) xb_add(&bar[XB_TOPGEN], 1u);
            else XB_SPIN(xb_ld(&bar[XB_TOPGEN]) == tg, bar);
            __builtin_amdgcn_fence(__ATOMIC_ACQUIRE, "agent");
            xb_add(&bar[XB_XGEN(b.x)], 1u);
            asm volatile("s_waitcnt vmcnt(0)" ::: "memory");
        } else {
            XB_SPIN(xb_ld(&bar[XB_XGEN(b.x)]) == gen, bar);
            __builtin_amdgcn_fence(__ATOMIC_ACQUIRE, "agent");
            asm volatile("s_waitcnt vmcnt(0)" ::: "memory");
        }
    }
    __syncthreads();
}

struct Args { const float* in[28]; float* out; unsigned char* ws; int ph_lo, ph_hi; };
enum { I_X = 0, I_C, I_CTX, I_CCTX, I_ADAW, I_ADAB, I_GPREMIX, I_GPOSTMIX, I_GPREFFN, I_GPOSTFFN, I_WIN, I_WOUT, I_AQG, I_AKG, I_POOLW, I_POOLS, I_LAMQK, I_CSUBLN,
       I_SGUW, I_SGUB, I_ROUTERW, I_ROUTERB, I_EW1, I_EW3, I_EW2, I_SW1, I_SW3, I_SW2 };

struct Frame {
    LAS unsigned char* lds;
    int tid, lane, wave, G, bid;
    const float* const* in; float* out; unsigned char* ws;
};

DI size_t opaque0() { unsigned z; asm volatile("s_mov_b32 %0, 0" : "=s"(z)); return (size_t)z; }
#ifdef NO_LAUNDER
DI Frame fresh(const Frame& F) { Frame G = F; G.lane = (int)__builtin_amdgcn_mbcnt_hi(~0u, __builtin_amdgcn_mbcnt_lo(~0u, 0u)); G.tid = G.wave * 64 + G.lane; return G; }
#else
DI Frame fresh(const Frame& F) { Frame G = F; const size_t z = opaque0(); G.ws = F.ws + z; G.in = F.in + z; G.out = F.out + z; { unsigned ln_; asm volatile("v_mbcnt_lo_u32_b32 %0, -1, %1\n\tv_mbcnt_hi_u32_b32 %0, -1, %0" : "=v"(ln_) : "s"((unsigned)z)); G.lane = (int)ln_; } G.wave = F.wave + (int)z; G.tid = G.wave * 64 + G.lane; G.bid = F.bid + (int)z; G.G = F.G + (int)z; G.lds = F.lds + z; return G; }
#endif
DI void load_row_f32(const float* p, int lane, f32x4 (&v)[4]) {
#pragma unroll
    for (int j = 0; j < 4; ++j) v[j] = *(const f32x4*)(p + 4 * lane + 256 * j);
}
DI void load_row_bf16(const bf16* p, int lane, f32x4 (&v)[4]) {
#pragma unroll
    for (int j = 0; j < 4; ++j) { const u32x2 w = *(const u32x2*)(p + 4 * lane + 256 * j); v[j] = (f32x4){lo16(w.x), hi16(w.x), lo16(w.y), hi16(w.y)}; }
}
DI void store_row_f32(float* p, int lane, const f32x4 (&v)[4]) {
#pragma unroll
    for (int j = 0; j < 4; ++j) *(f32x4*)(p + 4 * lane + 256 * j) = v[j];
}
DI void store_row_bf16(bf16* p, int lane, const f32x4 (&v)[4]) {
#pragma unroll
    for (int j = 0; j < 4; ++j) { u32x2 w; w.x = pk2(v[j][0], v[j][1]); w.y = pk2(v[j][2], v[j][3]); *(u32x2*)(p + 4 * lane + 256 * j) = w; }
}
DI float row_sumsq(const f32x4 (&v)[4]) {
    float s = 0.f;
#pragma unroll
    for (int j = 0; j < 4; ++j) s += (v[j][0] * v[j][0] + v[j][1] * v[j][1]) + (v[j][2] * v[j][2] + v[j][3] * v[j][3]);
    return wave_sum(s);
}
DI void norm_mod(f32x4 (&v)[4], float rstd, const float* g, const float* shift, const float* scale, int lane) {
#pragma unroll
    for (int j = 0; j < 4; ++j) { const int c = 4 * lane + 256 * j; const f32x4 gg = *(const f32x4*)(g + c), sh = *(const f32x4*)(shift + c), sc = *(const f32x4*)(scale + c);
        v[j] = (v[j] * rstd * gg) * (1.0f + sc) + sh; }
}
DI const float* modp(const Frame& F, int l, int r, int j) { return (const float*)(F.ws + WS_MOD) + ((size_t)(l * 3 + r) * 6 + j) * D; }
DI int mod_row(int row) { return row < NLAT ? row / SEQ : 2; }

template <class RowMap>
DI void transpose_item(const float* W, int K, int N, bf16* WT, const RowMap& rm, LAS float* scr, int item, int lane) {
    const int nblk = N / 32, kb = item / nblk, nb = item % nblk, k0 = 64 * kb, n0 = 32 * nb;
#pragma unroll 8
    for (int i = 0; i < 32; ++i) { const int kk = 2 * i + (lane >> 5); scr[kk * 33 + (lane & 31)] = W[(size_t)(k0 + kk) * N + n0 + (lane & 31)]; }
    LDS_WAIT(); asm volatile("" ::: "memory");
    const int c = lane & 7;
#pragma unroll
    for (int j = 0; j < 4; ++j) { const int n = (lane >> 3) + 8 * j; const LAS float* s = scr + (8 * c) * 33 + n;
        u32x4 o; o.x = pk2(s[0 * 33], s[1 * 33]); o.y = pk2(s[2 * 33], s[3 * 33]); o.z = pk2(s[4 * 33], s[5 * 33]); o.w = pk2(s[6 * 33], s[7 * 33]);
        *(u32x4*)(WT + (size_t)rm(n0 + n) * K + k0 + 8 * c) = o; }
    LDS_WAIT(); asm volatile("" ::: "memory");
}
template <class RowMap>
DI void transpose_item8(const float* W, int K, int N, unsigned char* WT8, const RowMap& rm, LAS float* scr, int item, int lane, float scale) {
    const int nblk = N / 32, kb = item / nblk, nb = item % nblk, k0 = 64 * kb, n0 = 32 * nb;
#pragma unroll 8
    for (int i = 0; i < 32; ++i) { const int kk = 2 * i + (lane >> 5); scr[kk * 33 + (lane & 31)] = W[(size_t)(k0 + kk) * N + n0 + (lane & 31)] * scale; }
    LDS_WAIT(); asm volatile("" ::: "memory");
    const int c = lane & 7;
#pragma unroll
    for (int j = 0; j < 4; ++j) { const int n = (lane >> 3) + 8 * j; const LAS float* sp = scr + (8 * c) * 33 + n;
        int w0 = 0, w1 = 0;
        w0 = __builtin_amdgcn_cvt_pk_fp8_f32(sp[0 * 33], sp[1 * 33], w0, false); w0 = __builtin_amdgcn_cvt_pk_fp8_f32(sp[2 * 33], sp[3 * 33], w0, true);
        w1 = __builtin_amdgcn_cvt_pk_fp8_f32(sp[4 * 33], sp[5 * 33], w1, false); w1 = __builtin_amdgcn_cvt_pk_fp8_f32(sp[6 * 33], sp[7 * 33], w1, true);
        u32x2 o; o.x = (unsigned)w0; o.y = (unsigned)w1;
        *(u32x2*)(WT8 + (size_t)rm(n0 + n) * K + k0 + 8 * c) = o; }
    LDS_WAIT(); asm volatile("" ::: "memory");
}
struct RowId { int off; DI int operator()(int n) const { return off + n; } };
struct RowW13 { int which; DI int operator()(int f) const { return ((f >> 7) << 8) + (((f >> 2) & 1) << 7) + (((f >> 5) & 3) << 5) + 16 * which + (((f >> 3) & 3) << 2) + (f & 3); } };

DI void convert_experts(const Frame& F, int l, LAS float* scr) {
    const int gw = F.bid * NWAVES + F.wave, NGW = F.G * NWAVES;
    bf16* WE13 = (bf16*)(F.ws + WS_WE13); bf16* WE2 = (bf16*)(F.ws + WS_WE2);
    constexpr int IT = 128;
    for (int it = gw; it < NEXP * 3 * IT; it += NGW) {
        const int e = it / (3 * IT), r = it % (3 * IT), m = r / IT, item = r % IT;
        const size_t eo = ((size_t)l * NEXP + e) * (size_t)(D * EH);
        if (m == 0) transpose_item8(F.in[I_EW1] + eo, D, EH, (unsigned char*)WE13 + (size_t)e * 512 * D, RowW13{0}, scr, item, F.lane, 32.0f);
        else if (m == 1) transpose_item8(F.in[I_EW3] + eo, D, EH, (unsigned char*)WE13 + (size_t)e * 512 * D, RowW13{1}, scr, item, F.lane, 32.0f);
        else transpose_item8(F.in[I_EW2] + eo, EH, D, (unsigned char*)WE2 + (size_t)e * D * EH, RowId{0}, scr, item, F.lane, 32.0f);
    }
}

DI void phase_pro_a(const Frame& F) {
    LAS float* scrw = (LAS float*)(F.lds + F.wave * 16384);
    if (F.bid < 192) {
        const int l = F.bid / 96, cg = F.bid % 96, n = cg * 64 + F.lane;
        const float* W = F.in[I_ADAW] + (size_t)l * D * 6144;
        float a0 = 0.f, a1 = 0.f, a2 = 0.f;
        const int k0 = F.wave * 128;
#pragma unroll 8
        for (int k = k0; k < k0 + 128; ++k) {
            const float w = W[(size_t)k * 6144 + n];
            const float c0 = F.in[I_C][k], c1 = F.in[I_C][D + k], c2 = F.in[I_CCTX][k];
            a0 += w * (c0 / (1.0f + __expf(-c0))); a1 += w * (c1 / (1.0f + __expf(-c1))); a2 += w * (c2 / (1.0f + __expf(-c2)));
        }
        LAS float* red = (LAS float*)(F.lds + 131072);
        red[(F.wave * 3 + 0) * 64 + F.lane] = a0; red[(F.wave * 3 + 1) * 64 + F.lane] = a1; red[(F.wave * 3 + 2) * 64 + F.lane] = a2;
        __syncthreads();
        if (F.wave < 3) { float s = F.in[I_ADAB][l * 6144 + n];
#pragma unroll
            for (int w = 0; w < 8; ++w) s += red[(w * 3 + F.wave) * 64 + F.lane];
            ((float*)(F.ws + WS_MOD))[(size_t)(l * 3 + F.wave) * 6144 + n] = s; }
        __syncthreads();
    }
    const int gw = F.bid * NWAVES + F.wave, NGW = F.G * NWAVES;
    {
        constexpr int I_IN = 16 * 64, I_OUT = 16 * 32, I_S = 128;
        constexpr int PER_L = I_IN + I_OUT + 3 * I_S;
        for (int it = gw; it < 2 * PER_L; it += NGW) {
            const int l = it / PER_L; int r = it % PER_L;
            if (r < I_IN) { transpose_item(F.in[I_WIN] + (size_t)l * D * PW, D, PW, (bf16*)(F.ws + WS_WIN) + (size_t)l * PW * D, RowId{0}, scrw, r, F.lane); continue; } r -= I_IN;
            if (r < I_OUT) { transpose_item(F.in[I_WOUT] + (size_t)l * D * D, D, D, (bf16*)(F.ws + WS_WOUT) + (size_t)l * D * D, RowId{0}, scrw, r, F.lane); continue; } r -= I_OUT;
            unsigned char* S13 = (unsigned char*)(F.ws + WS_WSH13) + (size_t)l * 512 * D; bf16* S2 = (bf16*)(F.ws + WS_WSH2) + (size_t)l * D * EH;
            if (r < I_S) { transpose_item8(F.in[I_SW1] + (size_t)l * D * EH, D, EH, S13, RowW13{0}, scrw, r, F.lane, 32.0f); continue; } r -= I_S;
            if (r < I_S) { transpose_item8(F.in[I_SW3] + (size_t)l * D * EH, D, EH, S13, RowW13{1}, scrw, r, F.lane, 32.0f); continue; } r -= I_S;
            transpose_item8(F.in[I_SW2] + (size_t)l * EH * D, EH, D, (unsigned char*)(F.ws + WS_WSH2) + (size_t)l * D * EH, RowId{0}, scrw, r, F.lane, 32.0f);
        }
    }
    convert_experts(F, 0, scrw);
    const int gt = F.bid * NTHREADS + F.tid, NGT = F.G * NTHREADS;
    for (int i = gt; i < 2 * 4 * 128 * 128; i += NGT) ((bf16*)(F.ws + WS_SGUW))[i] = (bf16)f2bf(F.in[I_SGUW][i]);
    for (int i = gt; i < 2 * 64 * 1024; i += NGT) { const int ll = i >> 16, k = (i >> 6) & 1023, n = i & 63; const float v = F.in[I_ROUTERW][i]; const unsigned hb = f2bf(v), lb = f2bf(v - __uint_as_float(hb << 16));
        unsigned short* rw = (unsigned short*)(F.ws + WS_RWT) + (size_t)ll * 131072 + (size_t)(((n >> 4) * 32 + (k >> 5)) * 2) * 512 + 8 * (((k >> 3) & 3) * 16 + (n & 15)) + (k & 7); rw[0] = (unsigned short)hb; rw[512] = (unsigned short)lb; }
    for (int i = gt; i < 2 * 4 * 64 * 64; i += NGT) { const int lg = i / 4096, n = (i / 64) % 64, k = i % 64; ((bf16*)(F.ws + WS_POOLW))[i] = (bf16)f2bf(F.in[I_POOLW][(size_t)lg * 4096 + k * 64 + n]); }
    for (int i = gt; i < 256 * 16; i += NGT) { const int p = i / 16, f = i % 16; const float inv = powf(10000.0f, -(float)f / 16.0f); const float ang = (float)p * inv;
        ((float*)(F.ws + WS_TAB))[2 * i] = cosf(ang); ((float*)(F.ws + WS_TAB))[2 * i + 1] = sinf(ang); }
    for (int i = gt; i < 256 * 8; i += NGT) { const int p = i / 8, f = i % 8; const float inv = powf(10000.0f, -(float)f / 8.0f); const float ang = (float)p * inv;
        ((float*)(F.ws + WS_TABC))[2 * i] = cosf(ang); ((float*)(F.ws + WS_TABC))[2 * i + 1] = sinf(ang); }
    if (gt < 2) { const int l = gt; const float* lq = F.in[I_LAMQK] + l * 128; float s0 = 0.f, s1 = 0.f;
        for (int i = 0; i < 32; ++i) { s0 += lq[i] * lq[32 + i]; s1 += lq[64 + i] * lq[96 + i]; }
        const float lam_init = 0.8f - 0.6f * expf(-0.3f * (float)l);
        float* sc = (float*)(F.ws + WS_SCAL); sc[4 * l] = expf(s0) - expf(s1) + lam_init; sc[4 * l + 1] = lam_init;
        float gq = 0.f, gk = 0.f; for (int i = 0; i < 64; ++i) { gq = fmaxf(gq, fabsf(F.in[I_AQG][l * 64 + i])); gk = fmaxf(gk, fabsf(F.in[I_AKG][l * 64 + i])); }
        sc[4 * l + 2] = fminf(8.0f * gq * gk * LOG2E * 1.01f + 0.01f, 100.0f); }
}

DI void phase_pro_b(const Frame& F) {
    const int gw = F.bid * NWAVES + F.wave, NGW = F.G * NWAVES;
    bf16* ACT = (bf16*)(F.ws + WS_ACT);
    for (int row = gw; row < NTOK; row += NGW) {
        const float* src = row < NLAT ? F.in[I_X] + (size_t)row * D : F.in[I_CTX] + (size_t)(row - NLAT) * D;
        f32x4 v[4]; load_row_f32(src, F.lane, v);
        const float rstd = rsqrtf(row_sumsq(v) * (1.0f / D) + RMS_EPS);
        const int r = mod_row(row);
        norm_mod(v, rstd, F.in[I_GPREMIX], modp(F, 0, r, 0), modp(F, 0, r, 1), F.lane);
        store_row_bf16(ACT + (size_t)row * D, F.lane, v);
    }
}

template <int PX> DI void rope8(float (&x)[8], bool second, const float* tab) {
#pragma unroll
    for (int e = 0; e < 8; ++e) { const float p = shx<PX>(x[e]); const float c = tab[2 * e], s = tab[2 * e + 1]; x[e] = x[e] * c + (second ? p : -p) * s; }
}
DI void unpack8(const u32x4 w, float (&x)[8]) { x[0] = lo16(w.x); x[1] = hi16(w.x); x[2] = lo16(w.y); x[3] = hi16(w.y); x[4] = lo16(w.z); x[5] = hi16(w.z); x[6] = lo16(w.w); x[7] = hi16(w.w); }
DI u32x4 pack8(const float (&x)[8]) { u32x4 w; w.x = pk2(x[0], x[1]); w.y = pk2(x[2], x[3]); w.z = pk2(x[4], x[5]); w.w = pk2(x[6], x[7]); return w; }

#ifndef ATTN_FP8
#define ATTN_FP8 1
#endif
DI u32x2 pack8_fp8(const float (&x)[8]) {
    int w0 = 0, w1 = 0;
    w0 = __builtin_amdgcn_cvt_pk_fp8_f32(x[0], x[1], w0, false); w0 = __builtin_amdgcn_cvt_pk_fp8_f32(x[2], x[3], w0, true);
    w1 = __builtin_amdgcn_cvt_pk_fp8_f32(x[4], x[5], w1, false); w1 = __builtin_amdgcn_cvt_pk_fp8_f32(x[6], x[7], w1, true);
    u32x2 r; r.x = (unsigned)w0; r.y = (unsigned)w1; return r;
}
constexpr int KTILES = KEYS / 64;
DI void phase_post(const Frame& F, int l) {
    const bf16* __restrict__ PJ = (const bf16*)(F.ws + WS_PJ);
    bf16* __restrict__ QA = (bf16*)(F.ws + WS_QA); bf16* __restrict__ KA = (bf16*)(F.ws + WS_KA); bf16* __restrict__ VA = (bf16*)(F.ws + WS_VA);
    bf16* __restrict__ QC = (bf16*)(F.ws + WS_QC); bf16* __restrict__ KC = (bf16*)(F.ws + WS_KC); bf16* __restrict__ VC = (bf16*)(F.ws + WS_VC);
    bf16* __restrict__ Y = (bf16*)(F.ws + WS_Y);
    const float* __restrict__ tabA = (const float*)(F.ws + WS_TAB); const float* __restrict__ tabC = (const float*)(F.ws + WS_TABC);
    constexpr int DSTR = 264, VSTR = 136;
    LAS bf16* DIFF = (LAS bf16*)F.lds;
    LAS bf16* VCT = (LAS bf16*)(F.lds + 128 * DSTR * 2);
    const int lane = F.lane, w = F.wave;
    const int j8 = lane & 7, j4 = lane & 3;
    for (int u = F.bid; u < 260; u += F.G) {
        const bool is_ctx = u >= 256;
        int b, p0, row0, n;
        if (!is_ctx) { b = u / 128; p0 = (u % 128) * 128; row0 = b * SEQ + p0; n = SEQ; }
        else { const int cc = u - 256; b = cc / 2; p0 = (cc % 2) * 128; row0 = NLAT + b * CTXL + p0; n = CTXL; }
        const int seq0 = row0 - p0;
        const bool mix = !(is_ctx && l == 1);
        if (mix) {
#pragma unroll 1
        for (int tg = 0; tg < 4; ++tg) {
            const int tl0 = 16 * w + 4 * tg, pb = p0 + tl0;
            u32x4 raw1[4], raw3[4];
#pragma unroll
            for (int i = 0; i < 4; ++i) { raw1[i] = *(const u32x4*)(PJ + (size_t)(row0 + tl0 + i) * PW + 512 + 8 * lane); raw3[i] = *(const u32x4*)(PJ + (size_t)(row0 + tl0 + i) * PW + 1536 + 8 * lane); }
            float acc[4][8];
#pragma unroll
            for (int i = 0; i < 4; ++i)
#pragma unroll
                for (int e = 0; e < 8; ++e) acc[i][e] = 0.f;
            const int g = (lane >> 3) & 3, half = 1 << g;
#pragma unroll
            for (int o = -8; o < 11; ++o) { const int q = pb + o;
                if (lane < 32 && q >= 0 && q < n && o >= -half && o < 3 + half) { float y[8]; unpack8(*(const u32x4*)(PJ + (size_t)(seq0 + q) * PW + 512 + 8 * lane), y);
#pragma unroll
                    for (int i = 0; i < 4; ++i) if (o - i >= -half && o - i < half) {
#pragma unroll
                        for (int e = 0; e < 8; ++e) acc[i][e] += y[e]; } } }
#pragma unroll
            for (int i = 0; i < 4; ++i) {
                const int tl = tl0 + i, p = pb + i;
                float x[8];
                {
                    unpack8(raw1[i], x);
                    if (lane < 32) { const int lo = max(p - half, 0), hi = min(p + half, n); const float inv = 1.0f / (float)(hi - lo); float d[8];
#pragma unroll
                        for (int e = 0; e < 8; ++e) d[e] = acc[i][e] * inv - x[e];
                        *(LAS u32x4*)(DIFF + tl * DSTR + 8 * lane) = pack8(d); }
                }
                {
                    unpack8(raw3[i], x);
                    float sm = 0.f;
#pragma unroll
                    for (int e = 0; e < 8; ++e) sm += x[e];
                    sm += shx<1>(sm); sm += shx<2>(sm); sm += shx<4>(sm); sm += shx<8>(sm); sm += shx<16>(sm);
                    const float mu = sm * (1.0f / 256.0f); float q2 = 0.f;
#pragma unroll
                    for (int e = 0; e < 8; ++e) { x[e] -= mu; q2 += x[e] * x[e]; }
                    q2 += shx<1>(q2); q2 += shx<2>(q2); q2 += shx<4>(q2); q2 += shx<8>(q2); q2 += shx<16>(q2);
                    const float rstd = rsqrtf(q2 * (1.0f / 256.0f) + LN_EPS);
                    if (lane >= 32) {
#pragma unroll
                        for (int e = 0; e < 8; ++e) VCT[(8 * (lane - 32) + e) * VSTR + tl] = (bf16)f2bf(x[e] * rstd); }
                }
            }
        }
        }
        LDS_WAIT(); __syncthreads();
        if (mix) {
        {
            const bf16* __restrict__ PWt = (const bf16*)(F.ws + WS_POOLW) + (size_t)l * 4 * 4096;
            const int fr = lane & 15, fq = lane >> 4;
            bf16* yrow = Y + (size_t)(row0 + 16 * w + fr) * D + 256;
#pragma unroll 1
            for (int g = 0; g < 4; ++g) {
                bf16x8 a[2];
#pragma unroll
                for (int ks = 0; ks < 2; ++ks) a[ks] = *(const LAS bf16x8*)(DIFF + (16 * w + fr) * DSTR + 64 * g + 32 * ks + 8 * fq);
#pragma unroll
                for (int nb = 0; nb < 4; ++nb) {
                    f32x4 acc = {0.f, 0.f, 0.f, 0.f};
#pragma unroll
                    for (int ks = 0; ks < 2; ++ks) { const bf16x8 bb = *(const bf16x8*)(PWt + (size_t)g * 4096 + (16 * nb + fr) * 64 + 32 * ks + 8 * fq);
                        acc = __builtin_amdgcn_mfma_f32_16x16x32_bf16(bb, a[ks], acc, 0, 0, 0); }
                    const int ch = 64 * g + 16 * nb + 4 * fq; const f32x4 sc = *(const f32x4*)(F.in[I_POOLS] + l * 256 + ch);
                    u32x2 o; o.x = pk2(acc[0] * sc[0], acc[1] * sc[1]); o.y = pk2(acc[2] * sc[2], acc[3] * sc[3]);
                    *(u32x2*)(yrow + ch) = o;
                }
            }
        }
        {
            const bf16* __restrict__ SW = (const bf16*)(F.ws + WS_SGUW) + (size_t)l * 4 * 16384;
            const int fr = lane & 15, fq = lane >> 4, pp = 16 * w + fr;
            bf16* yrow = Y + (size_t)(row0 + pp) * D + 768; const bf16* urow = PJ + (size_t)(row0 + pp) * PW + 1536;
#pragma unroll 1
            for (int h = 0; h < 4; ++h) {
                bf16x8 a[4];
#pragma unroll
                for (int ks = 0; ks < 4; ++ks) a[ks] = *(const bf16x8*)(SW + (size_t)h * 16384 + pp * 128 + 32 * ks + 8 * fq);
                const float bias = F.in[I_SGUB][(l * 4 + h) * 128 + pp];
#pragma unroll
                for (int nb = 0; nb < 4; ++nb) {
                    f32x4 acc = {0.f, 0.f, 0.f, 0.f};
#pragma unroll
                    for (int ks = 0; ks < 4; ++ks) { const bf16x8 bb = *(const LAS bf16x8*)(VCT + (64 * h + 16 * nb + fr) * VSTR + 32 * ks + 8 * fq);
                        acc = __builtin_amdgcn_mfma_f32_16x16x32_bf16(bb, a[ks], acc, 0, 0, 0); }
                    const int ch = 64 * h + 16 * nb + 4 * fq; const u32x2 uu = *(const u32x2*)(urow + ch);
                    u32x2 o; o.x = pk2(lo16(uu.x) * (acc[0] + bias), hi16(uu.x) * (acc[1] + bias)); o.y = pk2(lo16(uu.y) * (acc[2] + bias), hi16(uu.y) * (acc[3] + bias));
                    *(u32x2*)(yrow + ch) = o;
                }
            }
        }
        }
        __syncthreads();
#if ATTN_FP8
        {
            constexpr int SVSTR = 386;
            LAS bf16* SV = (LAS bf16*)F.lds;
            for (int pc = F.tid; pc < 128 * 48; pc += NTHREADS) { const int tk = pc / 48, c8 = pc % 48;
                const u32x4 v = *(const u32x4*)(PJ + (size_t)(row0 + tk) * PW + (c8 < 16 ? 384 + 8 * c8 : 1280 + 8 * (c8 - 16)));
                LAS unsigned* d32 = (LAS unsigned*)(SV + tk * SVSTR + 8 * c8); d32[0] = v.x; d32[1] = v.y; d32[2] = v.z; d32[3] = v.w; }
            LDS_WAIT(); __syncthreads();
            const int tb = is_ctx ? (p0 >> 6) : 4 + (p0 >> 6);
            for (int id = F.tid; id < 6 * 2 * 64 * 4; id += NTHREADS) {
                const int c16 = id & 3, d = (id >> 2) & 63, tt = (id >> 8) & 1, hb = id >> 9;
                float xv[16];
#pragma unroll
                for (int e = 0; e < 16; ++e) { const int pos = 16 * c16 + e; const int key = 32 * ((pos >> 4) & 1) + 8 * ((pos >> 2) & 3) + 4 * (pos >> 5) + (pos & 3);
                    xv[e] = bf2f(SV[(64 * tt + key) * SVSTR + 64 * hb + d]); }
                float x0[8], x1[8];
#pragma unroll
                for (int e = 0; e < 8; ++e) { x0[e] = xv[e]; x1[e] = xv[8 + e]; }
                const u32x2 a = pack8_fp8(x0), c = pack8_fp8(x1); u32x4 o; o.x = a.x; o.y = a.y; o.z = c.x; o.w = c.y;
                unsigned char* dst = hb < 2 ? (unsigned char*)VA + ((size_t)(b * 2 + hb) * KTILES + tb + tt) * 4096 : (unsigned char*)VC + ((size_t)(b * 4 + (hb - 2)) * KTILES + tb + tt) * 4096;
                *(u32x4*)(dst + d * 64 + 16 * c16) = o;
            }
            __syncthreads();
        }
#endif
    }
    {
        const int skip = 260 - F.G > 0 ? 260 - F.G : 0;
        const bool takes = F.G <= 2 * skip ? true : F.bid >= skip;
        const int nb_ = F.G <= 2 * skip ? F.G : F.G - skip, ib_ = F.G <= 2 * skip ? F.bid : F.bid - skip;
        float g0[8];
        { const float* g = (lane < 32 ? F.in[I_AQG] : F.in[I_AKG]) + l * 64 + 8 * j8;
#pragma unroll
          for (int e = 0; e < 8; ++e) g0[e] = (lane < 48) ? g[e] : 1.0f; }
        float kmax2 = 0.f; int kb_ = -1;
        if (takes)
#pragma unroll 1
        for (int grp = ib_ * NWAVES + w; grp < NTOK / 4; grp += nb_ * NWAVES) {
            const int rowg = 4 * grp; const bool is_ctx = rowg >= NLAT;
            const int b = is_ctx ? (rowg - NLAT) / CTXL : rowg / SEQ, pb = is_ctx ? (rowg - NLAT) % CTXL : rowg % SEQ;
            if (b != kb_) { if (kb_ >= 0 && lane < 32 && (lane & 3) == 0) atomicMax((int*)(F.ws + WS_CTL) + CW_MAXK + 16 * (((l * 2 + kb_) * 4 + (lane >> 3)) * 2 + ((lane >> 2) & 1)), __float_as_int(kmax2)); kmax2 = 0.f; kb_ = b; }
            u32x4 raw[4][3];
#pragma unroll
            for (int i = 0; i < 4; ++i)
#pragma unroll
                for (int sg = 0; sg < 3; ++sg) raw[i][sg] = *(const u32x4*)(PJ + (size_t)(rowg + i) * PW + 512 * sg + 8 * lane);
#pragma unroll
            for (int i = 0; i < 4; ++i) {
                const int p = pb + i;
                const int qpos = is_ctx ? SEQ + p : p, kpos = is_ctx ? p : CTXL + p;
                const int prow = p >> 6, pcol = p & 63;
                float x[8];
                {
                    unpack8(raw[i][0], x);
                    float ss = 0.f;
#pragma unroll
                    for (int e = 0; e < 8; ++e) ss += x[e] * x[e];
                    ss += shx<1>(ss); ss += shx<2>(ss); ss += shx<4>(ss);
                    const float rstd = (lane < 48) ? rsqrtf(ss * (1.0f / 64.0f) + RMS_EPS) : 1.0f;
#pragma unroll
                    for (int e = 0; e < 8; ++e) x[e] = x[e] * rstd * g0[e];
                    if (!is_ctx) { float xr[8];
#pragma unroll
                        for (int e = 0; e < 8; ++e) xr[e] = x[e];
                        rope8<2>(xr, (j8 & 2) != 0, tabA + ((size_t)((j8 & 4) ? pcol : prow) * 16 + 8 * (j8 & 1)) * 2);
                        if (lane < 48) {
#pragma unroll
                            for (int e = 0; e < 8; ++e) x[e] = xr[e]; } }
                    if (lane < 32) {
#pragma unroll
                        for (int e = 0; e < 8; ++e) x[e] *= (ATTN_FP8 ? LOG2E : QA_SCALE); }
#if ATTN_FP8
                    if (lane < 32) *(u32x2*)((unsigned char*)QA + ((size_t)(b * 4 + (lane >> 3)) * QROWS + qpos) * 64 + 8 * j8) = pack8_fp8(x);
                    else if (lane < 48) *(u32x2*)((unsigned char*)KA + ((size_t)(b * 2 + ((lane - 32) >> 3)) * KEYS + kpos) * 64 + 8 * j8) = pack8_fp8(x);
#else
                    bf16* dst;
                    if (lane < 32) dst = QA + ((size_t)(b * 4 + (lane >> 3)) * QROWS + qpos) * 64 + 8 * j8;
                    else if (lane < 48) dst = KA + ((size_t)(b * 2 + ((lane - 32) >> 3)) * KEYS + kpos) * 64 + 8 * j8;
                    else dst = VA + ((size_t)(b * 2 + ((lane - 48) >> 3)) * KEYS + kpos) * 64 + 8 * j8;
                    *(u32x4*)dst = (lane < 48) ? pack8(x) : raw[i][0];
#endif
                }
                {
                    unpack8(raw[i][1], x);
                    if (!is_ctx) rope8<1>(x, (j4 & 1) != 0, tabC + ((size_t)((j4 & 2) ? pcol : prow) * 8) * 2);
                    if (lane >= 32) {
#pragma unroll
                        for (int e = 0; e < 8; ++e) x[e] *= QC_SCALE;
                        const int hh = (lane - 32) >> 3;
#if ATTN_FP8
                        *(u32x2*)((unsigned char*)QC + ((size_t)(b * 4 + hh) * QROWS + qpos) * 64 + 8 * j8) = pack8_fp8(x);
#else
                        *(u32x4*)(QC + ((size_t)(b * 4 + hh) * QROWS + qpos) * 64 + 8 * j8) = pack8(x);
#endif
                    }
                }
                {
                    unpack8(raw[i][2], x);
                    if (!is_ctx) { float xr[8];
#pragma unroll
                        for (int e = 0; e < 8; ++e) xr[e] = x[e];
                        rope8<1>(xr, (j4 & 1) != 0, tabC + ((size_t)((j4 & 2) ? pcol : prow) * 8) * 2);
                        if (lane < 32) {
#pragma unroll
                            for (int e = 0; e < 8; ++e) x[e] = xr[e]; } }
                    { float n2 = 0.f;
#pragma unroll
                        for (int e = 0; e < 8; ++e) n2 += x[e] * x[e];
                        n2 += shx<1>(n2); n2 += shx<2>(n2); kmax2 = fmaxf(kmax2, n2); }
#if ATTN_FP8
                    if (lane < 32) { const int hh = lane >> 3;
                        *(u32x2*)((unsigned char*)KC + ((size_t)(b * 4 + hh) * KEYS + kpos) * 64 + 8 * j8) = pack8_fp8(x); }
#else
                    if (lane < 32) { const int hh = lane >> 3;
                        *(u32x4*)(KC + ((size_t)(b * 4 + hh) * KEYS + kpos) * 64 + 8 * j8) = pack8(x); }
                    else { const int hh = (lane - 32) >> 3;
                        *(u32x4*)(VC + ((size_t)(b * 4 + hh) * KEYS + kpos) * 64 + 8 * j8) = raw[i][2]; }
#endif
                }
            }
        }
        if (kb_ >= 0 && lane < 32 && (lane & 3) == 0) atomicMax((int*)(F.ws + WS_CTL) + CW_MAXK + 16 * (((l * 2 + kb_) * 4 + (lane >> 3)) * 2 + ((lane >> 2) & 1)), __float_as_int(kmax2));
    }
}

template <int QD>
DI void attn_naive_pass(const Frame& F, const bf16* Qrow, const bf16* Kb, const bf16* Vb, int nkeys, float (&o)[64]) {
    LAS float* Ks = (LAS float*)F.lds;
    LAS float* Vs = (LAS float*)(F.lds + 2 * 64 * QD * 4);
    LAS float* MG = (LAS float*)(F.lds + 65536);
    const int r = F.tid & 255, half = F.tid >> 8;
    float q[QD];
#pragma unroll
    for (int i = 0; i < QD / 8; ++i) { float x[8]; unpack8(*(const u32x4*)(Qrow + 8 * i), x);
#pragma unroll
        for (int e = 0; e < 8; ++e) q[8 * i + e] = x[e]; }
#pragma unroll
    for (int d = 0; d < 64; ++d) o[d] = 0.f;
    float m = -1e30f, lsum = 0.f;
    const int kh = nkeys / 2, kbeg = half * kh, ntile = kh / 64;
    for (int t = 0; t < ntile; ++t) {
        __syncthreads();
        const int key0 = kbeg + t * 64;
        for (int pc = r; pc < 64 * QD / 8; pc += 256) { const int kk = pc / (QD / 8), c = pc % (QD / 8); float x[8]; unpack8(*(const u32x4*)(Kb + (size_t)(key0 + kk) * 64 + 8 * c), x);
#pragma unroll
            for (int e = 0; e < 8; ++e) Ks[(half * 64 + kk) * QD + 8 * c + e] = x[e]; }
        for (int pc = r; pc < 512; pc += 256) { const int kk = pc / 8, c = pc % 8; float x[8]; unpack8(*(const u32x4*)(Vb + (size_t)(key0 + kk) * 64 + 8 * c), x);
#pragma unroll
            for (int e = 0; e < 8; ++e) Vs[(half * 64 + kk) * 64 + 8 * c + e] = x[e]; }
        __syncthreads();
#pragma unroll 2
        for (int j = 0; j < 64; ++j) {
            const LAS float* kr = Ks + (half * 64 + j) * QD; float s = 0.f;
#pragma unroll
            for (int d = 0; d < QD; ++d) s += q[d] * kr[d];
            if (s > m) { const float a = exp2f(m - s); lsum *= a;
#pragma unroll
                for (int d = 0; d < 64; ++d) o[d] *= a;
                m = s; }
            const float pp = exp2f(s - m); lsum += pp;
            const LAS float* vr = Vs + (half * 64 + j) * 64;
#pragma unroll
            for (int d = 0; d < 64; ++d) o[d] += pp * vr[d];
        }
    }
    __syncthreads();
    if (half == 1) { MG[r * 66] = m; MG[r * 66 + 1] = lsum;
#pragma unroll
        for (int d = 0; d < 64; ++d) MG[r * 66 + 2 + d] = o[d]; }
    __syncthreads();
    if (half == 0) { const float m1 = MG[r * 66], l1 = MG[r * 66 + 1]; const float mm = fmaxf(m, m1); const float a0 = exp2f(m - mm), a1 = exp2f(m1 - mm);
        const float inv = 1.0f / (lsum * a0 + l1 * a1);
#pragma unroll
        for (int d = 0; d < 64; ++d) o[d] = (o[d] * a0 + MG[r * 66 + 2 + d] * a1) * inv; }
    __syncthreads();
}
DI void phase_attn_naive(const Frame& F, int l) {
    const bf16* QA = (const bf16*)(F.ws + WS_QA); const bf16* KA = (const bf16*)(F.ws + WS_KA); const bf16* VA = (const bf16*)(F.ws + WS_VA);
    const bf16* QC = (const bf16*)(F.ws + WS_QC); const bf16* KC = (const bf16*)(F.ws + WS_KC); const bf16* VC = (const bf16*)(F.ws + WS_VC);
    bf16* Y = (bf16*)(F.ws + WS_Y);
    const float lam = ((const float*)(F.ws + WS_SCAL))[4 * l], lam_init = ((const float*)(F.ws + WS_SCAL))[4 * l + 1];
    const int r = F.tid & 255, half = F.tid >> 8;
    const int nqt = (l == 0) ? 65 : 64;
    const int nunits = 2 * NB * 4 * nqt;
    for (int u = F.bid; u < nunits; u += F.G) {
        const int kind = u / (NB * 4 * nqt), v = u % (NB * 4 * nqt), qt = v % nqt, bh = v / nqt, b = bh / 4, h = bh % 4;
        const int nkeys = (qt == 64) ? CTXL : KEYS;
        const int qpos = qt * 256 + r;
        const int orow = (qt == 64) ? NLAT + b * CTXL + r : b * SEQ + qt * 256 + r;
        float o[64];
        if (kind == 0) {
            attn_naive_pass<64>(F, QA + ((size_t)(b * 4 + h) * QROWS + qpos) * 64, KA + (size_t)(b * 2 + h / 2) * KEYS * 64, VA + (size_t)(b * 2 + h / 2) * KEYS * 64, nkeys, o);
            if (half == 0) {
#pragma unroll
                for (int i = 0; i < 8; ++i) { float x[8];
#pragma unroll
                    for (int e = 0; e < 8; ++e) x[e] = o[8 * i + e];
                    *(u32x4*)(Y + (size_t)orow * D + h * 64 + 8 * i) = pack8(x); } }
        } else {
            float o0[64];
            attn_naive_pass<32>(F, QC + ((size_t)(b * 4 + h) * QROWS + qpos) * 64, KC + (size_t)(b * 4 + h) * KEYS * 64, VC + (size_t)(b * 4 + h) * KEYS * 64, nkeys, o0);
            attn_naive_pass<32>(F, QC + ((size_t)(b * 4 + h) * QROWS + qpos) * 64 + 32, KC + (size_t)(b * 4 + h) * KEYS * 64 + 32, VC + (size_t)(b * 4 + h) * KEYS * 64, nkeys, o);
            if (half == 0) { float ss = 0.f;
#pragma unroll
                for (int d = 0; d < 64; ++d) { o[d] = o0[d] - lam * o[d]; ss += o[d] * o[d]; }
                const float rstd = rsqrtf(ss * (1.0f / 64.0f) + RMS_EPS) * (1.0f - lam_init);
#pragma unroll
                for (int i = 0; i < 8; ++i) { float x[8];
#pragma unroll
                    for (int e = 0; e < 8; ++e) x[e] = o[8 * i + e] * rstd * F.in[I_CSUBLN][l * 64 + 8 * i + e];
                    *(u32x4*)(Y + (size_t)orow * D + 512 + h * 64 + 8 * i) = pack8(x); } }
        }
    }
}


typedef float f32x16 __attribute__((ext_vector_type(16)));
typedef short s16x4 __attribute__((ext_vector_type(4)));
typedef __bf16 bf16x2_t __attribute__((ext_vector_type(2)));
DI unsigned cvtpk_s(float lo, float hi) { f32x2 v = {lo, hi}; bf16x2_t b = __builtin_convertvector(v, bf16x2_t); return __builtin_bit_cast(unsigned, b); }
DI s16x4 vtr(const LAS unsigned char* p) { return __builtin_bit_cast(s16x4, __builtin_amdgcn_ds_read_tr16_b64_v4i16((LAS s16x4*)p)); }
constexpr int ATT_KSTR = 144, ATT_KB = 64 * ATT_KSTR, ATT_VB = 64 * 128, ATT_BUF = ATT_KB + ATT_VB;
DI void softmax_block(const f32x16& S, float& lsum, bf16x8 (&P)[2]) {
    float p[16];
#pragma unroll
    for (int r = 0; r < 16; ++r) { p[r] = __builtin_amdgcn_exp2f(S[r]); lsum += p[r]; }
#pragma unroll
    for (int st = 0; st < 2; ++st) { u32x4 w; w.x = cvtpk_s(p[8 * st + 0], p[8 * st + 1]); w.y = cvtpk_s(p[8 * st + 2], p[8 * st + 3]); w.z = cvtpk_s(p[8 * st + 4], p[8 * st + 5]); w.w = cvtpk_s(p[8 * st + 6], p[8 * st + 7]);
        P[st] = __builtin_bit_cast(bf16x8, w); }
}
DI void pv_tile(f32x16 (&O)[2], const LAS unsigned char* vbase0, const LAS unsigned char* vbase1, const bf16x8 (&P0)[2], const bf16x8 (&P1)[2]) {
#pragma unroll
    for (int kb = 0; kb < 2; ++kb)
#pragma unroll
        for (int st = 0; st < 2; ++st) {
            const int ro = (32 * kb + 16 * st) * 128;
            const s16x4 a0 = vtr(vbase0 + ro), a1 = vtr(vbase0 + ro + 8 * 128), b0 = vtr(vbase1 + ro), b1 = vtr(vbase1 + ro + 8 * 128);
            const bf16x8 v0 = {a0[0], a0[1], a0[2], a0[3], a1[0], a1[1], a1[2], a1[3]}, v1 = {b0[0], b0[1], b0[2], b0[3], b1[0], b1[1], b1[2], b1[3]};
            const bf16x8 pp = kb == 0 ? P0[st] : P1[st];
            O[0] = __builtin_amdgcn_mfma_f32_32x32x16_bf16(v0, pp, O[0], 0, 0, 0);
            O[1] = __builtin_amdgcn_mfma_f32_32x32x16_bf16(v1, pp, O[1], 0, 0, 0);
        }
}
template <int KIND>
DI void attn_unit(const Frame& F, const bf16* Qb, const bf16* Kb, const bf16* Vb, int ntiles, float bound_in, bf16* Yb, float lam, const float* gain, float post) {
    const int lane = F.lane, w = F.wave, tid = F.tid, q32 = lane & 31, h = lane >> 5;
    LAS unsigned char* lds = F.lds;
    bf16x8 qf[4];
#pragma unroll
    for (int kk = 0; kk < 4; ++kk) qf[kk] = *(const bf16x8*)(Qb + (size_t)(32 * w + q32) * 64 + 16 * kk + 8 * h);
    float bound = bound_in;
    if (KIND == 1) {
        float n0 = 0.f, n1 = 0.f;
#pragma unroll
        for (int kk = 0; kk < 4; ++kk)
#pragma unroll
            for (int e = 0; e < 8; ++e) { const float v = bf2f((unsigned short)qf[kk][e]); if (kk < 2) n0 += v * v; else n1 += v * v; }
        n0 = xadd32(n0); n1 = xadd32(n1);
        bound = sqrtf(fmaxf(n0, n1)) * bound_in * 1.01f + 0.01f;
    }
    f32x16 cinit;
#pragma unroll
    for (int r = 0; r < 16; ++r) cinit[r] = -bound;
    asm volatile("" : "+v"(cinit));
    f32x16 O0[2], O1[2];
#pragma unroll
    for (int db = 0; db < 2; ++db)
#pragma unroll
        for (int r = 0; r < 16; ++r) { O0[db][r] = 0.f; O1[db][r] = 0.f; }
    float l0 = 0.f, l1 = 0.f;
    const int srow = tid >> 3, sc = tid & 7;
    const unsigned kw = (unsigned)(srow * ATT_KSTR + sc * 16), vw = (unsigned)(ATT_KB + srow * 128 + ((sc ^ (((srow >> 1) & 1) << 2)) * 16));
    const bf16* kg = Kb + (size_t)srow * 64 + sc * 8; const bf16* vg = Vb + (size_t)srow * 64 + sc * 8;
    const unsigned kr = (unsigned)(q32 * ATT_KSTR + 16 * h);
    const int qq = (lane & 15) >> 2, pp4 = lane & 3, dsub = (lane >> 4) & 1, sw = (qq >> 1) & 1;
    const unsigned vr0 = (unsigned)(ATT_KB + (4 * h + qq) * 128 + ((0 ^ sw) * 64) + (16 * dsub + 4 * pp4) * 2);
    const unsigned vr1 = (unsigned)(ATT_KB + (4 * h + qq) * 128 + ((1 ^ sw) * 64) + (16 * dsub + 4 * pp4) * 2);
    u32x4 kreg = *(const u32x4*)kg, vreg = *(const u32x4*)vg;
    *(LAS u32x4*)(lds + kw) = kreg; *(LAS u32x4*)(lds + vw) = vreg;
    if (ntiles > 1) { kreg = *(const u32x4*)(kg + 64 * 64); vreg = *(const u32x4*)(vg + 64 * 64); }
#pragma unroll 1
    for (int t = 0; t < ntiles; ++t) {
        __syncthreads();
        const unsigned cb = (unsigned)((t & 1) * ATT_BUF), nb = (unsigned)(((t + 1) & 1) * ATT_BUF);
        if (t + 1 < ntiles) {
            *(LAS u32x4*)(lds + nb + kw) = kreg; *(LAS u32x4*)(lds + nb + vw) = vreg;
            if (t + 2 < ntiles) { kreg = *(const u32x4*)(kg + (size_t)(t + 2) * 64 * 64); vreg = *(const u32x4*)(vg + (size_t)(t + 2) * 64 * 64); }
        }
        const LAS unsigned char* kp = lds + cb + kr;
        if (KIND == 0) {
            f32x16 S0 = cinit, S1 = cinit;
#pragma unroll
            for (int kk = 0; kk < 4; ++kk) {
                const bf16x8 a0 = *(const LAS bf16x8*)(kp + 32 * kk), a1 = *(const LAS bf16x8*)(kp + 32 * ATT_KSTR + 32 * kk);
                S0 = __builtin_amdgcn_mfma_f32_32x32x16_bf16(a0, qf[kk], S0, 0, 0, 0);
                S1 = __builtin_amdgcn_mfma_f32_32x32x16_bf16(a1, qf[kk], S1, 0, 0, 0);
            }
            bf16x8 P0[2], P1[2];
            softmax_block(S0, l0, P0); softmax_block(S1, l0, P1);
            pv_tile(O0, lds + cb + vr0, lds + cb + vr1, P0, P1);
        } else {
#pragma unroll
            for (int c = 0; c < 2; ++c) {
                f32x16 S0 = cinit, S1 = cinit;
#pragma unroll
                for (int k2 = 0; k2 < 2; ++k2) { const int kk = 2 * c + k2;
                    const bf16x8 a0 = *(const LAS bf16x8*)(kp + 32 * kk), a1 = *(const LAS bf16x8*)(kp + 32 * ATT_KSTR + 32 * kk);
                    S0 = __builtin_amdgcn_mfma_f32_32x32x16_bf16(a0, qf[kk], S0, 0, 0, 0);
                    S1 = __builtin_amdgcn_mfma_f32_32x32x16_bf16(a1, qf[kk], S1, 0, 0, 0);
                }
                bf16x8 P0[2], P1[2];
                if (c == 0) { softmax_block(S0, l0, P0); softmax_block(S1, l0, P1); pv_tile(O0, lds + cb + vr0, lds + cb + vr1, P0, P1); }
                else { softmax_block(S0, l1, P0); softmax_block(S1, l1, P1); pv_tile(O1, lds + cb + vr0, lds + cb + vr1, P0, P1); }
                __builtin_amdgcn_sched_barrier(0);
            }
        }
    }
    l0 = xadd32(l0);
    bf16* yrow = Yb + (size_t)(32 * w + q32) * D;
    if (KIND == 0) {
        const float inv = 1.0f / l0;
#pragma unroll
        for (int db = 0; db < 2; ++db)
#pragma unroll
            for (int g = 0; g < 4; ++g) { u32x2 o; o.x = pk2(O0[db][4 * g] * inv, O0[db][4 * g + 1] * inv); o.y = pk2(O0[db][4 * g + 2] * inv, O0[db][4 * g + 3] * inv);
                *(u32x2*)(yrow + 32 * db + 8 * g + 4 * h) = o; }
    } else {
        l1 = xadd32(l1);
        const float i0 = 1.0f / l0, i1 = lam / l1; float ss = 0.f;
#pragma unroll
        for (int db = 0; db < 2; ++db)
#pragma unroll
            for (int r = 0; r < 16; ++r) { const float v = O0[db][r] * i0 - O1[db][r] * i1; O0[db][r] = v; ss += v * v; }
        ss = xadd32(ss);
        const float rstd = rsqrtf(ss * (1.0f / 64.0f) + RMS_EPS) * post;
#pragma unroll
        for (int db = 0; db < 2; ++db)
#pragma unroll
            for (int g = 0; g < 4; ++g) { const f32x4 gg = *(const f32x4*)(gain + 32 * db + 8 * g + 4 * h); u32x2 o;
                o.x = pk2(O0[db][4 * g] * rstd * gg[0], O0[db][4 * g + 1] * rstd * gg[1]); o.y = pk2(O0[db][4 * g + 2] * rstd * gg[2], O0[db][4 * g + 3] * rstd * gg[3]);
                *(u32x2*)(yrow + 32 * db + 8 * g + 4 * h) = o; }
    }
    __syncthreads();
}
DI void phase_attn(const Frame& F, int l) {
    const bf16* QA = (const bf16*)(F.ws + WS_QA); const bf16* KA = (const bf16*)(F.ws + WS_KA); const bf16* VA = (const bf16*)(F.ws + WS_VA);
    const bf16* QC = (const bf16*)(F.ws + WS_QC); const bf16* KC = (const bf16*)(F.ws + WS_KC); const bf16* VC = (const bf16*)(F.ws + WS_VC);
    bf16* Y = (bf16*)(F.ws + WS_Y);
    const float* sc = (const float*)(F.ws + WS_SCAL);
    const float lam = sc[4 * l], lam_init = sc[4 * l + 1], boundA = sc[4 * l + 2];
    const int* MAXK = (const int*)(F.ws + WS_CTL) + CW_MAXK;
    const int nmain = 2 * NB * 4 * 64, nctx = (l == 0) ? 2 * NB * 4 : 0;
    for (int u = F.bid; u < nmain + nctx; u += F.G) {
        int kind, b, h, qt;
        if (u < nmain) { kind = u / (NB * 4 * 64); const int v = u % (NB * 4 * 64); b = v / 256; h = (v / 64) % 4; qt = v % 64; }
        else { const int v = u - nmain; kind = v / (NB * 4); b = (v / 4) % NB; h = v % 4; qt = 64; }
        const int ntiles = (qt == 64) ? CTXL / 64 : KEYS / 64;
        const int orow0 = (qt == 64) ? NLAT + b * CTXL : b * SEQ + qt * 256;
        const Frame U = fresh(F);
#ifdef ATT_ONLY_C
        if (false) {}
#else
        if (kind == 0) attn_unit<0>(U, QA + ((size_t)(b * 4 + h) * QROWS + qt * 256) * 64, KA + (size_t)(b * 2 + h / 2) * KEYS * 64, VA + (size_t)(b * 2 + h / 2) * KEYS * 64, ntiles, boundA,
                                    Y + (size_t)orow0 * D + h * 64, 0.f, nullptr, 0.f);
#endif
#ifndef ATT_ONLY_A
        else { const int mi = ((l * 2 + b) * 4 + h) * 2; const float mk = sqrtf(fmaxf(__int_as_float(MAXK[16 * mi]), __int_as_float(MAXK[16 * (mi + 1)])));
            attn_unit<1>(U, QC + ((size_t)(b * 4 + h) * QROWS + qt * 256) * 64, KC + (size_t)(b * 4 + h) * KEYS * 64, VC + (size_t)(b * 4 + h) * KEYS * 64, ntiles, mk,
                         Y + (size_t)orow0 * D + 512 + h * 64, lam, F.in[I_CSUBLN] + l * 64, 1.0f - lam_init); }
#endif
    }
}


typedef int v8i __attribute__((ext_vector_type(8)));
constexpr int A8_STR = 80, A8_K = 64 * A8_STR, A8_BUF = 2 * A8_K;
constexpr float P_OFFS = 14.0f;
constexpr int SC_ONE = 0x7f7f7f7f, SC_EIGHTH = 0x7c7c7c7c;
DI v8i lds32(const LAS unsigned char* p) { const u32x4 a = *(const LAS u32x4*)p, b = *(const LAS u32x4*)(p + 16); v8i r = {(int)a.x, (int)a.y, (int)a.z, (int)a.w, (int)b.x, (int)b.y, (int)b.z, (int)b.w}; return r; }
DI void softmax8(const f32x16& S0, const f32x16& S1, float& lsum, v8i& P) {
#pragma unroll
    for (int kb = 0; kb < 2; ++kb)
#pragma unroll
        for (int g = 0; g < 4; ++g) { const f32x16& S = kb ? S1 : S0;
            const float p0 = __builtin_amdgcn_exp2f(S[4 * g]), p1 = __builtin_amdgcn_exp2f(S[4 * g + 1]), p2 = __builtin_amdgcn_exp2f(S[4 * g + 2]), p3 = __builtin_amdgcn_exp2f(S[4 * g + 3]);
            lsum += (p0 + p1) + (p2 + p3);
            int wv = 0; wv = __builtin_amdgcn_cvt_pk_bf8_f32(p0, p1, wv, false); wv = __builtin_amdgcn_cvt_pk_bf8_f32(p2, p3, wv, true);
            P[4 * kb + g] = wv; }
}
template <int KIND>
DI void attn8_unit(const Frame& F, const unsigned char* Q8, const unsigned char* K8, const unsigned char* V8, int ntiles, float bound_in, bf16* Yb, float lam, const float* gain, float post) {
    const int lane = F.lane, w = F.wave, tid = F.tid, q32 = lane & 31, h = lane >> 5;
    LAS unsigned char* lds = F.lds;
    const unsigned char* qrow = Q8 + (unsigned)((32 * w + q32) * 64);
    v8i qa; long qc[2][2];
    float bound = bound_in;
    if (KIND == 0) { const u32x4 a = *(const u32x4*)(qrow + 32 * h), b2 = *(const u32x4*)(qrow + 32 * h + 16); qa = (v8i){(int)a.x, (int)a.y, (int)a.z, (int)a.w, (int)b2.x, (int)b2.y, (int)b2.z, (int)b2.w}; }
    else {
        float n0 = 0.f, n1 = 0.f;
#pragma unroll
        for (int c = 0; c < 2; ++c)
#pragma unroll
            for (int kk = 0; kk < 2; ++kk) { const u32x2 v = *(const u32x2*)(qrow + 32 * c + 16 * kk + 8 * h); qc[c][kk] = (long)(((unsigned long long)v.y << 32) | v.x);
                { const float a0 = __builtin_amdgcn_cvt_f32_fp8((int)v.x, 0), a1 = __builtin_amdgcn_cvt_f32_fp8((int)v.x, 1), a2 = __builtin_amdgcn_cvt_f32_fp8((int)v.x, 2), a3 = __builtin_amdgcn_cvt_f32_fp8((int)v.x, 3);
                  const float b0 = __builtin_amdgcn_cvt_f32_fp8((int)v.y, 0), b1 = __builtin_amdgcn_cvt_f32_fp8((int)v.y, 1), b2 = __builtin_amdgcn_cvt_f32_fp8((int)v.y, 2), b3 = __builtin_amdgcn_cvt_f32_fp8((int)v.y, 3);
                  const float nn = (a0 * a0 + a1 * a1) + (a2 * a2 + a3 * a3) + (b0 * b0 + b1 * b1) + (b2 * b2 + b3 * b3); if (c == 0) n0 += nn; else n1 += nn; } }
        n0 = xadd32(n0); n1 = xadd32(n1);
        bound = sqrtf(fmaxf(n0, n1)) * bound_in * 1.15f + 0.1f;
    }
    f32x16 cinit;
#pragma unroll
    for (int r = 0; r < 16; ++r) cinit[r] = P_OFFS - bound;
    asm volatile("" : "+v"(cinit));
    f32x16 O0[2], O1[2];
#pragma unroll
    for (int db = 0; db < 2; ++db)
#pragma unroll
        for (int r = 0; r < 16; ++r) { O0[db][r] = 0.f; O1[db][r] = 0.f; }
    float l0 = 0.f, l1 = 0.f;
    const int which = tid >> 8, srow = (tid & 255) >> 2, sc = tid & 3;
    const unsigned sw = (unsigned)(which * A8_K + srow * A8_STR + sc * 16), goff = (unsigned)(srow * 64 + sc * 16);
    const unsigned char* gsrc = which ? V8 : K8;
#define TLD(t_) (*(const u32x4*)(gsrc + (size_t)(t_) * 4096 + goff))
    const unsigned kr = (unsigned)(q32 * A8_STR), vr = (unsigned)(A8_K + q32 * A8_STR + 32 * h);
    u32x4 treg0 = TLD(0), treg1 = TLD(1);
    *(LAS u32x4*)(lds + sw) = treg0; *(LAS u32x4*)(lds + A8_BUF + sw) = treg1;
    if (ntiles > 2) { treg0 = TLD(2); treg1 = TLD(3); }
#pragma unroll 1
    for (int t = 0; t < ntiles; t += 2) {
        __syncthreads();
        const unsigned pb_ = (unsigned)(((t >> 1) & 1) * 2 * A8_BUF), nb = (unsigned)((((t >> 1) + 1) & 1) * 2 * A8_BUF);
        if (t + 2 < ntiles) { *(LAS u32x4*)(lds + nb + sw) = treg0; *(LAS u32x4*)(lds + nb + A8_BUF + sw) = treg1; if (t + 4 < ntiles) { treg0 = TLD(t + 4); treg1 = TLD(t + 5); } }
        if (KIND == 0) {
            const unsigned cb1 = pb_ + (unsigned)A8_BUF;
            const v8i ka0 = lds32(lds + pb_ + kr + 32 * h), ka1 = lds32(lds + pb_ + kr + 32 * A8_STR + 32 * h);
            const v8i kb0 = lds32(lds + cb1 + kr + 32 * h), kb1 = lds32(lds + cb1 + kr + 32 * A8_STR + 32 * h);
            const f32x16 Sa0 = __builtin_amdgcn_mfma_scale_f32_32x32x64_f8f6f4(ka0, qa, cinit, 0, 0, 0, SC_ONE, 0, SC_EIGHTH);
            const f32x16 Sa1 = __builtin_amdgcn_mfma_scale_f32_32x32x64_f8f6f4(ka1, qa, cinit, 0, 0, 0, SC_ONE, 0, SC_EIGHTH);
            const f32x16 Sb0 = __builtin_amdgcn_mfma_scale_f32_32x32x64_f8f6f4(kb0, qa, cinit, 0, 0, 0, SC_ONE, 0, SC_EIGHTH);
            const f32x16 Sb1 = __builtin_amdgcn_mfma_scale_f32_32x32x64_f8f6f4(kb1, qa, cinit, 0, 0, 0, SC_ONE, 0, SC_EIGHTH);
            { const v8i vf0 = lds32(lds + pb_ + vr), vf1 = lds32(lds + pb_ + vr + 32 * A8_STR);
              v8i P; softmax8(Sa0, Sa1, l0, P);
              O0[0] = __builtin_amdgcn_mfma_scale_f32_32x32x64_f8f6f4(vf0, P, O0[0], 0, 1, 0, SC_ONE, 0, SC_ONE);
              O0[1] = __builtin_amdgcn_mfma_scale_f32_32x32x64_f8f6f4(vf1, P, O0[1], 0, 1, 0, SC_ONE, 0, SC_ONE); }
            { const v8i vf0 = lds32(lds + cb1 + vr), vf1 = lds32(lds + cb1 + vr + 32 * A8_STR);
              v8i P; softmax8(Sb0, Sb1, l0, P);
              O0[0] = __builtin_amdgcn_mfma_scale_f32_32x32x64_f8f6f4(vf0, P, O0[0], 0, 1, 0, SC_ONE, 0, SC_ONE);
              O0[1] = __builtin_amdgcn_mfma_scale_f32_32x32x64_f8f6f4(vf1, P, O0[1], 0, 1, 0, SC_ONE, 0, SC_ONE); }
        } else
#pragma unroll
        for (int sub = 0; sub < 2; ++sub) {
        const unsigned cb = pb_ + (unsigned)(sub * A8_BUF);
        const v8i vf0 = lds32(lds + cb + vr), vf1 = lds32(lds + cb + vr + 32 * A8_STR);
        if (KIND == 0) {
            const v8i k0 = lds32(lds + cb + kr + 32 * h), k1 = lds32(lds + cb + kr + 32 * A8_STR + 32 * h);
            const f32x16 S0 = __builtin_amdgcn_mfma_scale_f32_32x32x64_f8f6f4(k0, qa, cinit, 0, 0, 0, SC_ONE, 0, SC_EIGHTH);
            const f32x16 S1 = __builtin_amdgcn_mfma_scale_f32_32x32x64_f8f6f4(k1, qa, cinit, 0, 0, 0, SC_ONE, 0, SC_EIGHTH);
            v8i P; softmax8(S0, S1, l0, P);
            O0[0] = __builtin_amdgcn_mfma_scale_f32_32x32x64_f8f6f4(vf0, P, O0[0], 0, 1, 0, SC_ONE, 0, SC_ONE);
            O0[1] = __builtin_amdgcn_mfma_scale_f32_32x32x64_f8f6f4(vf1, P, O0[1], 0, 1, 0, SC_ONE, 0, SC_ONE);
        } else {
#pragma unroll
            for (int c = 0; c < 2; ++c) {
                f32x16 S0 = cinit, S1 = cinit;
#pragma unroll
                for (int kk = 0; kk < 2; ++kk) {
                    const u32x2 a0 = *(const LAS u32x2*)(lds + cb + kr + 32 * c + 16 * kk + 8 * h), a1 = *(const LAS u32x2*)(lds + cb + kr + 32 * A8_STR + 32 * c + 16 * kk + 8 * h);
                    S0 = __builtin_amdgcn_mfma_f32_32x32x16_fp8_fp8((long)(((unsigned long long)a0.y << 32) | a0.x), qc[c][kk], S0, 0, 0, 0);
                    S1 = __builtin_amdgcn_mfma_f32_32x32x16_fp8_fp8((long)(((unsigned long long)a1.y << 32) | a1.x), qc[c][kk], S1, 0, 0, 0);
                }
                v8i P;
                if (c == 0) { softmax8(S0, S1, l0, P);
                    O0[0] = __builtin_amdgcn_mfma_scale_f32_32x32x64_f8f6f4(vf0, P, O0[0], 0, 1, 0, SC_ONE, 0, SC_ONE);
                    O0[1] = __builtin_amdgcn_mfma_scale_f32_32x32x64_f8f6f4(vf1, P, O0[1], 0, 1, 0, SC_ONE, 0, SC_ONE); }
                else { softmax8(S0, S1, l1, P);
                    O1[0] = __builtin_amdgcn_mfma_scale_f32_32x32x64_f8f6f4(vf0, P, O1[0], 0, 1, 0, SC_ONE, 0, SC_ONE);
                    O1[1] = __builtin_amdgcn_mfma_scale_f32_32x32x64_f8f6f4(vf1, P, O1[1], 0, 1, 0, SC_ONE, 0, SC_ONE); }
                __builtin_amdgcn_sched_barrier(0);
            }
        }
        }
    }
#undef TLD
    l0 = xadd32(l0);
    bf16* yrow = (bf16*)((char*)Yb + (unsigned)((32 * w + q32) * D * 2));
    if (KIND == 0) {
        const float inv = 1.0f / l0;
#pragma unroll
        for (int db = 0; db < 2; ++db)
#pragma unroll
            for (int g = 0; g < 4; ++g) { u32x2 o; o.x = pk2(O0[db][4 * g] * inv, O0[db][4 * g + 1] * inv); o.y = pk2(O0[db][4 * g + 2] * inv, O0[db][4 * g + 3] * inv);
                *(u32x2*)(yrow + 32 * db + 8 * g + 4 * h) = o; }
    } else {
        l1 = xadd32(l1);
        const float i0 = 1.0f / l0, i1 = lam / l1; float ss = 0.f;
#pragma unroll
        for (int db = 0; db < 2; ++db)
#pragma unroll
            for (int r = 0; r < 16; ++r) { const float v = O0[db][r] * i0 - O1[db][r] * i1; O0[db][r] = v; ss += v * v; }
        ss = xadd32(ss);
        const float rstd = rsqrtf(ss * (1.0f / 64.0f) + RMS_EPS) * post;
#pragma unroll
        for (int db = 0; db < 2; ++db)
#pragma unroll
            for (int g = 0; g < 4; ++g) { const f32x4 gg = *(const f32x4*)(gain + 32 * db + 8 * g + 4 * h); u32x2 o;
                o.x = pk2(O0[db][4 * g] * rstd * gg[0], O0[db][4 * g + 1] * rstd * gg[1]); o.y = pk2(O0[db][4 * g + 2] * rstd * gg[2], O0[db][4 * g + 3] * rstd * gg[3]);
                *(u32x2*)(yrow + 32 * db + 8 * g + 4 * h) = o; }
    }
    __syncthreads();
}
DI void phase_attn8(const Frame& F, int l) {
    const unsigned char* QA = (const unsigned char*)(F.ws + WS_QA); const unsigned char* KA = (const unsigned char*)(F.ws + WS_KA); const unsigned char* VA = (const unsigned char*)(F.ws + WS_VA);
    const unsigned char* QC = (const unsigned char*)(F.ws + WS_QC); const unsigned char* KC = (const unsigned char*)(F.ws + WS_KC); const unsigned char* VC = (const unsigned char*)(F.ws + WS_VC);
    bf16* Y = (bf16*)(F.ws + WS_Y);
    const float* sc = (const float*)(F.ws + WS_SCAL);
    const float lam = sc[4 * l], lam_init = sc[4 * l + 1], boundA = sc[4 * l + 2] * 1.15f + 0.1f;
    const int* MAXK = (const int*)(F.ws + WS_CTL) + CW_MAXK;
    const int nq = (l == 0) ? 65 : 64, nper = NB * 4 * nq;
#pragma unroll 1
    for (int u = F.bid; u < nper; u += F.G) {
        const int qt = u % nq, bh = u / nq, b = bh / 4, h = bh % 4;
        const int ntiles = (qt == 64) ? CTXL / 64 : KEYS / 64;
        const int orow0 = (qt == 64) ? NLAT + b * CTXL : b * SEQ + qt * 256;
        const Frame U = fresh(F);
        attn8_unit<0>(U, QA + ((size_t)(b * 4 + h) * QROWS + qt * 256) * 64, KA + (size_t)(b * 2 + h / 2) * KEYS * 64, VA + (size_t)(b * 2 + h / 2) * KTILES * 4096, ntiles, boundA,
                      Y + (size_t)orow0 * D + h * 64, 0.f, nullptr, 0.f);
    }
#pragma unroll 1
    for (int u = F.bid; u < nper; u += F.G) {
        const int qt = u % nq, bh = u / nq, b = bh / 4, h = bh % 4;
        const int ntiles = (qt == 64) ? CTXL / 64 : KEYS / 64;
        const int orow0 = (qt == 64) ? NLAT + b * CTXL : b * SEQ + qt * 256;
        const Frame U = fresh(F);
        const int mi = ((l * 2 + b) * 4 + h) * 2; const float mk = sqrtf(fmaxf(__int_as_float(MAXK[16 * mi]), __int_as_float(MAXK[16 * (mi + 1)])));
        attn8_unit<1>(U, QC + ((size_t)(b * 4 + h) * QROWS + qt * 256) * 64, KC + (size_t)(b * 4 + h) * KEYS * 64, VC + (size_t)(b * 4 + h) * KTILES * 4096, ntiles, mk,
                      Y + (size_t)orow0 * D + 512 + h * 64, lam, F.in[I_CSUBLN] + l * 64, 1.0f - lam_init);
    }
}

#ifndef PROBE_MASK
#define PROBE_MASK 0
#endif
#define PBX(b) do { if ((((PROBE_MASK) >> (b)) & 1)) { volatile LAS unsigned* M_ = (volatile LAS unsigned*)(F.lds + MISC_OFF); const unsigned long long t_ = __builtin_amdgcn_s_memrealtime(); M_[16] = (unsigned)t_; M_[17] = (unsigned)(t_ >> 32); } } while (0)
#define PEX(b) do { if ((((PROBE_MASK) >> (b)) & 1)) { volatile LAS unsigned* M_ = (volatile LAS unsigned*)(F.lds + MISC_OFF); const unsigned long long t_ = __builtin_amdgcn_s_memrealtime() - (((unsigned long long)M_[17] << 32) | M_[16]) + (((unsigned long long)M_[19] << 32) | M_[18]); __syncthreads(); M_[18] = (unsigned)t_; M_[19] = (unsigned)(t_ >> 32); __syncthreads(); } } while (0)
DI void wave_sum4(float (&v)[4]) {
#pragma unroll
    for (int i = 0; i < 4; ++i) v[i] += shx<1>(v[i]);
#pragma unroll
    for (int i = 0; i < 4; ++i) v[i] += shx<2>(v[i]);
#pragma unroll
    for (int i = 0; i < 4; ++i) v[i] += shx<4>(v[i]);
#pragma unroll
    for (int i = 0; i < 4; ++i) v[i] += shx<8>(v[i]);
#pragma unroll
    for (int i = 0; i < 4; ++i) v[i] += shx<16>(v[i]);
#pragma unroll
    for (int i = 0; i < 4; ++i) v[i] = xadd32(v[i]);
}
DI void phase_route(const Frame& F, int l, int ntok) {
    constexpr int TROW = 4128, TLO = 2064;
    LAS unsigned char* TK = F.lds;
    LAS float* LG = (LAS float*)(F.lds + 32 * TROW);
    LAS float* LG1 = (LAS float*)(F.lds + 147456);
    const int lane = F.lane, w = F.wave;
    const bf16* __restrict__ Z = (const bf16*)(F.ws + WS_Z); bf16* __restrict__ T = (bf16*)(F.ws + WS_ACT);
    float* XC = (float*)(F.ws + WS_XC); float* __restrict__ RINFO = (float*)(F.ws + WS_RINFO); int* __restrict__ LISTS = (int*)(F.ws + WS_LISTS);
    unsigned* CNT = (unsigned*)(F.ws + WS_CTL) + CW_CNT;
    const int chunk = ntok / NCHUNK;
    const __amdgpu_buffer_rsrc_t rwrs = __builtin_amdgcn_make_buffer_rsrc((void*)(F.ws + WS_RWT + (size_t)l * 262144), 0, 262144, 0x00020000);
    const float rbias = F.in[I_ROUTERB][l * NEXP + lane];
    const int ngrp = ntok / 32;
    u32x2 zr[4][4]; f32x4 xr[4][4];
#define ROUTE_SRC(row0_) ((row0_) < NLAT ? (l == 0 ? F.in[I_X] : F.out) + (size_t)(row0_) * D : (l == 0 ? F.in[I_CTX] : XC) + (size_t)((row0_) - NLAT) * D)
#define ROUTE_FETCH(g_) do { const int r0_ = (g_) * 32 + 4 * w; const float* s_ = ROUTE_SRC(r0_); _Pragma("unroll") for (int tt = 0; tt < 4; ++tt) _Pragma("unroll") for (int j = 0; j < 4; ++j) { \
        zr[tt][j] = *(const u32x2*)(Z + (size_t)(r0_ + tt) * D + 4 * lane + 256 * j); xr[tt][j] = *(const f32x4*)(s_ + (size_t)tt * D + 4 * lane + 256 * j); } } while (0)
    if (F.bid < ngrp) ROUTE_FETCH(F.bid);
#pragma unroll 1
    for (int grp = F.bid; grp < ngrp; grp += F.G) {
        PBX(11);
        {
            const int row0 = grp * 32 + 4 * w, r = mod_row(row0);
            float* __restrict__ dst = row0 < NLAT ? F.out + (size_t)row0 * D : XC + (size_t)(row0 - NLAT) * D;
            f32x4 z[4][4], x[4][4];
#pragma unroll
            for (int tt = 0; tt < 4; ++tt)
#pragma unroll
                for (int j = 0; j < 4; ++j) { const u32x2 wv = zr[tt][j]; z[tt][j] = (f32x4){lo16(wv.x), hi16(wv.x), lo16(wv.y), hi16(wv.y)}; x[tt][j] = xr[tt][j]; }
            float ss[4];
#pragma unroll
            for (int tt = 0; tt < 4; ++tt) { float a = 0.f;
#pragma unroll
                for (int j = 0; j < 4; ++j) a += (z[tt][j][0] * z[tt][j][0] + z[tt][j][1] * z[tt][j][1]) + (z[tt][j][2] * z[tt][j][2] + z[tt][j][3] * z[tt][j][3]);
                ss[tt] = a; }
            wave_sum4(ss);
            { const float* gate = modp(F, l, r, 2); const float* gp = F.in[I_GPOSTMIX] + l * D;
#pragma unroll
              for (int j = 0; j < 4; ++j) { const int c = 4 * lane + 256 * j; const f32x4 gg = *(const f32x4*)(gate + c) * *(const f32x4*)(gp + c);
#pragma unroll
                for (int tt = 0; tt < 4; ++tt) x[tt][j] = x[tt][j] + gg * (z[tt][j] * rsqrtf(ss[tt] * (1.0f / D) + RMS_EPS)); } }
#pragma unroll
            for (int tt = 0; tt < 4; ++tt) { store_row_f32(dst + (size_t)tt * D, lane, x[tt]); float a = 0.f;
#pragma unroll
                for (int j = 0; j < 4; ++j) a += (x[tt][j][0] * x[tt][j][0] + x[tt][j][1] * x[tt][j][1]) + (x[tt][j][2] * x[tt][j][2] + x[tt][j][3] * x[tt][j][3]);
                ss[tt] = a; }
            wave_sum4(ss);
            { const float* g = F.in[I_GPREFFN] + l * D; const float* sh = modp(F, l, r, 3); const float* scl = modp(F, l, r, 4);
#pragma unroll
              for (int j = 0; j < 4; ++j) { const int c = 4 * lane + 256 * j; const f32x4 gg = *(const f32x4*)(g + c) * (1.0f + *(const f32x4*)(scl + c)), hh = *(const f32x4*)(sh + c);
#pragma unroll
                for (int tt = 0; tt < 4; ++tt) x[tt][j] = x[tt][j] * rsqrtf(ss[tt] * (1.0f / D) + RMS_EPS) * gg + hh; } }
#pragma unroll
            for (int tt = 0; tt < 4; ++tt) {
#pragma unroll
                for (int j = 0; j < 4; ++j) { int wv = 0; wv = __builtin_amdgcn_cvt_pk_fp8_f32(x[tt][j][0], x[tt][j][1], wv, false); wv = __builtin_amdgcn_cvt_pk_fp8_f32(x[tt][j][2], x[tt][j][3], wv, true);
                    *(int*)((unsigned char*)T + (size_t)(row0 + tt) * D + 4 * lane + 256 * j) = wv; }
#pragma unroll
                for (int j = 0; j < 4; ++j) {
                    u32x2 hi, lo; hi.x = pk2(x[tt][j][0], x[tt][j][1]); hi.y = pk2(x[tt][j][2], x[tt][j][3]);
                    lo.x = pk2(x[tt][j][0] - lo16(hi.x), x[tt][j][1] - hi16(hi.x)); lo.y = pk2(x[tt][j][2] - lo16(hi.y), x[tt][j][3] - hi16(hi.y));
                    LAS unsigned char* tp = TK + (4 * w + tt) * TROW + 8 * lane + 512 * j;
                    *(LAS u32x2*)tp = hi; *(LAS u32x2*)(tp + TLO) = lo; } }
        }
        LDS_WAIT(); __syncthreads();
        PEX(11); PBX(12);
        {
            const int eb = w & 3, kh = w >> 2, fr = lane & 15, fq = lane >> 4;
            f32x4 accB[2], accS[2];
#pragma unroll
            for (int tb = 0; tb < 2; ++tb) { accB[tb] = (f32x4){0.f, 0.f, 0.f, 0.f}; accS[tb] = (f32x4){0.f, 0.f, 0.f, 0.f}; }
            const LAS unsigned char* ap = TK + fr * TROW + 16 * fq + 1024 * kh;
            const int so = ((eb * 32 + 16 * kh) * 2) * 1024, vo = 16 * lane;
#define RW_LD(s_, part_) __builtin_bit_cast(bf16x8, __builtin_amdgcn_raw_buffer_load_b128(rwrs, vo, so + ((s_) * 2 + (part_)) * 1024, 0))
            bf16x8 bh[8], bl[8];
#pragma unroll
            for (int sI = 0; sI < 8; ++sI) { bh[sI] = RW_LD(sI, 0); bl[sI] = RW_LD(sI, 1); }
#pragma unroll
            for (int sI = 0; sI < 16; ++sI) {
#pragma unroll
                for (int tb = 0; tb < 2; ++tb) {
                    const bf16x8 ah = *(const LAS bf16x8*)(ap + tb * 16 * TROW + 64 * sI), al = *(const LAS bf16x8*)(ap + tb * 16 * TROW + TLO + 64 * sI);
                    accB[tb] = __builtin_amdgcn_mfma_f32_16x16x32_bf16(ah, bh[sI & 7], accB[tb], 0, 0, 0);
                    accS[tb] = __builtin_amdgcn_mfma_f32_16x16x32_bf16(ah, bl[sI & 7], accS[tb], 0, 0, 0);
                    accS[tb] = __builtin_amdgcn_mfma_f32_16x16x32_bf16(al, bh[sI & 7], accS[tb], 0, 0, 0);
                }
                if (sI + 8 < 16) { bh[sI & 7] = RW_LD(sI + 8, 0); bl[sI & 7] = RW_LD(sI + 8, 1); }
                if (sI == 7) {
                    __builtin_amdgcn_sched_barrier(0); if (grp + F.G < ngrp) ROUTE_FETCH(grp + F.G); __builtin_amdgcn_sched_barrier(0); }
            }
#undef RW_LD
            LAS float* lgp = kh ? LG1 : LG;
#pragma unroll
            for (int tb = 0; tb < 2; ++tb) { const f32x4 at = accB[tb] + accS[tb];
#pragma unroll
                for (int rr = 0; rr < 4; ++rr) lgp[(16 * tb + 4 * fq + rr) * 64 + 16 * eb + fr] = at[rr]; }
        }
        LDS_WAIT(); __syncthreads();
        PEX(12); PBX(13);
        {
            float score[4]; int rank[4]; bool chosen[4];
#pragma unroll
            for (int tt = 0; tt < 4; ++tt) {
                const float logit = LG[(4 * w + tt) * 64 + lane] + LG1[(4 * w + tt) * 64 + lane];
                score[tt] = 1.0f / (1.0f + __expf(-logit));
                const float sel = score[tt] + rbias;
                float m1 = sel; m1 = fmaxf(m1, shx<1>(m1)); m1 = fmaxf(m1, shx<2>(m1)); m1 = fmaxf(m1, shx<4>(m1));
                int i1 = (sel == m1) ? (lane & 7) : 8; i1 = min(i1, shx<1>(i1)); i1 = min(i1, shx<2>(i1)); i1 = min(i1, shx<4>(i1));
                float s2 = ((lane & 7) == i1) ? -INFINITY : sel; s2 = fmaxf(s2, shx<1>(s2)); s2 = fmaxf(s2, shx<2>(s2)); s2 = fmaxf(s2, shx<4>(s2));
                const float gs = m1 + s2; const int g = lane >> 3;
                int grank = 0;
#pragma unroll
                for (int g2 = 0; g2 < 8; ++g2) { const float o = rdlane(gs, 8 * g2); grank += (o > gs || (o == gs && g2 < g)) ? 1 : 0; }
                const float msel = (grank < 4) ? sel : -INFINITY;
                int rk = 0;
#pragma unroll 1
                for (int g2 = 0; g2 < 8; ++g2) if (__builtin_amdgcn_readlane(grank, 8 * g2) < 4) {
#pragma unroll
                    for (int i2 = 0; i2 < 8; ++i2) { const int l2 = 8 * g2 + i2; const float o = rdlane(msel, l2); rk += (o > msel || (o == msel && l2 < lane)) ? 1 : 0; } }
                rank[tt] = rk; chosen[tt] = (rk < TOPK) && (grank < 4);
            }
            float wsum[4];
#pragma unroll
            for (int tt = 0; tt < 4; ++tt) wsum[tt] = chosen[tt] ? score[tt] : 0.f;
            wave_sum4(wsum);
            LAS unsigned* WC = (LAS unsigned*)TK;
            unsigned loc[4], nw = 0;
#pragma unroll
            for (int tt = 0; tt < 4; ++tt) { loc[tt] = nw; nw += chosen[tt] ? 1u : 0u; }
            WC[w * 64 + lane] = nw;
            LDS_WAIT(); __syncthreads();
            if (w == 0) {
                unsigned pre[8], tot = 0;
#pragma unroll
                for (int i = 0; i < 8; ++i) { pre[i] = tot; tot += WC[i * 64 + lane]; }
                const int c = (grp * 32) / chunk;
                const unsigned base = tot ? atomicAdd(CNT + 16 * ((l * NCHUNK + c) * NEXP + lane), tot) : 0u;
#pragma unroll
                for (int i = 0; i < 8; ++i) WC[i * 64 + lane] = base + pre[i];
            }
            LDS_WAIT(); __syncthreads();
            const unsigned wbase = WC[w * 64 + lane];
#pragma unroll
            for (int tt = 0; tt < 4; ++tt) if (chosen[tt]) { const int row = grp * 32 + 4 * w + tt, c = row / chunk; const unsigned slot = wbase + loc[tt];
                if (slot < (unsigned)LCAP) LISTS[(size_t)(c * NEXP + lane) * LCAP + slot] = row * 8 + rank[tt];
                RINFO[(size_t)row * 8 + rank[tt]] = score[tt] / wsum[tt] * 2.5f; }
        }
        __syncthreads();
        PEX(13);
    }
}

struct MoeSched {
    const LAS int* pre; const LAS int* cnt; const LAS int* hsb;
    int ng, nct, G, c, K; int g0;
    const char* A; const char* Wr; const char* Wsh; size_t wstride; const int* lists;
    bool gatherA; int shared_grp;
    DI bool next(int i, pg8::Unit& u) const {
        const long L = (long)i * G + c; const int total = __builtin_amdgcn_readfirstlane(pre[ng]) * nct; if (L >= total) return false;
        const int tile = (int)(L / nct), ct = (int)(L % nct);
        int lo = 0, hi = ng;
        while (hi - lo > 1) { const int mid = (lo + hi) >> 1; if (__builtin_amdgcn_readfirstlane(pre[mid]) <= tile) lo = mid; else hi = mid; }
        const int g = lo, rt = tile - __builtin_amdgcn_readfirstlane(pre[g]);
        const int cg = __builtin_amdgcn_readfirstlane(cnt[g]), hb = __builtin_amdgcn_readfirstlane(hsb[g]);
        const bool sh = (g == shared_grp);
        u.pn = ct; u.nvalid = min(cg - rt * 256, 256); u.aux = g;
        u.rows = sh ? nullptr : lists + (size_t)(g0 + g) * LCAP + rt * 256;
        const char* Wb = sh ? Wsh : Wr + (size_t)((g0 + g) % NEXP) * wstride;
        u.B = Wb + (size_t)ct * 256 * K;
        if (gatherA) { u.A = sh ? A + (size_t)rt * 256 * K : A; u.orow0 = hb + rt * 256; }
        else { u.A = A + (size_t)(hb + rt * 256) * K; u.orow0 = rt * 256; }
        return true;
    }
};
DI void moe_tables(const Frame& F, int l, int ntok, int gbeg, int n, bool with_shared, LAS int* pre, LAS int* cnt, LAS int* hsb, LAS int* tmp) {
    const unsigned* CNT = (const unsigned*)(F.ws + WS_CTL) + CW_CNT;
    __syncthreads();
    if (F.tid < NCHUNK * NEXP) tmp[F.tid] = (int)min(__hip_atomic_load(CNT + 16 * (l * NCHUNK * NEXP + F.tid), __ATOMIC_RELAXED, __HIP_MEMORY_SCOPE_AGENT), (unsigned)LCAP);
    __syncthreads();
    if (F.wave == 0) {
        constexpr int GPL = NCHUNK * NEXP / 64;
        int c[GPL], t[GPL], ts = 0;
#pragma unroll
        for (int i = 0; i < GPL; ++i) { c[i] = tmp[GPL * F.lane + i]; t[i] = (c[i] + 255) >> 8; ts += t[i]; }
        int incl = ts;
#pragma unroll
        for (int o = 1; o < 64; o <<= 1) { const int v = __builtin_amdgcn_ds_bpermute((F.lane - o) << 2, incl); if (F.lane >= o) incl += v; }
        int run = incl - ts;
        const int before = rdlane(incl - ts, gbeg / GPL);
        const int endp = rdlane(incl, (gbeg + n) / GPL - 1);
#pragma unroll
        for (int i = 0; i < GPL; ++i) { const int g = GPL * F.lane + i;
            if (g >= gbeg && g < gbeg + n) { pre[g - gbeg] = run - before; cnt[g - gbeg] = c[i]; hsb[g - gbeg] = run * 256; }
            run += t[i]; }
        if (F.lane == 0) { const int p = endp - before;
            if (with_shared) { pre[n] = p; cnt[n] = ntok; hsb[n] = HS_SH_BASE; pre[n + 1] = p + ntok / 256; }
            else pre[n] = p; }
    }
    __syncthreads();
}

struct CmbTok { u32x2 f0[4]; unsigned o[4][4]; };
DI int o2pos(int lane) { return ((lane >> 3) & 3) * 64 + ((lane >> 1) & 3) * 16 + (lane >> 5) * 8 + (lane & 1) * 4; }
DI void cmb_load(CmbTok& t, const bf16* __restrict__ F0row, const unsigned char* __restrict__ O2row, int lane) {
#pragma unroll
    for (int j = 0; j < 4; ++j) t.f0[j] = *(const u32x2*)(F0row + 4 * lane + 256 * j);
#pragma unroll
    for (int k = 0; k < 4; ++k)
#pragma unroll
        for (int j = 0; j < 4; ++j) t.o[k][j] = *(const unsigned*)(O2row + (size_t)k * D + o2pos(lane) + 256 * j);
}
DI f32x4 fp8x4(unsigned w) { return (f32x4){__builtin_amdgcn_cvt_f32_fp8((int)w, 0), __builtin_amdgcn_cvt_f32_fp8((int)w, 1), __builtin_amdgcn_cvt_f32_fp8((int)w, 2), __builtin_amdgcn_cvt_f32_fp8((int)w, 3)}; }
DI void cmb_finish(const Frame& F, const CmbTok& t, int l, int row, const unsigned char* __restrict__ O2row, float* __restrict__ xp, bf16* __restrict__ actrow, const float* __restrict__ rinfo, int lane) {
    const int r = mod_row(row);
    unsigned o2[4][4]; f32x4 tx[4]; float wk[8];
#pragma unroll
    for (int k = 0; k < 4; ++k)
#pragma unroll
        for (int j = 0; j < 4; ++j) o2[k][j] = *(const unsigned*)(O2row + (size_t)(4 + k) * D + o2pos(lane) + 256 * j);
#pragma unroll
    for (int j = 0; j < 4; ++j) tx[j] = *(const f32x4*)(xp + 4 * lane + 256 * j);
#pragma unroll
    for (int k = 0; k < 8; ++k) wk[k] = rinfo[k] * (1.0f / 16.0f);
    f32x4 f[4];
#pragma unroll
    for (int j = 0; j < 4; ++j) { const u32x2 w = t.f0[j]; f[j] = (f32x4){lo16(w.x), hi16(w.x), lo16(w.y), hi16(w.y)}; }
#pragma unroll
    for (int k = 0; k < 4; ++k)
#pragma unroll
        for (int j = 0; j < 4; ++j) f[j] += wk[k] * fp8x4(t.o[k][j]);
#pragma unroll
    for (int k = 0; k < 4; ++k)
#pragma unroll
        for (int j = 0; j < 4; ++j) f[j] += wk[4 + k] * fp8x4(o2[k][j]);
    const float rf = rsqrtf(row_sumsq(f) * (1.0f / D) + RMS_EPS);
    f32x4 x[4];
    const float* gate = modp(F, l, r, 5); const float* gp = F.in[I_GPOSTFFN] + l * D;
#pragma unroll
    for (int j = 0; j < 4; ++j) { const int cc = 4 * lane + 256 * j; x[j] = tx[j] + *(const f32x4*)(gate + cc) * (f[j] * rf * *(const f32x4*)(gp + cc)); }
    store_row_f32(xp, lane, x);
    if (l == 0) {
        const float rx = rsqrtf(row_sumsq(x) * (1.0f / D) + RMS_EPS);
        norm_mod(x, rx, F.in[I_GPREMIX] + D, modp(F, 1, r, 0), modp(F, 1, r, 1), lane);
        store_row_bf16(actrow, lane, x);
    }
}
DI void phase_combine(const Frame& F, int l, int ntok, int c) {
    const int gw = F.bid * NWAVES + F.wave, NGW = F.G * NWAVES, lane = F.lane;
    const int chunk = ntok / NCHUNK;
    const unsigned char* OUT2 = (const unsigned char*)(F.ws + WS_OUT2); const bf16* F0 = (const bf16*)(F.ws + WS_F0); const float* RINFO = (const float*)(F.ws + WS_RINFO);
    float* XC = (float*)(F.ws + WS_XC); bf16* ACT = (bf16*)(F.ws + WS_ACT);
#define CMB_PTRS(i_) const int row_##i_ = c * chunk + (i_); float* xp_##i_ = row_##i_ < NLAT ? F.out + (size_t)row_##i_ * D : XC + (size_t)(row_##i_ - NLAT) * D
    int i = gw;
    if (i >= chunk) return;
    CmbTok ta, tb;
    { CMB_PTRS(i); cmb_load(ta, F0 + (size_t)row_i * D, OUT2 + (size_t)i * 8 * D, lane); }
    for (;;) {
        const int i2 = i + NGW;
        if (i2 < chunk) { CMB_PTRS(i2); cmb_load(tb, F0 + (size_t)row_i2 * D, OUT2 + (size_t)i2 * 8 * D, lane); }
        { CMB_PTRS(i); cmb_finish(F, ta, l, row_i, OUT2 + (size_t)i * 8 * D, xp_i, ACT + (size_t)row_i * D, RINFO + (size_t)row_i * 8, lane); }
        if (i2 >= chunk) break;
        const int i3 = i2 + NGW;
        if (i3 < chunk) { CMB_PTRS(i3); cmb_load(ta, F0 + (size_t)row_i3 * D, OUT2 + (size_t)i3 * 8 * D, lane); }
        { CMB_PTRS(i2); cmb_finish(F, tb, l, row_i2, OUT2 + (size_t)i2 * 8 * D, xp_i2, ACT + (size_t)row_i2 * D, RINFO + (size_t)row_i2 * 8, lane); }
        if (i3 >= chunk) break;
        i = i3;
    }
#undef CMB_PTRS
}

constexpr int PH_PRO_A = 0, PH_PRO_B = 1, PH_L0 = 2, PH_PER_LAYER = 6 + 2 * NCHUNK, N_PHASES = PH_L0 + 2 * PH_PER_LAYER;
__global__ void __launch_bounds__(NTHREADS, 2) fwd(Args args) {
    extern __shared__ __attribute__((aligned(16))) unsigned char lds_raw[];
    Frame F;
    F.lds = (LAS unsigned char*)lds_raw;
    F.tid = 0; F.lane = 0; F.wave = __builtin_amdgcn_readfirstlane((int)threadIdx.x >> 6);
    F.G = gridDim.x; F.bid = blockIdx.x; F.in = args.in; F.out = args.out; F.ws = args.ws;
    volatile LAS unsigned* MISC = (volatile LAS unsigned*)(F.lds + MISC_OFF);
    for (int u = threadIdx.x; u < (147456 - LDSCTL_OFF) / 4; u += NTHREADS) ((LAS unsigned*)(F.lds + LDSCTL_OFF))[u] = 0u;
    __syncthreads();
    const int lo = args.ph_lo, hi = args.ph_hi;
    XcdBarrier bar; bar.bar = (unsigned*)(F.ws + WS_CTL) + CW_BAR; bar.x = 0; bar.st = nullptr;
    if (hi - lo > 1) bar = xcd_barrier_post((unsigned*)(F.ws + WS_CTL) + CW_BAR, MISC + 8, threadIdx.x == 0);
#ifndef EN_MASK
#define EN_MASK 0x3ff
#endif
#define EN(b) (((EN_MASK) >> (b)) & 1)
#define IN(k) (lo <= (k) && (k) < hi)
#ifndef PROBE_MASK
#define PROBE_MASK 0
#endif
#ifndef PROBE_MULT
#define PROBE_MULT 8
#endif
#define PB(b) do { if ((((PROBE_MASK) >> (b)) & 1)) { const unsigned long long t_ = __builtin_amdgcn_s_memrealtime(); MISC[16] = (unsigned)t_; MISC[17] = (unsigned)(t_ >> 32); } } while (0)
#define PE(b) do { if ((((PROBE_MASK) >> (b)) & 1)) { const unsigned long long t_ = __builtin_amdgcn_s_memrealtime() - (((unsigned long long)MISC[17] << 32) | MISC[16]) + (((unsigned long long)MISC[19] << 32) | MISC[18]); __syncthreads(); MISC[18] = (unsigned)t_; MISC[19] = (unsigned)(t_ >> 32); __syncthreads(); } } while (0)
#ifndef REP_MASK
#define REP_MASK 0
#endif
#define REPS(b) _Pragma("unroll 1") for (int rep_ = 0; rep_ < ((((REP_MASK) >> (b)) & 1) ? 2 : 1); ++rep_)
#define SEAM(k) do { if (IN(k) && IN((k) + 1)) { PB(10); const Frame B_ = fresh(F); XcdBarrier b2_ = bar; b2_.bar = bar.bar + opaque0(); xcd_barrier(b2_, B_.tid == 0); PE(10); } } while (0)
    LAS int* TPRE = (LAS int*)(F.lds + TBL_OFF); LAS int* TCNT = TPRE + 272; LAS int* THSB = TCNT + 272; LAS int* TTMP = THSB + 272;

    PB(0); if (EN(0) && IN(PH_PRO_A)) REPS(0) { const Frame P_ = fresh(F); phase_pro_a(P_); } SEAM(PH_PRO_A); PE(0);
    PB(1); if (EN(1) && IN(PH_PRO_B)) REPS(1) { const Frame P_ = fresh(F); phase_pro_b(P_); } SEAM(PH_PRO_B); PE(1);
#pragma unroll 1
    for (int l = 0; l < 2; ++l) {
        const int P = PH_L0 + l * PH_PER_LAYER;
        const int ntok = (l == 0) ? NTOK : NLAT;
        PB(2); if (EN(2) && IN(P + 0)) REPS(2) {
            const Frame Q = fresh(F);
            pg8::DenseOrder S; S.init(Q.ws + WS_ACT, Q.ws + WS_WIN + (size_t)l * PW * D * 2, NTOK, PW, 2 * D, Q.G, Q.bid);
            pg8::EpiBf16 E{(bf16*)(Q.ws + WS_PJ), PW};
            pg8::gemm_phase<pg8::EpiBf16, pg8::DenseOrder, false>(Q.lds, Q.tid, 2 * D, S, E, Q.ws);
        } SEAM(P + 0); PE(2);
        PB(3); if (EN(3) && IN(P + 1)) REPS(3) { const Frame P_ = fresh(F); phase_post(P_, l); } SEAM(P + 1); PE(3);
        PB(4); if (EN(4) && IN(P + 2)) REPS(4) { const Frame P_ = fresh(F);
#if ATTN_NAIVE
            phase_attn_naive(P_, l);
#else
#if ATTN_FP8
            phase_attn8(P_, l);
#else
            phase_attn(P_, l);
#endif
#endif
        } SEAM(P + 2); PE(4);
        PB(5); if (EN(5) && IN(P + 3)) REPS(5) {
            const Frame Q = fresh(F);
            pg8::DenseOrder S; S.init(Q.ws + WS_Y, Q.ws + WS_WOUT + (size_t)l * D * D * 2, ntok, D, 2 * D, Q.G, Q.bid);
            pg8::EpiBf16 E{(bf16*)(Q.ws + WS_Z), D};
            pg8::gemm_phase<pg8::EpiBf16, pg8::DenseOrder, false>(Q.lds, Q.tid, 2 * D, S, E, Q.ws);
        } SEAM(P + 3); PE(5);
        PB(6); if (EN(6) && IN(P + 4)) { const Frame P_ = fresh(F); phase_route(P_, l, ntok); } SEAM(P + 4); PE(6);
        PB(7); if (EN(7) && IN(P + 5)) REPS(7) {
            const Frame Q = fresh(F);
            moe_tables(Q, l, ntok, 0, NCHUNK * NEXP, true, TPRE, TCNT, THSB, TTMP);
            MoeSched S; S.pre = TPRE; S.cnt = TCNT; S.hsb = THSB; S.ng = NCHUNK * NEXP + 1; S.nct = 2; S.G = Q.G; S.c = Q.bid; S.K = D; S.g0 = 0;
            S.A = (const char*)(Q.ws + WS_ACT); S.Wr = (const char*)(Q.ws + WS_WE13); S.Wsh = (const char*)(Q.ws + WS_WSH13) + (size_t)l * 512 * D; S.wstride = (size_t)512 * D;
            S.lists = (const int*)(Q.ws + WS_LISTS); S.gatherA = true; S.shared_grp = NCHUNK * NEXP;
            pg8::EpiSwiglu E{(unsigned char*)(Q.ws + WS_HS)};
            pg8::gemm_phase<pg8::EpiSwiglu, MoeSched, true, true>(Q.lds, Q.tid, D, S, E, Q.ws);
        } SEAM(P + 5); PE(7);
#pragma unroll 1
        for (int c = 0; c < NCHUNK; ++c) {
            PB(8); if (EN(8) && IN(P + 6 + 2 * c)) REPS(8) {
                const Frame Q = fresh(F);
                moe_tables(Q, l, ntok, c * NEXP, NEXP, c == 0, TPRE, TCNT, THSB, TTMP);
                MoeSched S; S.pre = TPRE; S.cnt = TCNT; S.hsb = THSB; S.ng = NEXP + (c == 0 ? 1 : 0); S.nct = 4; S.G = Q.G; S.c = Q.bid; S.K = EH; S.g0 = c * NEXP;
                S.A = (const char*)(Q.ws + WS_HS); S.Wr = (const char*)(Q.ws + WS_WE2); S.Wsh = (const char*)(Q.ws + WS_WSH2) + (size_t)l * D * EH; S.wstride = (size_t)D * EH;
                S.lists = (const int*)(Q.ws + WS_LISTS); S.gatherA = false; S.shared_grp = (c == 0) ? NEXP : -1;
                pg8::EpiMoeOut E{(bf16*)(Q.ws + WS_OUT2), (bf16*)(Q.ws + WS_F0), c * (ntok / NCHUNK) * 8};
                pg8::gemm_phase<pg8::EpiMoeOut, MoeSched, false, true>(Q.lds, Q.tid, EH, S, E, Q.ws);
            } SEAM(P + 6 + 2 * c); PE(8);
            PB(9); if (EN(9) && IN(P + 7 + 2 * c)) {
                const Frame Q = fresh(F);
                phase_combine(Q, l, ntok, c);
                if (l == 0 && c == NCHUNK - 1) convert_experts(Q, 1, (LAS float*)(Q.lds + Q.wave * 16384));
            } SEAM(P + 7 + 2 * c); PE(9);
        }
    }
#undef IN
#undef SEAM
    const Frame E_ = fresh(F);
    if (PROBE_MASK != 0 && E_.bid == 0 && E_.tid == 0) { const unsigned long long te = __builtin_amdgcn_s_memrealtime(); const unsigned long long want = (unsigned long long)PROBE_MULT * ((((unsigned long long)MISC[19] << 32) | MISC[18]));
        while (__builtin_amdgcn_s_memrealtime() - te < want) __builtin_amdgcn_s_sleep(8); }
}

extern "C" void kernel_launch(void* const* d_in, const int* in_sizes, int n_in, void* d_out, int out_size, void* d_ws, size_t ws_size, hipStream_t stream) {
    static int grid = 0;
    if (grid == 0) {
        if (n_in != 28 || in_sizes[0] != NLAT * D || out_size != NLAT * D || ws_size < WS_END) { fprintf(stderr, "kernel_launch: unexpected shapes or workspace (%zu < %zu)\n", ws_size, (size_t)WS_END); grid = -1; return; }
        int dev = 0, cus = 0, per_cu = 0;
        if (hipGetDevice(&dev) != hipSuccess || hipDeviceGetAttribute(&cus, hipDeviceAttributeMultiprocessorCount, dev) != hipSuccess) { grid = -1; return; }
        if (hipFuncSetAttribute((const void*)fwd, hipFuncAttributeMaxDynamicSharedMemorySize, LDS_BYTES) != hipSuccess) { fprintf(stderr, "kernel_launch: hipFuncSetAttribute failed\n"); grid = -1; return; }
        if (hipOccupancyMaxActiveBlocksPerMultiprocessor(&per_cu, (const void*)fwd, NTHREADS, LDS_BYTES) != hipSuccess || per_cu < 1) { fprintf(stderr, "kernel_launch: occupancy query says %d\n", per_cu); }
        (void)hipGetLastError();
        grid = cus;
    }
    if (grid < 0) return;
    if (hipMemsetAsync((char*)d_ws + WS_CTL, 0, CTL_ZERO_BYTES, stream) != hipSuccess) return;
    Args a{};
    for (int i = 0; i < 28; ++i) a.in[i] = (const float*)d_in[i];
    a.out = (float*)d_out; a.ws = (unsigned char*)d_ws;
#if MK_ONE_LAUNCH
    a.ph_lo = 0; a.ph_hi = N_PHASES;
    hipLaunchKernelGGL(fwd, dim3(grid), dim3(NTHREADS), LDS_BYTES, stream, a);
#else
    for (int p = 0; p < N_PHASES; ++p) { a.ph_lo = p; a.ph_hi = p + 1; hipLaunchKernelGGL(fwd, dim3(grid), dim3(NTHREADS), LDS_BYTES, stream, a); }
#endif
}
```

```cpp
#include <hip/hip_runtime.h>
#include <cstdio>
#include <cstdint>

#ifndef ATTN_NAIVE
#define ATTN_NAIVE 0
#endif
#ifndef MK_ONE_LAUNCH
#define MK_ONE_LAUNCH 1
#endif

#define DI __device__ __forceinline__
#define LAS __attribute__((address_space(3)))
#define GAS __attribute__((address_space(1)))
typedef unsigned short bf16;
typedef short bf16x8 __attribute__((ext_vector_type(8)));
typedef float f32x4 __attribute__((ext_vector_type(4)));
typedef float f32x2 __attribute__((ext_vector_type(2)));
typedef unsigned u32x4 __attribute__((ext_vector_type(4)));
typedef unsigned u32x2 __attribute__((ext_vector_type(2)));

constexpr int D = 1024, NB = 2, SEQ = 16384, NLAT = NB * SEQ, CTXL = 256, NCTX = NB * CTXL, NTOK = NLAT + NCTX;
constexpr int PW = 2048, KEYS = CTXL + SEQ, QROWS = SEQ + CTXL;
constexpr int NEXP = 64, TOPK = 8, EH = 256, NCHUNK = 2, LCAP = NTOK / NCHUNK;
constexpr int NWAVES = 8, NTHREADS = 512;
constexpr float RMS_EPS = 1e-6f, LN_EPS = 1e-5f;
constexpr float LOG2E = 1.4426950408889634f;
constexpr float QA_SCALE = 0.125f * LOG2E;
constexpr float QC_SCALE = 0.17677669529663687f * LOG2E;

constexpr size_t MiB = 1u << 20;
constexpr size_t WS_CTL = 0, CTL_ZERO_BYTES = 1 * MiB;
constexpr size_t WS_MOD = 1 * MiB;
constexpr size_t WS_TAB = 1 * MiB + 256 * 1024;
constexpr size_t WS_TABC = WS_TAB + 32768, WS_SCAL = WS_TAB + 49152;
constexpr size_t WS_RWT = 1 * MiB + 512 * 1024;
constexpr size_t WS_SGUW = 2 * MiB;
constexpr size_t WS_POOLW = 2 * MiB + 512 * 1024;
constexpr size_t WS_WIN = 8 * MiB;
constexpr size_t WS_WOUT = 16 * MiB;
constexpr size_t WS_WSH13 = 20 * MiB;
constexpr size_t WS_WSH2 = 22 * MiB;
constexpr size_t WS_XC = 24 * MiB;
constexpr size_t WS_RINFO = 26 * MiB;
constexpr size_t WS_LISTS = 28 * MiB;
constexpr size_t WS_WE13 = 40 * MiB;
constexpr size_t WS_WE2 = 72 * MiB;
constexpr size_t WS_ACT = 88 * MiB;
constexpr size_t WS_R = 201 * MiB;
constexpr size_t WS_PJ = WS_R;
constexpr size_t QA_BYTES = (size_t)NB * 4 * QROWS * 64 * 2, KA_BYTES = (size_t)NB * 2 * KEYS * 64 * 2;
constexpr size_t WS_QA = 331 * MiB, WS_KA = WS_QA + QA_BYTES, WS_VA = WS_KA + KA_BYTES, WS_QC = WS_VA + KA_BYTES;
constexpr size_t WS_KC = WS_QC + QA_BYTES, WS_VC = WS_KC + QA_BYTES;
constexpr size_t WS_Y = 413 * MiB, WS_Z = 478 * MiB;
static_assert(WS_VC + QA_BYTES <= WS_Y, "qkv region");
constexpr int HS_SH_BASE = NTOK * TOPK + NCHUNK * NEXP * 255;
constexpr size_t WS_HS = WS_R;
constexpr size_t WS_OUT2 = 283 * MiB;
constexpr size_t OUT2_CHUNK = (size_t)LCAP * 8 * D;
constexpr size_t WS_F0 = 121 * MiB;
constexpr size_t WS_END = 575 * MiB;
static_assert(WS_HS + (size_t)(HS_SH_BASE + NTOK) * 256 <= WS_OUT2, "hs region");
static_assert(WS_OUT2 + NCHUNK * OUT2_CHUNK <= WS_END && WS_F0 + (size_t)NTOK * D * 2 <= WS_R && WS_ACT + (size_t)NTOK * D <= WS_F0 && WS_WE2 + (size_t)NEXP * D * EH <= WS_ACT, "moe regions");
constexpr int CW_TMO = 0, CW_BAR = 4096, CW_CNT = 16384;
constexpr int CW_MAXK = 32768;

constexpr int LDS_BYTES = 155648, LDS_SCRATCH = 141312, LDSCTL_OFF = LDS_SCRATCH;
constexpr int MISC_OFF = LDSCTL_OFF;
constexpr int TBL_OFF = LDSCTL_OFF + 128;

DI float bf2f(unsigned v) { return __uint_as_float(v << 16); }
DI unsigned f2bf(float f) { unsigned u = __float_as_uint(f); return (u + 0x7fffu + ((u >> 16) & 1u)) >> 16; }
DI unsigned pk2(float lo, float hi) { return f2bf(lo) | (f2bf(hi) << 16); }
DI float lo16(unsigned w) { return __uint_as_float(w << 16); }
DI float hi16(unsigned w) { return __uint_as_float(w & 0xffff0000u); }
template <int M> DI int shx(int v) {
    static_assert(M == 1 || M == 2 || M == 4 || M == 8 || M == 16, "xor mask inside 32 lanes");
    if constexpr (M == 1) return __builtin_amdgcn_update_dpp(0, v, 0xB1, 0xf, 0xf, true);
    else if constexpr (M == 2) return __builtin_amdgcn_update_dpp(0, v, 0x4E, 0xf, 0xf, true);
    else if constexpr (M == 4) return __builtin_amdgcn_update_dpp(0, v, 0x141, 0xf, 0xf, true);
    else if constexpr (M == 8) return __builtin_amdgcn_update_dpp(0, v, 0x140, 0xf, 0xf, true);
    else return __builtin_amdgcn_ds_swizzle(v, (M << 10) | 0x1f);
}
template <int M> DI float shx(float v) { return __int_as_float(shx<M>(__float_as_int(v))); }
DI float xadd16(float v) { const auto rr = __builtin_amdgcn_permlane16_swap(__float_as_uint(v), __float_as_uint(v), false, false); return __uint_as_float(rr[0]) + __uint_as_float(rr[1]); }
DI float xadd32(float v) { const auto rr = __builtin_amdgcn_permlane32_swap(__float_as_uint(v), __float_as_uint(v), false, false); return __uint_as_float(rr[0]) + __uint_as_float(rr[1]); }
DI float rdlane(float v, int l) { return __int_as_float(__builtin_amdgcn_readlane(__float_as_int(v), l)); }
DI int rdlane(int v, int l) { return __builtin_amdgcn_readlane(v, l); }
DI float wave_sum(float v) {
    v += shx<1>(v); v += shx<2>(v); v += shx<4>(v); v += shx<8>(v); v = xadd16(v);
    return xadd32(v);
}
#define LDS_WAIT() asm volatile("s_waitcnt lgkmcnt(0)" ::: "memory")
#define VM_WAIT() asm volatile("s_waitcnt vmcnt(0)" ::: "memory")

namespace pg8 {
constexpr int BM = 256, BK = 64, HALF = 128, HTB = HALF * BK * 2, STAGE_BYTES = 8 * HTB, NXCD = 8, WGM = 8;
__host__ __device__ __forceinline__ int lds_byte(int r, int c) { const int st = (r >> 4) * 2 + (c >> 5), rr = r & 15, cc = c & 31, ob = rr * 64 + cc * 2; return st * 1024 + (ob ^ (((ob >> 9) & 1) << 5)); }
__host__ __device__ __forceinline__ void stage_rc(int b, int& R, int& C) { const int st = b / 1024, sb = b % 1024, swz = sb ^ (((sb >> 9) & 1) << 5); R = (st >> 1) * 16 + swz / 64; C = (st & 1) * 32 + (swz % 64) / 2; }
__host__ __device__ __forceinline__ int perm32(int rho) { const int n = rho >> 4, i = rho & 15; return 8 * (i >> 2) + 4 * n + (i & 3); }

struct Unit {
    const char* A;
    const char* B;
    const int* rows;
    int nvalid;
    int orow0;
    int pn;
    int aux;
};

struct DenseOrder {
    const bf16* A; const bf16* Bt; int K; int nM, nN, nwg, G, c;
    DI void init(const void* A_, const void* Bt_, int M, int N, int KB_, int G_, int c_) { A = (const bf16*)A_; Bt = (const bf16*)Bt_; K = KB_;     nM = M / BM; nN = N / BM; nwg = nM * nN; G = G_; c = c_; }
    DI bool next(int i, Unit& u) const {
        const long L = (long)i * G + c; if (L >= nwg) return false;
        int wgid = (int)L; { const int q = nwg / NXCD, r = nwg % NXCD, xcd = wgid % NXCD, off = wgid / NXCD; wgid = (xcd < r ? xcd * (q + 1) : r * (q + 1) + (xcd - r) * q) + off; }
        const int nig = WGM * nN, gid = wgid / nig, fm = gid * WGM, gsz = (nM - fm) < WGM ? (nM - fm) : WGM;
        const int pm = fm + ((wgid % nig) % gsz), pn = (wgid % nig) / gsz;
        u.A = (const char*)A + (size_t)pm * BM * K; u.B = (const char*)Bt + (size_t)pn * BM * K; u.rows = nullptr; u.nvalid = BM; u.orow0 = pm * BM; u.pn = pn; u.aux = 0;
        return true;
    }
};

DI unsigned cvt_pk_bf16(float lo, float hi) { unsigned r; asm volatile("v_cvt_pk_bf16_f32 %0, %1, %2" : "=v"(r) : "v"(lo), "v"(hi)); return r; }

struct EpiBf16 {
    static constexpr bool PERM = true;
    bf16* O; int ldc; float sc;
    DI void operator()(const f32x4 (&acc)[2][2][4][2], const Unit& u, int wr, int wc, int fr, int fq) const {
        const int row0 = u.orow0 + wr * 64 + fr; const int col0 = u.pn * BM + wc * 32 + 8 * fq;
#pragma unroll
        for (int ai = 0; ai < 2; ++ai)
#pragma unroll
            for (int m = 0; m < 4; ++m) { bf16* rowp = O + (size_t)(row0 + ai * HALF + m * 16) * ldc + col0;
#pragma unroll
                for (int bj = 0; bj < 2; ++bj) { const f32x4 v0 = acc[ai][bj][m][0] * sc, v1 = acc[ai][bj][m][1] * sc;
                    u32x4 w; w.x = cvt_pk_bf16(v0[0], v0[1]); w.y = cvt_pk_bf16(v0[2], v0[3]); w.z = cvt_pk_bf16(v1[0], v1[1]); w.w = cvt_pk_bf16(v1[2], v1[3]);
                    *(u32x4*)(rowp + bj * HALF) = w; } }
    }
};
struct EpiSwiglu {
    static constexpr bool PERM = false; static constexpr float WINV = 1.0f / 32.0f, HSCALE = 8.0f;
    unsigned char* Hs;
    DI void operator()(const f32x4 (&acc)[2][2][4][2], const Unit& u, int wr, int wc, int fr, int fq) const {
        const int row0 = u.orow0 + wr * 64 + fr; const int f0 = u.pn * 128 + wc * 32 + 8 * fq;
#pragma unroll
        for (int ai = 0; ai < 2; ++ai)
#pragma unroll
            for (int m = 0; m < 4; ++m) { unsigned char* rowp = Hs + (size_t)(row0 + ai * HALF + m * 16) * EH + f0; u32x2 w;
#pragma unroll
                for (int bj = 0; bj < 2; ++bj) { const f32x4 a = acc[ai][bj][m][0], b = acc[ai][bj][m][1]; float h[4];
#pragma unroll
                    for (int j = 0; j < 4; ++j) { const float a1 = a[j] * WINV, a3 = b[j] * (WINV * HSCALE); const float s = a1 * __builtin_amdgcn_rcpf(1.0f + __builtin_amdgcn_exp2f(-a1 * LOG2E)); h[j] = s * a3; }
#pragma unroll
                    for (int j = 0; j < 4; ++j) h[j] = __builtin_amdgcn_fmed3f(h[j], -448.0f, 448.0f);
                    int wv = 0; wv = __builtin_amdgcn_cvt_pk_fp8_f32(h[0], h[1], wv, false); wv = __builtin_amdgcn_cvt_pk_fp8_f32(h[2], h[3], wv, true);
                    if (bj == 0) w.x = (unsigned)wv; else w.y = (unsigned)wv; }
                *(u32x2*)rowp = w; }
    }
};
struct EpiMoeOut {
    static constexpr bool PERM = true;
    bf16* OUT2; bf16* F0; int ebase;
    DI void operator()(const f32x4 (&acc)[2][2][4][2], const Unit& u, int wr, int wc, int fr, int fq) const {
        const int col0 = u.pn * BM + wc * 32 + 8 * fq;
        const bool routed = u.rows != nullptr;
        bf16* base = routed ? OUT2 : F0;
        int drow[2][4];
        if (routed) {
#pragma unroll
            for (int ai = 0; ai < 2; ++ai)
#pragma unroll
                for (int m = 0; m < 4; ++m) { const int r = wr * 64 + fr + ai * HALF + m * 16; drow[ai][m] = u.rows[min(r, u.nvalid - 1)]; }
#pragma unroll
            for (int ai = 0; ai < 2; ++ai)
#pragma unroll
                for (int m = 0; m < 4; ++m) { const int r = wr * 64 + fr + ai * HALF + m * 16; drow[ai][m] = (r < u.nvalid) ? drow[ai][m] - ebase : -1; }
        } else {
#pragma unroll
            for (int ai = 0; ai < 2; ++ai)
#pragma unroll
                for (int m = 0; m < 4; ++m) drow[ai][m] = u.orow0 + wr * 64 + fr + ai * HALF + m * 16;
        }
        if (routed) {
            unsigned char* base8 = (unsigned char*)OUT2;
#pragma unroll
            for (int ai = 0; ai < 2; ++ai)
#pragma unroll
                for (int m = 0; m < 4; ++m) {
                    if (drow[ai][m] >= 0) { unsigned char* rowp = base8 + (size_t)drow[ai][m] * D + u.pn * BM + wc * 64 + 16 * fq; u32x4 w;
#pragma unroll
                    for (int bj = 0; bj < 2; ++bj) { const f32x4 v0 = acc[ai][bj][m][0] * (16.0f / 256.0f), v1 = acc[ai][bj][m][1] * (16.0f / 256.0f); int w0 = 0, w1 = 0;
                        w0 = __builtin_amdgcn_cvt_pk_fp8_f32(v0[0], v0[1], w0, false); w0 = __builtin_amdgcn_cvt_pk_fp8_f32(v0[2], v0[3], w0, true);
                        w1 = __builtin_amdgcn_cvt_pk_fp8_f32(v1[0], v1[1], w1, false); w1 = __builtin_amdgcn_cvt_pk_fp8_f32(v1[2], v1[3], w1, true);
                        if (bj == 0) { w.x = (unsigned)w0; w.y = (unsigned)w1; } else { w.z = (unsigned)w0; w.w = (unsigned)w1; } }
                    *(u32x4*)rowp = w; } }
        } else {
#pragma unroll
        for (int ai = 0; ai < 2; ++ai)
#pragma unroll
            for (int m = 0; m < 4; ++m) {
                bf16* rowp = base + (size_t)drow[ai][m] * D + col0;
#pragma unroll
                for (int bj = 0; bj < 2; ++bj) { const f32x4 v0 = acc[ai][bj][m][0] * (1.0f / 256.0f), v1 = acc[ai][bj][m][1] * (1.0f / 256.0f);
                    u32x4 w; w.x = cvt_pk_bf16(v0[0], v0[1]); w.y = cvt_pk_bf16(v0[2], v0[3]); w.z = cvt_pk_bf16(v1[0], v1[1]); w.w = cvt_pk_bf16(v1[2], v1[3]);
                    *(u32x4*)(rowp + bj * HALF) = w; } }
        }
    }
};

template <bool GATHER, bool PERMB> DI void set_voff(const Unit& u, unsigned (&v)[2][2], unsigned (&vB)[2], int wid, int KB) {
    unsigned lane_s; asm volatile("v_mbcnt_lo_u32_b32 %0, -1, 0\n\tv_mbcnt_hi_u32_b32 %0, -1, %0" : "=v"(lane_s));
    const int tid = wid * 64 + (int)lane_s;
#pragma unroll
    for (int i = 0; i < 2; ++i) {
        int R, C; stage_rc(tid * 16 + i * 8192, R, C); const int Rb = PERMB ? ((R & ~31) + perm32(R & 31)) : R; vB[i] = (unsigned)(Rb * KB + C * 2);
#pragma unroll
        for (int h = 0; h < 2; ++h) {
            if (GATHER && u.rows) { const int r = h * HALF + R; const int e = u.rows[min(r, u.nvalid - 1)]; v[h][i] = (unsigned)((e >> 3) * KB + C * 2); }
            else v[h][i] = (unsigned)((h * HALF + R) * KB + C * 2);
        }
    }
}

template <class Epi, class Sched, bool GATHER, bool FP8 = false, int WSCALE = 0x7f7f7f7f>
DI void gemm_phase(LAS unsigned char* lds, const int tid, const int KB, const Sched& S, const Epi& E, const unsigned char* wsbase) {
    const char* wsb_ = (const char*)wsbase; const __amdgpu_buffer_rsrc_t rs_ = __builtin_amdgcn_make_buffer_rsrc((void*)wsbase, 0, 0x7fffffff, 0x00020000);
    const int wid = __builtin_amdgcn_readfirstlane(tid >> 6), lane = tid & 63, wr = wid >> 2, wc = wid & 3, fr = lane & 15, fq = lane >> 4;
    const int nt = KB / (BK * 2);
    unsigned voffB[2];
    const size_t kstep = (size_t)(BK * 2);
    const size_t hstep = (size_t)HALF * KB;
    const unsigned ldsw = (unsigned)wid * 1024u;
    const int aoff = lds_byte(wr * 64 + fr, fq * 8), boff = lds_byte(wc * 32 + fr, fq * 8);
#define PG8_SA(b, h) (((b) * 2 + (h)) * HTB)
#define PG8_SB(b, h) ((4 + (b) * 2 + (h)) * HTB)
#define PG8_STAGE(bufoff, gbase, voff) do { const int so_ = (int)(unsigned)((const char*)(gbase) - wsb_); _Pragma("unroll") for (int _i = 0; _i < 2; ++_i) \
        __builtin_amdgcn_raw_ptr_buffer_load_lds(rs_, (LAS unsigned*)(lds + (bufoff) + ldsw + _i * 8192), 16, (int)(voff)[_i], so_, 0, 0); } while (0)
#define PG8_LDA(dst, b, h) do { _Pragma("unroll") for (int m = 0; m < 4; ++m) { const i32x4_ lo_ = *(const LAS i32x4_*)(lds + PG8_SA(b, h) + aoff + m * 2048), hi_ = *(const LAS i32x4_*)(lds + PG8_SA(b, h) + aoff + m * 2048 + 1024); \
        dst[m] = __builtin_shufflevector(lo_, hi_, 0, 1, 2, 3, 4, 5, 6, 7); } } while (0)
#define PG8_LDB(dst, b, h) do { _Pragma("unroll") for (int n = 0; n < 2; ++n) { const i32x4_ lo_ = *(const LAS i32x4_*)(lds + PG8_SB(b, h) + boff + n * 2048), hi_ = *(const LAS i32x4_*)(lds + PG8_SB(b, h) + boff + n * 2048 + 1024); \
        dst[n] = __builtin_shufflevector(lo_, hi_, 0, 1, 2, 3, 4, 5, 6, 7); } } while (0)
#define PG8_MMA(ai, bj, At, Bt) do { __builtin_amdgcn_s_setprio(1); _Pragma("unroll") for (int m = 0; m < 4; ++m) _Pragma("unroll") for (int n = 0; n < 2; ++n) { \
        if constexpr (FP8) acc[ai][bj][m][n] = __builtin_amdgcn_mfma_scale_f32_16x16x128_f8f6f4(Bt[n], At[m], acc[ai][bj][m][n], 0, 0, 0, 0, 0, 0); \
        else { const bf16x8 b0_ = __builtin_bit_cast(bf16x8, __builtin_shufflevector(Bt[n], Bt[n], 0, 1, 2, 3)), b1_ = __builtin_bit_cast(bf16x8, __builtin_shufflevector(Bt[n], Bt[n], 4, 5, 6, 7)); \
               const bf16x8 a0_ = __builtin_bit_cast(bf16x8, __builtin_shufflevector(At[m], At[m], 0, 1, 2, 3)), a1_ = __builtin_bit_cast(bf16x8, __builtin_shufflevector(At[m], At[m], 4, 5, 6, 7)); \
               acc[ai][bj][m][n] = __builtin_amdgcn_mfma_f32_16x16x32_bf16(b0_, a0_, acc[ai][bj][m][n], 0, 0, 0); acc[ai][bj][m][n] = __builtin_amdgcn_mfma_f32_16x16x32_bf16(b1_, a1_, acc[ai][bj][m][n], 0, 0, 0); } } \
        __builtin_amdgcn_s_setprio(0); } while (0)
#define PG8_WAIT_V(n) asm volatile("s_waitcnt vmcnt(" #n ")" ::: "memory")
#define PG8_WAIT_L(n) asm volatile("s_waitcnt lgkmcnt(" #n ")" ::: "memory")
#define PG8_BAR __builtin_amdgcn_s_barrier()
#define PG8_SCHED __builtin_amdgcn_sched_barrier(0)
    Unit cur, nxt; int ui = 0;
    if (!S.next(0, cur)) return;
    f32x4 acc[2][2][4][2];
#pragma unroll
    for (int a = 0; a < 2; ++a)
#pragma unroll
        for (int b = 0; b < 2; ++b)
#pragma unroll
            for (int m = 0; m < 4; ++m)
#pragma unroll
                for (int n = 0; n < 2; ++n) acc[a][b][m][n] = (f32x4){0.f, 0.f, 0.f, 0.f};
    typedef int i32x4_ __attribute__((ext_vector_type(4))); typedef int v8i_ __attribute__((ext_vector_type(8)));
    v8i_ At[4], B0[2], B1[2];
    unsigned voC[2][2];
    set_voff<GATHER, Epi::PERM>(cur, voC, voffB, wid, KB);
    LAS u32x4* const park = (LAS u32x4*)(lds + STAGE_BYTES) + tid;
    const char* cA = cur.A; const char* cB = cur.B;
    PG8_STAGE(PG8_SB(0, 0), cB, voffB); PG8_STAGE(PG8_SB(0, 1), cB + hstep, voffB); PG8_STAGE(PG8_SA(0, 0), cA, voC[0]); PG8_STAGE(PG8_SA(0, 1), cA, voC[1]);
    if (wr == 1) PG8_BAR;
    PG8_WAIT_V(2); PG8_BAR;
    PG8_STAGE(PG8_SB(1, 0), cB + kstep, voffB); PG8_STAGE(PG8_SA(1, 0), cA + kstep, voC[0]); PG8_STAGE(PG8_SB(1, 1), cB + hstep + kstep, voffB);
    PG8_WAIT_V(6); PG8_BAR;
    for (;;) {
        const bool has_next = S.next(ui + 1, nxt);
        const char* nA = has_next ? nxt.A : cA; const char* nB = has_next ? nxt.B : cB;
        if constexpr (GATHER) {
            unsigned vb_[2], voN[2][2];
            if (has_next) set_voff<GATHER, Epi::PERM>(nxt, voN, vb_, wid, KB);
            else {
#pragma unroll
                for (int h = 0; h < 2; ++h)
#pragma unroll
                    for (int i = 0; i < 2; ++i) voN[h][i] = voC[h][i]; }
            u32x4 pk_; pk_.x = voN[0][0]; pk_.y = voN[0][1]; pk_.z = voN[1][0]; pk_.w = voN[1][1]; *park = pk_;
        }
#pragma unroll 1
        for (int t = 0; t < nt; t += 2) {
            const bool last = (t == nt - 2);
            const char* a1 = cA + (size_t)(t + 1) * kstep;
            const char* a2 = last ? nA : cA + (size_t)(t + 2) * kstep; const char* b2 = last ? nB : cB + (size_t)(t + 2) * kstep;
            const char* a3 = a2 + kstep; const char* b3 = b2 + kstep;
            unsigned vo2[2][2];
            if constexpr (GATHER) { const u32x4 pk_ = *park; vo2[0][0] = last ? pk_.x : voC[0][0]; vo2[0][1] = last ? pk_.y : voC[0][1]; vo2[1][0] = last ? pk_.z : voC[1][0]; vo2[1][1] = last ? pk_.w : voC[1][1]; }
            else {
#pragma unroll
                for (int h = 0; h < 2; ++h)
#pragma unroll
                    for (int i = 0; i < 2; ++i) vo2[h][i] = voC[h][i]; }
            PG8_LDB(B0, 0, 0); PG8_LDB(B1, 0, 1); PG8_SCHED; PG8_LDA(At, 0, 0); PG8_STAGE(PG8_SA(1, 1), a1, voC[1]);
            PG8_WAIT_V(8); PG8_WAIT_L(0); PG8_BAR; PG8_MMA(0, 0, At, B0); PG8_MMA(0, 1, At, B1); PG8_BAR; PG8_SCHED;
            PG8_LDA(At, 0, 1); PG8_STAGE(PG8_SB(0, 0), b2, voffB); PG8_STAGE(PG8_SB(0, 1), b2 + hstep, voffB); PG8_STAGE(PG8_SA(0, 0), a2, vo2[0]);
            PG8_WAIT_V(8); PG8_WAIT_L(0); PG8_BAR; PG8_MMA(1, 0, At, B0); PG8_MMA(1, 1, At, B1); PG8_BAR; PG8_SCHED;
            PG8_LDB(B0, 1, 0); PG8_LDB(B1, 1, 1); PG8_SCHED; PG8_LDA(At, 1, 0); PG8_STAGE(PG8_SA(0, 1), a2, vo2[1]);
            PG8_WAIT_V(8); PG8_WAIT_L(0); PG8_BAR; PG8_MMA(0, 0, At, B0); PG8_MMA(0, 1, At, B1); PG8_BAR; PG8_SCHED;
            PG8_LDA(At, 1, 1); PG8_STAGE(PG8_SB(1, 0), b3, voffB); PG8_STAGE(PG8_SB(1, 1), b3 + hstep, voffB); PG8_STAGE(PG8_SA(1, 0), a3, vo2[0]);
            PG8_WAIT_V(8); PG8_WAIT_L(0); PG8_BAR; PG8_MMA(1, 0, At, B0); PG8_MMA(1, 1, At, B1); PG8_BAR; PG8_SCHED;
        }
        if (wr == 0) PG8_BAR;
        { unsigned lane_e; asm volatile("v_mbcnt_lo_u32_b32 %0, -1, 0\n\tv_mbcnt_hi_u32_b32 %0, -1, %0" : "=v"(lane_e));
          E(acc, cur, wr, wc, (int)(lane_e & 15u), (int)(lane_e >> 4)); }
        if (!has_next) break;
#pragma unroll
        for (int a = 0; a < 2; ++a)
#pragma unroll
            for (int b = 0; b < 2; ++b)
#pragma unroll
                for (int m = 0; m < 4; ++m)
#pragma unroll
                    for (int n = 0; n < 2; ++n) acc[a][b][m][n] = (f32x4){0.f, 0.f, 0.f, 0.f};
        cur = nxt; cA = nA; cB = nB; ++ui;
        if constexpr (GATHER) { const u32x4 pk_ = *park; voC[0][0] = pk_.x; voC[0][1] = pk_.y; voC[1][0] = pk_.z; voC[1][1] = pk_.w; }
        if (wr == 1) PG8_BAR;
    }
    PG8_WAIT_V(0);
    PG8_BAR;
#undef PG8_SA
#undef PG8_SB
#undef PG8_STAGE
#undef PG8_LDA
#undef PG8_LDB
#undef PG8_MMA
#undef PG8_WAIT_V
#undef PG8_WAIT_L
#undef PG8_BAR
#undef PG8_SCHED
}
}

#define XB_TMO      128
#define XB_XCNT(j)  (256  + 64 * (j))
#define XB_XSUB(j)  (1280 + 64 * (j))
#define XB_XGEN(j)  (2304 + 64 * (j))
#define XB_TOP      3328
#define XB_TOPGEN   3392
#define XCD_BAR_WORDS 3456
#define XB_SPIN_CAP (1u << 18)
DI unsigned xb_ld(unsigned* p)              { return __hip_atomic_load(p, __ATOMIC_RELAXED, __HIP_MEMORY_SCOPE_AGENT); }
DI unsigned xb_add(unsigned* p, unsigned v) { return __hip_atomic_fetch_add(p, v, __ATOMIC_RELAXED, __HIP_MEMORY_SCOPE_AGENT); }
DI unsigned xb_xcc_id() { return (unsigned)__builtin_amdgcn_s_getreg((3 << 11) | 20) & 0xFu; }
#define XB_SPIN(cond, bar) do { unsigned _sp = 0; while (cond) { __builtin_amdgcn_s_sleep(1); \
    if ((++_sp & 255u) == 0u) { if (xb_ld(&(bar)[XB_TMO])) break; if (_sp > XB_SPIN_CAP) { atomicAdd(&(bar)[XB_TMO], 1u); break; } } } } while (0)
struct XcdBarrier { unsigned* bar; unsigned x; volatile LAS unsigned* st; };
DI XcdBarrier xcd_barrier_post(unsigned* bar, volatile LAS unsigned* st, const bool leader) {
    XcdBarrier b; b.bar = bar; b.x = xb_xcc_id(); b.st = st;
    if (leader) (void)xb_add(&bar[XB_XCNT(b.x)], 1u);
    return b;
}
DI void xcd_barrier_complete(unsigned* bar, unsigned x, unsigned& nloc, unsigned& nx) {
    const unsigned G = gridDim.x * gridDim.y * gridDim.z;
    unsigned sum, cnt, mine, sp = 0u;
    for (;;) {
        sum = 0u; cnt = 0u; mine = 0u;
#pragma unroll
        for (unsigned j = 0; j < 16; ++j) { const unsigned c = xb_ld(&bar[XB_XCNT(j)]); sum += c; cnt += (c > 0u) ? 1u : 0u; mine = (j == x) ? c : mine; }
        if (sum == G) break;
        __builtin_amdgcn_s_sleep(1);
        if ((++sp & 255u) == 0u) { if (xb_ld(&bar[XB_TMO])) break; if (sp > XB_SPIN_CAP) { atomicAdd(&bar[XB_TMO], 1u); break; } }
    }
    nloc = mine > 0u ? mine : 1u; nx = cnt > 0u ? cnt : 1u;
}
DI void xcd_barrier(const XcdBarrier& b, const bool leader) {
    asm volatile("s_waitcnt vmcnt(0)" ::: "memory");
    __syncthreads();
    if (leader) {
        unsigned* bar = b.bar;
        __builtin_amdgcn_s_waitcnt(0);
        unsigned nloc = b.st[0], nx = b.st[1];
        if (nloc == 0u) { xcd_barrier_complete(bar, b.x, nloc, nx); b.st[0] = nloc; b.st[1] = nx; }
        const unsigned old = xb_add(&bar[XB_XSUB(b.x)], 1u);
        const unsigned gen = old / nloc;
        if (old + 1u == (gen + 1u) * nloc) {
            __builtin_amdgcn_fence(__ATOMIC_RELEASE, "agent");
            asm volatile("s_waitcnt vmcnt(0)" ::: "memory");
            const unsigned og = xb_add(&bar[XB_TOP], 1u);
            const unsigned tg = og / nx;
            if (og + 1u == (tg + 1u) * nx) xb_add(&bar[XB_TOPGEN], 1u);
            else XB_SPIN(xb_ld(&bar[XB_TOPGEN]) == tg, bar);
            __builtin_amdgcn_fence(__ATOMIC_ACQUIRE, "agent");
            xb_add(&bar[XB_XGEN(b.x)], 1u);
            asm volatile("s_waitcnt vmcnt(0)" ::: "memory");
        } else {
            XB_SPIN(xb_ld(&bar[XB_XGEN(b.x)]) == gen, bar);
            __builtin_amdgcn_fence(__ATOMIC_ACQUIRE, "agent");
            asm volatile("s_waitcnt vmcnt(0)" ::: "memory");
        }
    }
    __syncthreads();
}

struct Args { const float* in[28]; float* out; unsigned char* ws; int ph_lo, ph_hi; };
enum { I_X = 0, I_C, I_CTX, I_CCTX, I_ADAW, I_ADAB, I_GPREMIX, I_GPOSTMIX, I_GPREFFN, I_GPOSTFFN, I_WIN, I_WOUT, I_AQG, I_AKG, I_POOLW, I_POOLS, I_LAMQK, I_CSUBLN,
       I_SGUW, I_SGUB, I_ROUTERW, I_ROUTERB, I_EW1, I_EW3, I_EW2, I_SW1, I_SW3, I_SW2 };

struct Frame {
    LAS unsigned char* lds;
    int tid, lane, wave, G, bid;
    const float* const* in; float* out; unsigned char* ws;
};

DI size_t opaque0() { unsigned z; asm volatile("s_mov_b32 %0, 0" : "=s"(z)); return (size_t)z; }
#ifdef NO_LAUNDER
DI Frame fresh(const Frame& F) { Frame G = F; G.lane = (int)__builtin_amdgcn_mbcnt_hi(~0u, __builtin_amdgcn_mbcnt_lo(~0u, 0u)); G.tid = G.wave * 64 + G.lane; return G; }
#else
DI Frame fresh(const Frame& F) { Frame G = F; const size_t z = opaque0(); G.ws = F.ws + z; G.in = F.in + z; G.out = F.out + z; { unsigned ln_; asm volatile("v_mbcnt_lo_u32_b32 %0, -1, %1\n\tv_mbcnt_hi_u32_b32 %0, -1, %0" : "=v"(ln_) : "s"((unsigned)z)); G.lane = (int)ln_; } G.wave = F.wave + (int)z; G.tid = G.wave * 64 + G.lane; G.bid = F.bid + (int)z; G.G = F.G + (int)z; G.lds = F.lds + z; return G; }
#endif
DI void load_row_f32(const float* p, int lane, f32x4 (&v)[4]) {
#pragma unroll
    for (int j = 0; j < 4; ++j) v[j] = *(const f32x4*)(p + 4 * lane + 256 * j);
}
DI void load_row_bf16(const bf16* p, int lane, f32x4 (&v)[4]) {
#pragma unroll
    for (int j = 0; j < 4; ++j) { const u32x2 w = *(const u32x2*)(p + 4 * lane + 256 * j); v[j] = (f32x4){lo16(w.x), hi16(w.x), lo16(w.y), hi16(w.y)}; }
}
DI void store_row_f32(float* p, int lane, const f32x4 (&v)[4]) {
#pragma unroll
    for (int j = 0; j < 4; ++j) *(f32x4*)(p + 4 * lane + 256 * j) = v[j];
}
DI void store_row_bf16(bf16* p, int lane, const f32x4 (&v)[4]) {
#pragma unroll
    for (int j = 0; j < 4; ++j) { u32x2 w; w.x = pk2(v[j][0], v[j][1]); w.y = pk2(v[j][2], v[j][3]); *(u32x2*)(p + 4 * lane + 256 * j) = w; }
}
DI float row_sumsq(const f32x4 (&v)[4]) {
    float s = 0.f;
#pragma unroll
    for (int j = 0; j < 4; ++j) s += (v[j][0] * v[j][0] + v[j][1] * v[j][1]) + (v[j][2] * v[j][2] + v[j][3] * v[j][3]);
    return wave_sum(s);
}
DI void norm_mod(f32x4 (&v)[4], float rstd, const float* g, const float* shift, const float* scale, int lane) {
#pragma unroll
    for (int j = 0; j < 4; ++j) { const int c = 4 * lane + 256 * j; const f32x4 gg = *(const f32x4*)(g + c), sh = *(const f32x4*)(shift + c), sc = *(const f32x4*)(scale + c);
        v[j] = (v[j] * rstd * gg) * (1.0f + sc) + sh; }
}
DI const float* modp(const Frame& F, int l, int r, int j) { return (const float*)(F.ws + WS_MOD) + ((size_t)(l * 3 + r) * 6 + j) * D; }
DI int mod_row(int row) { return row < NLAT ? row / SEQ : 2; }

template <class RowMap>
DI void transpose_item(const float* W, int K, int N, bf16* WT, const RowMap& rm, LAS float* scr, int item, int lane) {
    const int nblk = N / 32, kb = item / nblk, nb = item % nblk, k0 = 64 * kb, n0 = 32 * nb;
#pragma unroll 8
    for (int i = 0; i < 32; ++i) { const int kk = 2 * i + (lane >> 5); scr[kk * 33 + (lane & 31)] = W[(size_t)(k0 + kk) * N + n0 + (lane & 31)]; }
    LDS_WAIT(); asm volatile("" ::: "memory");
    const int c = lane & 7;
#pragma unroll
    for (int j = 0; j < 4; ++j) { const int n = (lane >> 3) + 8 * j; const LAS float* s = scr + (8 * c) * 33 + n;
        u32x4 o; o.x = pk2(s[0 * 33], s[1 * 33]); o.y = pk2(s[2 * 33], s[3 * 33]); o.z = pk2(s[4 * 33], s[5 * 33]); o.w = pk2(s[6 * 33], s[7 * 33]);
        *(u32x4*)(WT + (size_t)rm(n0 + n) * K + k0 + 8 * c) = o; }
    LDS_WAIT(); asm volatile("" ::: "memory");
}
template <class RowMap>
DI void transpose_item8(const float* W, int K, int N, unsigned char* WT8, const RowMap& rm, LAS float* scr, int item, int lane, float scale) {
    const int nblk = N / 32, kb = item / nblk, nb = item % nblk, k0 = 64 * kb, n0 = 32 * nb;
#pragma unroll 8
    for (int i = 0; i < 32; ++i) { const int kk = 2 * i + (lane >> 5); scr[kk * 33 + (lane & 31)] = W[(size_t)(k0 + kk) * N + n0 + (lane & 31)] * scale; }
    LDS_WAIT(); asm volatile("" ::: "memory");
    const int c = lane & 7;
#pragma unroll
    for (int j = 0; j < 4; ++j) { const int n = (lane >> 3) + 8 * j; const LAS float* sp = scr + (8 * c) * 33 + n;
        int w0 = 0, w1 = 0;
        w0 = __builtin_amdgcn_cvt_pk_fp8_f32(sp[0 * 33], sp[1 * 33], w0, false); w0 = __builtin_amdgcn_cvt_pk_fp8_f32(sp[2 * 33], sp[3 * 33], w0, true);
        w1 = __builtin_amdgcn_cvt_pk_fp8_f32(sp[4 * 33], sp[5 * 33], w1, false); w1 = __builtin_amdgcn_cvt_pk_fp8_f32(sp[6 * 33], sp[7 * 33], w1, true);
        u32x2 o; o.x = (unsigned)w0; o.y = (unsigned)w1;
        *(u32x2*)(WT8 + (size_t)rm(n0 + n) * K + k0 + 8 * c) = o; }
    LDS_WAIT(); asm volatile("" ::: "memory");
}
struct RowId { int off; DI int operator()(int n) const { return off + n; } };
struct RowW13 { int which; DI int operator()(int f) const { return ((f >> 7) << 8) + (((f >> 2) & 1) << 7) + (((f >> 5) & 3) << 5) + 16 * which + (((f >> 3) & 3) << 2) + (f & 3); } };

DI void convert_experts(const Frame& F, int l, LAS float* scr) {
    const int gw = F.bid * NWAVES + F.wave, NGW = F.G * NWAVES;
    bf16* WE13 = (bf16*)(F.ws + WS_WE13); bf16* WE2 = (bf16*)(F.ws + WS_WE2);
    constexpr int IT = 128;
    for (int it = gw; it < NEXP * 3 * IT; it += NGW) {
        const int e = it / (3 * IT), r = it % (3 * IT), m = r / IT, item = r % IT;
        const size_t eo = ((size_t)l * NEXP + e) * (size_t)(D * EH);
        if (m == 0) transpose_item8(F.in[I_EW1] + eo, D, EH, (unsigned char*)WE13 + (size_t)e * 512 * D, RowW13{0}, scr, item, F.lane, 32.0f);
        else if (m == 1) transpose_item8(F.in[I_EW3] + eo, D, EH, (unsigned char*)WE13 + (size_t)e * 512 * D, RowW13{1}, scr, item, F.lane, 32.0f);
        else transpose_item8(F.in[I_EW2] + eo, EH, D, (unsigned char*)WE2 + (size_t)e * D * EH, RowId{0}, scr, item, F.lane, 32.0f);
    }
}

DI void phase_pro_a(const Frame& F) {
    LAS float* scrw = (LAS float*)(F.lds + F.wave * 16384);
    if (F.bid < 192) {
        const int l = F.bid / 96, cg = F.bid % 96, n = cg * 64 + F.lane;
        const float* W = F.in[I_ADAW] + (size_t)l * D * 6144;
        LAS float* sc3 = (LAS float*)F.lds;
        LAS float* red = (LAS float*)(F.lds + 16384);
        for (int i = F.tid; i < 3 * D; i += NTHREADS) { const int j = i / D, k = i % D; const float c = j == 0 ? F.in[I_C][k] : j == 1 ? F.in[I_C][D + k] : F.in[I_CCTX][k]; sc3[i] = c / (1.0f + __expf(-c)); }
        LDS_WAIT(); __syncthreads();
        const int ks = F.lane >> 4, c4 = F.lane & 15;
        f32x4 a0 = {0.f, 0.f, 0.f, 0.f}, a1 = a0, a2 = a0;
        const float* wp = W + (size_t)(F.wave * 128 + ks) * 6144 + cg * 64 + 4 * c4;
#pragma unroll 1
        for (int i0 = 0; i0 < 32; i0 += 16) {
            f32x4 v[16];
#pragma unroll
            for (int i = 0; i < 16; ++i) v[i] = *(const f32x4*)(wp + (size_t)(4 * (i0 + i)) * 6144);
#pragma unroll
            for (int i = 0; i < 16; ++i) { const int k = F.wave * 128 + 4 * (i0 + i) + ks; a0 += v[i] * sc3[k]; a1 += v[i] * sc3[D + k]; a2 += v[i] * sc3[2 * D + k]; }
        }
#pragma unroll
        for (int e = 0; e < 4; ++e) { a0[e] = xadd32(xadd16(a0[e])); a1[e] = xadd32(xadd16(a1[e])); a2[e] = xadd32(xadd16(a2[e])); }
        if (F.lane < 16) {
#pragma unroll
            for (int e = 0; e < 4; ++e) { red[(F.wave * 3 + 0) * 64 + 4 * c4 + e] = a0[e]; red[(F.wave * 3 + 1) * 64 + 4 * c4 + e] = a1[e]; red[(F.wave * 3 + 2) * 64 + 4 * c4 + e] = a2[e]; } }
        LDS_WAIT(); __syncthreads();
        if (F.wave < 3) { float s = F.in[I_ADAB][l * 6144 + n];
#pragma unroll
            for (int w = 0; w < 8; ++w) s += red[(w * 3 + F.wave) * 64 + F.lane];
            ((float*)(F.ws + WS_MOD))[(size_t)(l * 3 + F.wave) * 6144 + n] = s; }
        __syncthreads();
    }
    const int gw = F.bid * NWAVES + F.wave, NGW = F.G * NWAVES;
    {
        constexpr int I_IN = 16 * 64, I_OUT = 16 * 32, I_S = 128;
        constexpr int PER_L = I_IN + I_OUT + 3 * I_S;
        for (int it = gw; it < 2 * PER_L; it += NGW) {
            const int l = it / PER_L; int r = it % PER_L;
            if (r < I_IN) { transpose_item8(F.in[I_WIN] + (size_t)l * D * PW, D, PW, (unsigned char*)(F.ws + WS_WIN) + (size_t)l * PW * D, RowId{0}, scrw, r, F.lane, 32.0f); continue; } r -= I_IN;
            if (r < I_OUT) { transpose_item(F.in[I_WOUT] + (size_t)l * D * D, D, D, (bf16*)(F.ws + WS_WOUT) + (size_t)l * D * D, RowId{0}, scrw, r, F.lane); continue; } r -= I_OUT;
            unsigned char* S13 = (unsigned char*)(F.ws + WS_WSH13) + (size_t)l * 512 * D; bf16* S2 = (bf16*)(F.ws + WS_WSH2) + (size_t)l * D * EH;
            if (r < I_S) { transpose_item8(F.in[I_SW1] + (size_t)l * D * EH, D, EH, S13, RowW13{0}, scrw, r, F.lane, 32.0f); continue; } r -= I_S;
            if (r < I_S) { transpose_item8(F.in[I_SW3] + (size_t)l * D * EH, D, EH, S13, RowW13{1}, scrw, r, F.lane, 32.0f); continue; } r -= I_S;
            transpose_item8(F.in[I_SW2] + (size_t)l * EH * D, EH, D, (unsigned char*)(F.ws + WS_WSH2) + (size_t)l * D * EH, RowId{0}, scrw, r, F.lane, 32.0f);
        }
    }
    convert_experts(F, 0, scrw);
    const int gt = F.bid * NTHREADS + F.tid, NGT = F.G * NTHREADS;
    for (int i = gt; i < 2 * 4 * 128 * 128; i += NGT) ((bf16*)(F.ws + WS_SGUW))[i] = (bf16)f2bf(F.in[I_SGUW][i]);
    for (int i = gt; i < 2 * 64 * 1024; i += NGT) { const int ll = i >> 16, k = (i >> 6) & 1023, n = i & 63; const float v = F.in[I_ROUTERW][i]; const unsigned hb = f2bf(v), lb = f2bf(v - __uint_as_float(hb << 16));
        unsigned short* rw = (unsigned short*)(F.ws + WS_RWT) + (size_t)ll * 131072 + (size_t)(((n >> 4) * 32 + (k >> 5)) * 2) * 512 + 8 * (((k >> 3) & 3) * 16 + (n & 15)) + (k & 7); rw[0] = (unsigned short)hb; rw[512] = (unsigned short)lb; }
    for (int i = gt; i < 2 * 4 * 64 * 64; i += NGT) { const int lg = i / 4096, n = (i / 64) % 64, k = i % 64; ((bf16*)(F.ws + WS_POOLW))[i] = (bf16)f2bf(F.in[I_POOLW][(size_t)lg * 4096 + k * 64 + n]); }
    for (int i = gt; i < 256 * 16; i += NGT) { const int p = i / 16, f = i % 16; const float inv = powf(10000.0f, -(float)f / 16.0f); const float ang = (float)p * inv;
        ((float*)(F.ws + WS_TAB))[2 * i] = cosf(ang); ((float*)(F.ws + WS_TAB))[2 * i + 1] = sinf(ang); }
    for (int i = gt; i < 256 * 8; i += NGT) { const int p = i / 8, f = i % 8; const float inv = powf(10000.0f, -(float)f / 8.0f); const float ang = (float)p * inv;
        ((float*)(F.ws + WS_TABC))[2 * i] = cosf(ang); ((float*)(F.ws + WS_TABC))[2 * i + 1] = sinf(ang); }
    if (gt < 2) { const int l = gt; const float* lq = F.in[I_LAMQK] + l * 128; float s0 = 0.f, s1 = 0.f;
        for (int i = 0; i < 32; ++i) { s0 += lq[i] * lq[32 + i]; s1 += lq[64 + i] * lq[96 + i]; }
        const float lam_init = 0.8f - 0.6f * expf(-0.3f * (float)l);
        float* sc = (float*)(F.ws + WS_SCAL); sc[4 * l] = expf(s0) - expf(s1) + lam_init; sc[4 * l + 1] = lam_init;
        float gq = 0.f, gk = 0.f; for (int i = 0; i < 64; ++i) { gq = fmaxf(gq, fabsf(F.in[I_AQG][l * 64 + i])); gk = fmaxf(gk, fabsf(F.in[I_AKG][l * 64 + i])); }
        sc[4 * l + 2] = fminf(8.0f * gq * gk * LOG2E * 1.01f + 0.01f, 100.0f); }
}

DI void phase_pro_b(const Frame& F) {
    const int gw = F.bid * NWAVES + F.wave, NGW = F.G * NWAVES;
    bf16* ACT = (bf16*)(F.ws + WS_ACT);
#define PROB_SRC(row_) ((row_) < NLAT ? F.in[I_X] + (size_t)(row_) * D : F.in[I_CTX] + (size_t)((row_) - NLAT) * D)
    f32x4 nv[4], gm[4], sh[4]; int rcur = -1;
    if (gw < NTOK) load_row_f32(PROB_SRC(gw), F.lane, nv);
    for (int row = gw; row < NTOK; row += NGW) {
        f32x4 v[4];
#pragma unroll
        for (int j = 0; j < 4; ++j) v[j] = nv[j];
        if (row + NGW < NTOK) load_row_f32(PROB_SRC(row + NGW), F.lane, nv);
        const int r = mod_row(row);
        if (r != rcur) { const float* g = F.in[I_GPREMIX]; const float* shift = modp(F, 0, r, 0); const float* scale = modp(F, 0, r, 1);
#pragma unroll
            for (int j = 0; j < 4; ++j) { const int c = 4 * F.lane + 256 * j; gm[j] = *(const f32x4*)(g + c) * (1.0f + *(const f32x4*)(scale + c)); sh[j] = *(const f32x4*)(shift + c); }
            rcur = r; }
        const float rstd = rsqrtf(row_sumsq(v) * (1.0f / D) + RMS_EPS);
#pragma unroll
        for (int j = 0; j < 4; ++j) v[j] = (v[j] * rstd) * gm[j] + sh[j];
#pragma unroll
        for (int j = 0; j < 4; ++j) { int wv = 0; wv = __builtin_amdgcn_cvt_pk_fp8_f32(v[j][0], v[j][1], wv, false); wv = __builtin_amdgcn_cvt_pk_fp8_f32(v[j][2], v[j][3], wv, true);
            *(int*)((unsigned char*)ACT + (size_t)row * D + 4 * F.lane + 256 * j) = wv; }
    }
#undef PROB_SRC
}

template <int PX> DI void rope8(float (&x)[8], bool second, const float* tab) {
#pragma unroll
    for (int e = 0; e < 8; ++e) { const float p = shx<PX>(x[e]); const float c = tab[2 * e], s = tab[2 * e + 1]; x[e] = x[e] * c + (second ? p : -p) * s; }
}
template <int PX> DI void rope8l(float (&x)[8], bool second, const LAS float* tab) {
    const f32x4 t0 = *(const LAS f32x4*)tab, t1 = *(const LAS f32x4*)(tab + 4), t2 = *(const LAS f32x4*)(tab + 8), t3 = *(const LAS f32x4*)(tab + 12);
    const float cs[16] = {t0[0], t0[1], t0[2], t0[3], t1[0], t1[1], t1[2], t1[3], t2[0], t2[1], t2[2], t2[3], t3[0], t3[1], t3[2], t3[3]};
#pragma unroll
    for (int e = 0; e < 8; ++e) { const float p = shx<PX>(x[e]); x[e] = x[e] * cs[2 * e] + (second ? p : -p) * cs[2 * e + 1]; }
}
DI void unpack8(const u32x4 w, float (&x)[8]) { x[0] = lo16(w.x); x[1] = hi16(w.x); x[2] = lo16(w.y); x[3] = hi16(w.y); x[4] = lo16(w.z); x[5] = hi16(w.z); x[6] = lo16(w.w); x[7] = hi16(w.w); }
DI u32x4 pack8(const float (&x)[8]) { u32x4 w; w.x = pk2(x[0], x[1]); w.y = pk2(x[2], x[3]); w.z = pk2(x[4], x[5]); w.w = pk2(x[6], x[7]); return w; }

#ifndef ATTN_FP8
#define ATTN_FP8 1
#endif
DI u32x2 pack8_fp8(const float (&x)[8]) {
    int w0 = 0, w1 = 0;
    w0 = __builtin_amdgcn_cvt_pk_fp8_f32(x[0], x[1], w0, false); w0 = __builtin_amdgcn_cvt_pk_fp8_f32(x[2], x[3], w0, true);
    w1 = __builtin_amdgcn_cvt_pk_fp8_f32(x[4], x[5], w1, false); w1 = __builtin_amdgcn_cvt_pk_fp8_f32(x[6], x[7], w1, true);
    u32x2 r; r.x = (unsigned)w0; r.y = (unsigned)w1; return r;
}
constexpr int KTILES = KEYS / 64;
DI void phase_post(const Frame& F, int l) {
    const bf16* __restrict__ PJ = (const bf16*)(F.ws + WS_PJ);
    bf16* __restrict__ QA = (bf16*)(F.ws + WS_QA); bf16* __restrict__ KA = (bf16*)(F.ws + WS_KA); bf16* __restrict__ VA = (bf16*)(F.ws + WS_VA);
    bf16* __restrict__ QC = (bf16*)(F.ws + WS_QC); bf16* __restrict__ KC = (bf16*)(F.ws + WS_KC); bf16* __restrict__ VC = (bf16*)(F.ws + WS_VC);
    bf16* __restrict__ Y = (bf16*)(F.ws + WS_Y);
    const float* __restrict__ tabA = (const float*)(F.ws + WS_TAB); const float* __restrict__ tabC = (const float*)(F.ws + WS_TABC);
    constexpr int DSTR = 264, VSTR = 136;
    LAS bf16* DIFF = (LAS bf16*)F.lds;
    LAS bf16* VCT = (LAS bf16*)(F.lds + 128 * DSTR * 2);
    const int lane = F.lane, w = F.wave;
    const int j8 = lane & 7, j4 = lane & 3;
    for (int u = F.bid; u < 260; u += F.G) {
        const bool is_ctx = u >= 256;
        int b, p0, row0, n;
        if (!is_ctx) { b = u / 128; p0 = (u % 128) * 128; row0 = b * SEQ + p0; n = SEQ; }
        else { const int cc = u - 256; b = cc / 2; p0 = (cc % 2) * 128; row0 = NLAT + b * CTXL + p0; n = CTXL; }
        const int seq0 = row0 - p0;
        const bool mix = !(is_ctx && l == 1);
        if (mix) {
#pragma unroll 1
        for (int tg = 0; tg < 4; ++tg) {
            const int tl0 = 16 * w + 4 * tg, pb = p0 + tl0;
            u32x4 raw1[4], raw3[4];
#pragma unroll
            for (int i = 0; i < 4; ++i) { raw1[i] = *(const u32x4*)(PJ + (size_t)(row0 + tl0 + i) * PW + 512 + 8 * lane); raw3[i] = *(const u32x4*)(PJ + (size_t)(row0 + tl0 + i) * PW + 1536 + 8 * lane); }
            float acc[4][8];
#pragma unroll
            for (int i = 0; i < 4; ++i)
#pragma unroll
                for (int e = 0; e < 8; ++e) acc[i][e] = 0.f;
            const int g = (lane >> 3) & 3, half = 1 << g;
            u32x4 wrow[19];
#pragma unroll
            for (int o = -8; o < 11; ++o) { const int qc = min(max(pb + o, 0), n - 1); wrow[o + 8] = *(const u32x4*)(PJ + (size_t)(seq0 + qc) * PW + 512 + 8 * (lane & 31)); }
#pragma unroll
            for (int o = -8; o < 11; ++o) { const int q = pb + o;
                if (q >= 0 && q < n && o >= -half && o < 3 + half) { float y[8]; unpack8(wrow[o + 8], y);
#pragma unroll
                    for (int i = 0; i < 4; ++i) if (o - i >= -half && o - i < half) {
#pragma unroll
                        for (int e = 0; e < 8; ++e) acc[i][e] += y[e]; } } }
            float dvn[4][8];
#pragma unroll
            for (int i = 0; i < 4; ++i) {
                const int tl = tl0 + i, p = pb + i;
                float x[8];
                {
                    unpack8(raw1[i], x);
                    if (lane < 32) { const int lo = max(p - half, 0), hi = min(p + half, n); const float inv = 1.0f / (float)(hi - lo); float d[8];
#pragma unroll
                        for (int e = 0; e < 8; ++e) d[e] = acc[i][e] * inv - x[e];
                        *(LAS u32x4*)(DIFF + tl * DSTR + 8 * lane) = pack8(d); }
                }
                {
                    unpack8(raw3[i], x);
                    float sm = 0.f;
#pragma unroll
                    for (int e = 0; e < 8; ++e) sm += x[e];
                    sm += shx<1>(sm); sm += shx<2>(sm); sm += shx<4>(sm); sm += shx<8>(sm); sm = xadd16(sm);
                    const float mu = sm * (1.0f / 256.0f); float q2 = 0.f;
#pragma unroll
                    for (int e = 0; e < 8; ++e) { x[e] -= mu; q2 += x[e] * x[e]; }
                    q2 += shx<1>(q2); q2 += shx<2>(q2); q2 += shx<4>(q2); q2 += shx<8>(q2); q2 = xadd16(q2);
                    const float rstd = rsqrtf(q2 * (1.0f / 256.0f) + LN_EPS);
#pragma unroll
                    for (int e = 0; e < 8; ++e) dvn[i][e] = x[e] * rstd;
                }
            }
            if (lane >= 32) {
#pragma unroll
                for (int e = 0; e < 8; ++e) { u32x2 wv; wv.x = pk2(dvn[0][e], dvn[1][e]); wv.y = pk2(dvn[2][e], dvn[3][e]); *(LAS u32x2*)(VCT + (8 * (lane - 32) + e) * VSTR + tl0) = wv; } }
        }
        }
        LDS_WAIT(); __syncthreads();
        if (mix) {
        {
            const bf16* __restrict__ PWt = (const bf16*)(F.ws + WS_POOLW) + (size_t)l * 4 * 4096;
            const int fr = lane & 15, fq = lane >> 4;
            bf16* yrow = Y + (size_t)(row0 + 16 * w + fr) * D + 256;
#pragma unroll 1
            for (int g = 0; g < 4; ++g) {
                bf16x8 a[2]; f32x4 scv[4];
#pragma unroll
                for (int nb = 0; nb < 4; ++nb) scv[nb] = *(const f32x4*)(F.in[I_POOLS] + l * 256 + 64 * g + 16 * nb + 4 * fq);
#pragma unroll
                for (int ks = 0; ks < 2; ++ks) a[ks] = *(const LAS bf16x8*)(DIFF + (16 * w + fr) * DSTR + 64 * g + 32 * ks + 8 * fq);
#pragma unroll
                for (int nb = 0; nb < 4; ++nb) {
                    f32x4 acc = {0.f, 0.f, 0.f, 0.f};
#pragma unroll
                    for (int ks = 0; ks < 2; ++ks) { const bf16x8 bb = *(const bf16x8*)(PWt + (size_t)g * 4096 + (16 * nb + fr) * 64 + 32 * ks + 8 * fq);
                        acc = __builtin_amdgcn_mfma_f32_16x16x32_bf16(bb, a[ks], acc, 0, 0, 0); }
                    const int ch = 64 * g + 16 * nb + 4 * fq; const f32x4 sc = scv[nb];
                    u32x2 o; o.x = pk2(acc[0] * sc[0], acc[1] * sc[1]); o.y = pk2(acc[2] * sc[2], acc[3] * sc[3]);
                    *(u32x2*)(yrow + ch) = o;
                }
            }
        }
        {
            const bf16* __restrict__ SW = (const bf16*)(F.ws + WS_SGUW) + (size_t)l * 4 * 16384;
            const int fr = lane & 15, fq = lane >> 4, pp = 16 * w + fr;
            bf16* yrow = Y + (size_t)(row0 + pp) * D + 768; const bf16* urow = PJ + (size_t)(row0 + pp) * PW + 1536;
            float biasv[4];
#pragma unroll
            for (int h = 0; h < 4; ++h) biasv[h] = F.in[I_SGUB][(l * 4 + h) * 128 + pp];
#pragma unroll 1
            for (int h = 0; h < 4; ++h) {
                bf16x8 a[4];
#pragma unroll
                for (int ks = 0; ks < 4; ++ks) a[ks] = *(const bf16x8*)(SW + (size_t)h * 16384 + pp * 128 + 32 * ks + 8 * fq);
                const float bias = h == 0 ? biasv[0] : h == 1 ? biasv[1] : h == 2 ? biasv[2] : biasv[3];
                u32x2 uuv[4];
#pragma unroll
                for (int nb = 0; nb < 4; ++nb) uuv[nb] = *(const u32x2*)(urow + 64 * h + 16 * nb + 4 * fq);
#pragma unroll
                for (int nb = 0; nb < 4; ++nb) {
                    f32x4 acc = {0.f, 0.f, 0.f, 0.f};
#pragma unroll
                    for (int ks = 0; ks < 4; ++ks) { const bf16x8 bb = *(const LAS bf16x8*)(VCT + (64 * h + 16 * nb + fr) * VSTR + 32 * ks + 8 * fq);
                        acc = __builtin_amdgcn_mfma_f32_16x16x32_bf16(bb, a[ks], acc, 0, 0, 0); }
                    const int ch = 64 * h + 16 * nb + 4 * fq; const u32x2 uu = uuv[nb];
                    u32x2 o; o.x = pk2(lo16(uu.x) * (acc[0] + bias), hi16(uu.x) * (acc[1] + bias)); o.y = pk2(lo16(uu.y) * (acc[2] + bias), hi16(uu.y) * (acc[3] + bias));
                    *(u32x2*)(yrow + ch) = o;
                }
            }
        }
        }
        __syncthreads();
#if ATTN_FP8
        {
            constexpr int SVSTR = 386;
            LAS bf16* SV = (LAS bf16*)F.lds;
            for (int pc = F.tid; pc < 128 * 48; pc += NTHREADS) { const int tk = pc / 48, c8 = pc % 48;
                const u32x4 v = *(const u32x4*)(PJ + (size_t)(row0 + tk) * PW + (c8 < 16 ? 384 + 8 * c8 : 1280 + 8 * (c8 - 16)));
                LAS unsigned* d32 = (LAS unsigned*)(SV + tk * SVSTR + 8 * c8); d32[0] = v.x; d32[1] = v.y; d32[2] = v.z; d32[3] = v.w; }
            LDS_WAIT(); __syncthreads();
            const int tb = is_ctx ? (p0 >> 6) : 4 + (p0 >> 6);
            for (int id = F.tid; id < 6 * 2 * 64 * 4; id += NTHREADS) {
                const int c16 = id & 3, d = (id >> 2) & 63, tt = (id >> 8) & 1, hb = id >> 9;
                float xv[16];
#pragma unroll
                for (int e = 0; e < 16; ++e) { const int pos = 16 * c16 + e; const int key = 32 * ((pos >> 4) & 1) + 8 * ((pos >> 2) & 3) + 4 * (pos >> 5) + (pos & 3);
                    xv[e] = bf2f(SV[(64 * tt + key) * SVSTR + 64 * hb + d]); }
                float x0[8], x1[8];
#pragma unroll
                for (int e = 0; e < 8; ++e) { x0[e] = xv[e]; x1[e] = xv[8 + e]; }
                const u32x2 a = pack8_fp8(x0), c = pack8_fp8(x1); u32x4 o; o.x = a.x; o.y = a.y; o.z = c.x; o.w = c.y;
                unsigned char* dst = hb < 2 ? (unsigned char*)VA + ((size_t)(b * 2 + hb) * KTILES + tb + tt) * 4096 : (unsigned char*)VC + ((size_t)(b * 4 + (hb - 2)) * KTILES + tb + tt) * 4096;
                *(u32x4*)(dst + d * 64 + 16 * c16) = o;
            }
            __syncthreads();
        }
#endif
    }
    {
        const int skip = 260 - F.G > 0 ? 260 - F.G : 0;
        const bool takes = F.G <= 2 * skip ? true : F.bid >= skip;
        const int nb_ = F.G <= 2 * skip ? F.G : F.G - skip, ib_ = F.G <= 2 * skip ? F.bid : F.bid - skip;
        float g0[8];
        { const float* g = (lane < 32 ? F.in[I_AQG] : F.in[I_AKG]) + l * 64 + 8 * j8;
#pragma unroll
          for (int e = 0; e < 8; ++e) g0[e] = (lane < 48) ? g[e] : 1.0f; }
        float kmax2 = 0.f; int kb_ = -1;
        LAS float* ltab = (LAS float*)F.lds;
        __syncthreads();
        for (int i = F.tid; i < 49152 / 16; i += NTHREADS) ((LAS f32x4*)ltab)[i] = ((const f32x4*)tabA)[i];
        LDS_WAIT(); __syncthreads();
        const LAS float* ltabA = ltab; const LAS float* ltabC = ltab + 8192;
        const int gstep = nb_ * NWAVES;
        const int l31 = lane & 31, hf = lane >> 5;
#define PA_LOAD(dstA, dstQ, dstK, r0_) do { _Pragma("unroll") for (int i = 0; i < 4; ++i) dstA[i] = *(const u32x4*)(PJ + (size_t)((r0_) + i) * PW + 8 * lane); \
        _Pragma("unroll") for (int pr = 0; pr < 2; ++pr) { dstQ[pr] = *(const u32x4*)(PJ + (size_t)((r0_) + 2 * pr + hf) * PW + 768 + 8 * l31); dstK[pr] = *(const u32x4*)(PJ + (size_t)((r0_) + 2 * pr + hf) * PW + 1024 + 8 * l31); } } while (0)
#define KMAX_FLUSH(bb_) do { float km_ = kmax2; { const auto rr_ = __builtin_amdgcn_permlane32_swap(__float_as_uint(km_), __float_as_uint(km_), false, false); km_ = fmaxf(__uint_as_float(rr_[0]), __uint_as_float(rr_[1])); } \
        if (lane < 32 && (lane & 3) == 0) atomicMax((int*)(F.ws + WS_CTL) + CW_MAXK + 16 * (((l * 2 + (bb_)) * 4 + (lane >> 3)) * 2 + ((lane >> 2) & 1)), __float_as_int(km_)); } while (0)
        u32x4 nA[4], nQ[2], nK[2];
        { const int g0_ = ib_ * NWAVES + w; if (takes && g0_ < NTOK / 4) PA_LOAD(nA, nQ, nK, 4 * g0_); }
        if (takes)
#pragma unroll 1
        for (int grp = ib_ * NWAVES + w; grp < NTOK / 4; grp += gstep) {
            const int rowg = 4 * grp; const bool is_ctx = rowg >= NLAT;
            const int b = is_ctx ? (rowg - NLAT) / CTXL : rowg / SEQ, pb = is_ctx ? (rowg - NLAT) % CTXL : rowg % SEQ;
            if (b != kb_) { if (kb_ >= 0) KMAX_FLUSH(kb_); kmax2 = 0.f; kb_ = b; }
            u32x4 rA[4], rQ[2], rK[2];
#pragma unroll
            for (int i = 0; i < 4; ++i) rA[i] = nA[i];
#pragma unroll
            for (int pr = 0; pr < 2; ++pr) { rQ[pr] = nQ[pr]; rK[pr] = nK[pr]; }
            if (grp + gstep < NTOK / 4) PA_LOAD(nA, nQ, nK, rowg + 4 * gstep);
#pragma unroll
            for (int i = 0; i < 4; ++i) {
                const int p = pb + i;
                const int qpos = is_ctx ? SEQ + p : p, kpos = is_ctx ? p : CTXL + p;
                const int prow = p >> 6, pcol = p & 63;
                float x[8];
                unpack8(rA[i], x);
                float ss = 0.f;
#pragma unroll
                for (int e = 0; e < 8; ++e) ss += x[e] * x[e];
                ss += shx<1>(ss); ss += shx<2>(ss); ss += shx<4>(ss);
                const float rstd = (lane < 48) ? rsqrtf(ss * (1.0f / 64.0f) + RMS_EPS) : 1.0f;
#pragma unroll
                for (int e = 0; e < 8; ++e) x[e] = x[e] * rstd * g0[e];
                if (!is_ctx) rope8l<2>(x, (j8 & 2) != 0, ltabA + (((j8 & 4) ? pcol : prow) * 16 + 8 * (j8 & 1)) * 2);
                if (lane < 32) {
#pragma unroll
                    for (int e = 0; e < 8; ++e) x[e] *= LOG2E;
                    *(u32x2*)((unsigned char*)QA + ((size_t)(b * 4 + (lane >> 3)) * QROWS + qpos) * 64 + 8 * j8) = pack8_fp8(x); }
                else if (lane < 48) *(u32x2*)((unsigned char*)KA + ((size_t)(b * 2 + ((lane - 32) >> 3)) * KEYS + kpos) * 64 + 8 * j8) = pack8_fp8(x);
            }
#pragma unroll
            for (int pr = 0; pr < 2; ++pr) {
                const int p = pb + 2 * pr + hf;
                const int qpos = is_ctx ? SEQ + p : p, kpos = is_ctx ? p : CTXL + p;
                const int prow = p >> 6, pcol = p & 63, hh = l31 >> 3;
                const LAS float* tc = ltabC + (((j4 & 2) ? pcol : prow) * 8) * 2;
                float x[8];
                unpack8(rQ[pr], x);
                if (!is_ctx) rope8l<1>(x, (j4 & 1) != 0, tc);
#pragma unroll
                for (int e = 0; e < 8; ++e) x[e] *= QC_SCALE;
                *(u32x2*)((unsigned char*)QC + ((size_t)(b * 4 + hh) * QROWS + qpos) * 64 + 8 * j8) = pack8_fp8(x);
                unpack8(rK[pr], x);
                if (!is_ctx) rope8l<1>(x, (j4 & 1) != 0, tc);
                { float n2 = 0.f;
#pragma unroll
                  for (int e = 0; e < 8; ++e) n2 += x[e] * x[e];
                  n2 += shx<1>(n2); n2 += shx<2>(n2); kmax2 = fmaxf(kmax2, n2); }
                *(u32x2*)((unsigned char*)KC + ((size_t)(b * 4 + hh) * KEYS + kpos) * 64 + 8 * j8) = pack8_fp8(x);
            }
        }
        if (kb_ >= 0) KMAX_FLUSH(kb_);
#undef PA_LOAD
#undef KMAX_FLUSH
    }
}

template <int QD>
DI void attn_naive_pass(const Frame& F, const bf16* Qrow, const bf16* Kb, const bf16* Vb, int nkeys, float (&o)[64]) {
    LAS float* Ks = (LAS float*)F.lds;
    LAS float* Vs = (LAS float*)(F.lds + 2 * 64 * QD * 4);
    LAS float* MG = (LAS float*)(F.lds + 65536);
    const int r = F.tid & 255, half = F.tid >> 8;
    float q[QD];
#pragma unroll
    for (int i = 0; i < QD / 8; ++i) { float x[8]; unpack8(*(const u32x4*)(Qrow + 8 * i), x);
#pragma unroll
        for (int e = 0; e < 8; ++e) q[8 * i + e] = x[e]; }
#pragma unroll
    for (int d = 0; d < 64; ++d) o[d] = 0.f;
    float m = -1e30f, lsum = 0.f;
    const int kh = nkeys / 2, kbeg = half * kh, ntile = kh / 64;
    for (int t = 0; t < ntile; ++t) {
        __syncthreads();
        const int key0 = kbeg + t * 64;
        for (int pc = r; pc < 64 * QD / 8; pc += 256) { const int kk = pc / (QD / 8), c = pc % (QD / 8); float x[8]; unpack8(*(const u32x4*)(Kb + (size_t)(key0 + kk) * 64 + 8 * c), x);
#pragma unroll
            for (int e = 0; e < 8; ++e) Ks[(half * 64 + kk) * QD + 8 * c + e] = x[e]; }
        for (int pc = r; pc < 512; pc += 256) { const int kk = pc / 8, c = pc % 8; float x[8]; unpack8(*(const u32x4*)(Vb + (size_t)(key0 + kk) * 64 + 8 * c), x);
#pragma unroll
            for (int e = 0; e < 8; ++e) Vs[(half * 64 + kk) * 64 + 8 * c + e] = x[e]; }
        __syncthreads();
#pragma unroll 2
        for (int j = 0; j < 64; ++j) {
            const LAS float* kr = Ks + (half * 64 + j) * QD; float s = 0.f;
#pragma unroll
            for (int d = 0; d < QD; ++d) s += q[d] * kr[d];
            if (s > m) { const float a = exp2f(m - s); lsum *= a;
#pragma unroll
                for (int d = 0; d < 64; ++d) o[d] *= a;
                m = s; }
            const float pp = exp2f(s - m); lsum += pp;
            const LAS float* vr = Vs + (half * 64 + j) * 64;
#pragma unroll
            for (int d = 0; d < 64; ++d) o[d] += pp * vr[d];
        }
    }
    __syncthreads();
    if (half == 1) { MG[r * 66] = m; MG[r * 66 + 1] = lsum;
#pragma unroll
        for (int d = 0; d < 64; ++d) MG[r * 66 + 2 + d] = o[d]; }
    __syncthreads();
    if (half == 0) { const float m1 = MG[r * 66], l1 = MG[r * 66 + 1]; const float mm = fmaxf(m, m1); const float a0 = exp2f(m - mm), a1 = exp2f(m1 - mm);
        const float inv = 1.0f / (lsum * a0 + l1 * a1);
#pragma unroll
        for (int d = 0; d < 64; ++d) o[d] = (o[d] * a0 + MG[r * 66 + 2 + d] * a1) * inv; }
    __syncthreads();
}
DI void phase_attn_naive(const Frame& F, int l) {
    const bf16* QA = (const bf16*)(F.ws + WS_QA); const bf16* KA = (const bf16*)(F.ws + WS_KA); const bf16* VA = (const bf16*)(F.ws + WS_VA);
    const bf16* QC = (const bf16*)(F.ws + WS_QC); const bf16* KC = (const bf16*)(F.ws + WS_KC); const bf16* VC = (const bf16*)(F.ws + WS_VC);
    bf16* Y = (bf16*)(F.ws + WS_Y);
    const float lam = ((const float*)(F.ws + WS_SCAL))[4 * l], lam_init = ((const float*)(F.ws + WS_SCAL))[4 * l + 1];
    const int r = F.tid & 255, half = F.tid >> 8;
    const int nqt = (l == 0) ? 65 : 64;
    const int nunits = 2 * NB * 4 * nqt;
    for (int u = F.bid; u < nunits; u += F.G) {
        const int kind = u / (NB * 4 * nqt), v = u % (NB * 4 * nqt), qt = v % nqt, bh = v / nqt, b = bh / 4, h = bh % 4;
        const int nkeys = (qt == 64) ? CTXL : KEYS;
        const int qpos = qt * 256 + r;
        const int orow = (qt == 64) ? NLAT + b * CTXL + r : b * SEQ + qt * 256 + r;
        float o[64];
        if (kind == 0) {
            attn_naive_pass<64>(F, QA + ((size_t)(b * 4 + h) * QROWS + qpos) * 64, KA + (size_t)(b * 2 + h / 2) * KEYS * 64, VA + (size_t)(b * 2 + h / 2) * KEYS * 64, nkeys, o);
            if (half == 0) {
#pragma unroll
                for (int i = 0; i < 8; ++i) { float x[8];
#pragma unroll
                    for (int e = 0; e < 8; ++e) x[e] = o[8 * i + e];
                    *(u32x4*)(Y + (size_t)orow * D + h * 64 + 8 * i) = pack8(x); } }
        } else {
            float o0[64];
            attn_naive_pass<32>(F, QC + ((size_t)(b * 4 + h) * QROWS + qpos) * 64, KC + (size_t)(b * 4 + h) * KEYS * 64, VC + (size_t)(b * 4 + h) * KEYS * 64, nkeys, o0);
            attn_naive_pass<32>(F, QC + ((size_t)(b * 4 + h) * QROWS + qpos) * 64 + 32, KC + (size_t)(b * 4 + h) * KEYS * 64 + 32, VC + (size_t)(b * 4 + h) * KEYS * 64, nkeys, o);
            if (half == 0) { float ss = 0.f;
#pragma unroll
                for (int d = 0; d < 64; ++d) { o[d] = o0[d] - lam * o[d]; ss += o[d] * o[d]; }
                const float rstd = rsqrtf(ss * (1.0f / 64.0f) + RMS_EPS) * (1.0f - lam_init);
#pragma unroll
                for (int i = 0; i < 8; ++i) { float x[8];
#pragma unroll
                    for (int e = 0; e < 8; ++e) x[e] = o[8 * i + e] * rstd * F.in[I_CSUBLN][l * 64 + 8 * i + e];
                    *(u32x4*)(Y + (size_t)orow * D + 512 + h * 64 + 8 * i) = pack8(x); } }
        }
    }
}


typedef float f32x16 __attribute__((ext_vector_type(16)));
typedef short s16x4 __attribute__((ext_vector_type(4)));
typedef __bf16 bf16x2_t __attribute__((ext_vector_type(2)));
DI unsigned cvtpk_s(float lo, float hi) { f32x2 v = {lo, hi}; bf16x2_t b = __builtin_convertvector(v, bf16x2_t); return __builtin_bit_cast(unsigned, b); }
DI s16x4 vtr(const LAS unsigned char* p) { return __builtin_bit_cast(s16x4, __builtin_amdgcn_ds_read_tr16_b64_v4i16((LAS s16x4*)p)); }
constexpr int ATT_KSTR = 144, ATT_KB = 64 * ATT_KSTR, ATT_VB = 64 * 128, ATT_BUF = ATT_KB + ATT_VB;
DI void softmax_block(const f32x16& S, float& lsum, bf16x8 (&P)[2]) {
    float p[16];
#pragma unroll
    for (int r = 0; r < 16; ++r) { p[r] = __builtin_amdgcn_exp2f(S[r]); lsum += p[r]; }
#pragma unroll
    for (int st = 0; st < 2; ++st) { u32x4 w; w.x = cvtpk_s(p[8 * st + 0], p[8 * st + 1]); w.y = cvtpk_s(p[8 * st + 2], p[8 * st + 3]); w.z = cvtpk_s(p[8 * st + 4], p[8 * st + 5]); w.w = cvtpk_s(p[8 * st + 6], p[8 * st + 7]);
        P[st] = __builtin_bit_cast(bf16x8, w); }
}
DI void pv_tile(f32x16 (&O)[2], const LAS unsigned char* vbase0, const LAS unsigned char* vbase1, const bf16x8 (&P0)[2], const bf16x8 (&P1)[2]) {
#pragma unroll
    for (int kb = 0; kb < 2; ++kb)
#pragma unroll
        for (int st = 0; st < 2; ++st) {
            const int ro = (32 * kb + 16 * st) * 128;
            const s16x4 a0 = vtr(vbase0 + ro), a1 = vtr(vbase0 + ro + 8 * 128), b0 = vtr(vbase1 + ro), b1 = vtr(vbase1 + ro + 8 * 128);
            const bf16x8 v0 = {a0[0], a0[1], a0[2], a0[3], a1[0], a1[1], a1[2], a1[3]}, v1 = {b0[0], b0[1], b0[2], b0[3], b1[0], b1[1], b1[2], b1[3]};
            const bf16x8 pp = kb == 0 ? P0[st] : P1[st];
            O[0] = __builtin_amdgcn_mfma_f32_32x32x16_bf16(v0, pp, O[0], 0, 0, 0);
            O[1] = __builtin_amdgcn_mfma_f32_32x32x16_bf16(v1, pp, O[1], 0, 0, 0);
        }
}
template <int KIND>
DI void attn_unit(const Frame& F, const bf16* Qb, const bf16* Kb, const bf16* Vb, int ntiles, float bound_in, bf16* Yb, float lam, const float* gain, float post) {
    const int lane = F.lane, w = F.wave, tid = F.tid, q32 = lane & 31, h = lane >> 5;
    LAS unsigned char* lds = F.lds;
    bf16x8 qf[4];
#pragma unroll
    for (int kk = 0; kk < 4; ++kk) qf[kk] = *(const bf16x8*)(Qb + (size_t)(32 * w + q32) * 64 + 16 * kk + 8 * h);
    float bound = bound_in;
    if (KIND == 1) {
        float n0 = 0.f, n1 = 0.f;
#pragma unroll
        for (int kk = 0; kk < 4; ++kk)
#pragma unroll
            for (int e = 0; e < 8; ++e) { const float v = bf2f((unsigned short)qf[kk][e]); if (kk < 2) n0 += v * v; else n1 += v * v; }
        n0 = xadd32(n0); n1 = xadd32(n1);
        bound = sqrtf(fmaxf(n0, n1)) * bound_in * 1.01f + 0.01f;
    }
    f32x16 cinit;
#pragma unroll
    for (int r = 0; r < 16; ++r) cinit[r] = -bound;
    asm volatile("" : "+v"(cinit));
    f32x16 O0[2], O1[2];
#pragma unroll
    for (int db = 0; db < 2; ++db)
#pragma unroll
        for (int r = 0; r < 16; ++r) { O0[db][r] = 0.f; O1[db][r] = 0.f; }
    float l0 = 0.f, l1 = 0.f;
    const int srow = tid >> 3, sc = tid & 7;
    const unsigned kw = (unsigned)(srow * ATT_KSTR + sc * 16), vw = (unsigned)(ATT_KB + srow * 128 + ((sc ^ (((srow >> 1) & 1) << 2)) * 16));
    const bf16* kg = Kb + (size_t)srow * 64 + sc * 8; const bf16* vg = Vb + (size_t)srow * 64 + sc * 8;
    const unsigned kr = (unsigned)(q32 * ATT_KSTR + 16 * h);
    const int qq = (lane & 15) >> 2, pp4 = lane & 3, dsub = (lane >> 4) & 1, sw = (qq >> 1) & 1;
    const unsigned vr0 = (unsigned)(ATT_KB + (4 * h + qq) * 128 + ((0 ^ sw) * 64) + (16 * dsub + 4 * pp4) * 2);
    const unsigned vr1 = (unsigned)(ATT_KB + (4 * h + qq) * 128 + ((1 ^ sw) * 64) + (16 * dsub + 4 * pp4) * 2);
    u32x4 kreg = *(const u32x4*)kg, vreg = *(const u32x4*)vg;
    *(LAS u32x4*)(lds + kw) = kreg; *(LAS u32x4*)(lds + vw) = vreg;
    if (ntiles > 1) { kreg = *(const u32x4*)(kg + 64 * 64); vreg = *(const u32x4*)(vg + 64 * 64); }
#pragma unroll 1
    for (int t = 0; t < ntiles; ++t) {
        __syncthreads();
        const unsigned cb = (unsigned)((t & 1) * ATT_BUF), nb = (unsigned)(((t + 1) & 1) * ATT_BUF);
        if (t + 1 < ntiles) {
            *(LAS u32x4*)(lds + nb + kw) = kreg; *(LAS u32x4*)(lds + nb + vw) = vreg;
            if (t + 2 < ntiles) { kreg = *(const u32x4*)(kg + (size_t)(t + 2) * 64 * 64); vreg = *(const u32x4*)(vg + (size_t)(t + 2) * 64 * 64); }
        }
        const LAS unsigned char* kp = lds + cb + kr;
        if (KIND == 0) {
            f32x16 S0 = cinit, S1 = cinit;
#pragma unroll
            for (int kk = 0; kk < 4; ++kk) {
                const bf16x8 a0 = *(const LAS bf16x8*)(kp + 32 * kk), a1 = *(const LAS bf16x8*)(kp + 32 * ATT_KSTR + 32 * kk);
                S0 = __builtin_amdgcn_mfma_f32_32x32x16_bf16(a0, qf[kk], S0, 0, 0, 0);
                S1 = __builtin_amdgcn_mfma_f32_32x32x16_bf16(a1, qf[kk], S1, 0, 0, 0);
            }
            bf16x8 P0[2], P1[2];
            softmax_block(S0, l0, P0); softmax_block(S1, l0, P1);
            pv_tile(O0, lds + cb + vr0, lds + cb + vr1, P0, P1);
        } else {
#pragma unroll
            for (int c = 0; c < 2; ++c) {
                f32x16 S0 = cinit, S1 = cinit;
#pragma unroll
                for (int k2 = 0; k2 < 2; ++k2) { const int kk = 2 * c + k2;
                    const bf16x8 a0 = *(const LAS bf16x8*)(kp + 32 * kk), a1 = *(const LAS bf16x8*)(kp + 32 * ATT_KSTR + 32 * kk);
                    S0 = __builtin_amdgcn_mfma_f32_32x32x16_bf16(a0, qf[kk], S0, 0, 0, 0);
                    S1 = __builtin_amdgcn_mfma_f32_32x32x16_bf16(a1, qf[kk], S1, 0, 0, 0);
                }
                bf16x8 P0[2], P1[2];
                if (c == 0) { softmax_block(S0, l0, P0); softmax_block(S1, l0, P1); pv_tile(O0, lds + cb + vr0, lds + cb + vr1, P0, P1); }
                else { softmax_block(S0, l1, P0); softmax_block(S1, l1, P1); pv_tile(O1, lds + cb + vr0, lds + cb + vr1, P0, P1); }
                __builtin_amdgcn_sched_barrier(0);
            }
        }
    }
    l0 = xadd32(l0);
    bf16* yrow = Yb + (size_t)(32 * w + q32) * D;
    if (KIND == 0) {
        const float inv = 1.0f / l0;
#pragma unroll
        for (int db = 0; db < 2; ++db)
#pragma unroll
            for (int g = 0; g < 4; ++g) { u32x2 o; o.x = pk2(O0[db][4 * g] * inv, O0[db][4 * g + 1] * inv); o.y = pk2(O0[db][4 * g + 2] * inv, O0[db][4 * g + 3] * inv);
                *(u32x2*)(yrow + 32 * db + 8 * g + 4 * h) = o; }
    } else {
        l1 = xadd32(l1);
        const float i0 = 1.0f / l0, i1 = lam / l1; float ss = 0.f;
#pragma unroll
        for (int db = 0; db < 2; ++db)
#pragma unroll
            for (int r = 0; r < 16; ++r) { const float v = O0[db][r] * i0 - O1[db][r] * i1; O0[db][r] = v; ss += v * v; }
        ss = xadd32(ss);
        const float rstd = rsqrtf(ss * (1.0f / 64.0f) + RMS_EPS) * post;
#pragma unroll
        for (int db = 0; db < 2; ++db)
#pragma unroll
            for (int g = 0; g < 4; ++g) { const f32x4 gg = *(const f32x4*)(gain + 32 * db + 8 * g + 4 * h); u32x2 o;
                o.x = pk2(O0[db][4 * g] * rstd * gg[0], O0[db][4 * g + 1] * rstd * gg[1]); o.y = pk2(O0[db][4 * g + 2] * rstd * gg[2], O0[db][4 * g + 3] * rstd * gg[3]);
                *(u32x2*)(yrow + 32 * db + 8 * g + 4 * h) = o; }
    }
    __syncthreads();
}
DI void phase_attn(const Frame& F, int l) {
    const bf16* QA = (const bf16*)(F.ws + WS_QA); const bf16* KA = (const bf16*)(F.ws + WS_KA); const bf16* VA = (const bf16*)(F.ws + WS_VA);
    const bf16* QC = (const bf16*)(F.ws + WS_QC); const bf16* KC = (const bf16*)(F.ws + WS_KC); const bf16* VC = (const bf16*)(F.ws + WS_VC);
    bf16* Y = (bf16*)(F.ws + WS_Y);
    const float* sc = (const float*)(F.ws + WS_SCAL);
    const float lam = sc[4 * l], lam_init = sc[4 * l + 1], boundA = sc[4 * l + 2];
    const int* MAXK = (const int*)(F.ws + WS_CTL) + CW_MAXK;
    const int nmain = 2 * NB * 4 * 64, nctx = (l == 0) ? 2 * NB * 4 : 0;
    for (int u = F.bid; u < nmain + nctx; u += F.G) {
        int kind, b, h, qt;
        if (u < nmain) { kind = u / (NB * 4 * 64); const int v = u % (NB * 4 * 64); b = v / 256; h = (v / 64) % 4; qt = v % 64; }
        else { const int v = u - nmain; kind = v / (NB * 4); b = (v / 4) % NB; h = v % 4; qt = 64; }
        const int ntiles = (qt == 64) ? CTXL / 64 : KEYS / 64;
        const int orow0 = (qt == 64) ? NLAT + b * CTXL : b * SEQ + qt * 256;
        const Frame U = fresh(F);
#ifdef ATT_ONLY_C
        if (false) {}
#else
        if (kind == 0) attn_unit<0>(U, QA + ((size_t)(b * 4 + h) * QROWS + qt * 256) * 64, KA + (size_t)(b * 2 + h / 2) * KEYS * 64, VA + (size_t)(b * 2 + h / 2) * KEYS * 64, ntiles, boundA,
                                    Y + (size_t)orow0 * D + h * 64, 0.f, nullptr, 0.f);
#endif
#ifndef ATT_ONLY_A
        else { const int mi = ((l * 2 + b) * 4 + h) * 2; const float mk = sqrtf(fmaxf(__int_as_float(MAXK[16 * mi]), __int_as_float(MAXK[16 * (mi + 1)])));
            attn_unit<1>(U, QC + ((size_t)(b * 4 + h) * QROWS + qt * 256) * 64, KC + (size_t)(b * 4 + h) * KEYS * 64, VC + (size_t)(b * 4 + h) * KEYS * 64, ntiles, mk,
                         Y + (size_t)orow0 * D + 512 + h * 64, lam, F.in[I_CSUBLN] + l * 64, 1.0f - lam_init); }
#endif
    }
}


typedef int v8i __attribute__((ext_vector_type(8)));
constexpr int A8_STR = 80, A8_K = 64 * A8_STR, A8_BUF = 2 * A8_K;
constexpr float P_OFFS = 14.0f;
constexpr int SC_ONE = 0x7f7f7f7f, SC_EIGHTH = 0x7c7c7c7c;
DI v8i lds32(const LAS unsigned char* p) { const u32x4 a = *(const LAS u32x4*)p, b = *(const LAS u32x4*)(p + 16); v8i r = {(int)a.x, (int)a.y, (int)a.z, (int)a.w, (int)b.x, (int)b.y, (int)b.z, (int)b.w}; return r; }
DI void softmax8(const f32x16& S0, const f32x16& S1, float& lsum, v8i& P) {
#pragma unroll
    for (int kb = 0; kb < 2; ++kb)
#pragma unroll
        for (int g = 0; g < 4; ++g) { const f32x16& S = kb ? S1 : S0;
            const float p0 = __builtin_amdgcn_exp2f(S[4 * g]), p1 = __builtin_amdgcn_exp2f(S[4 * g + 1]), p2 = __builtin_amdgcn_exp2f(S[4 * g + 2]), p3 = __builtin_amdgcn_exp2f(S[4 * g + 3]);
            lsum += (p0 + p1) + (p2 + p3);
            int wv = 0; wv = __builtin_amdgcn_cvt_pk_bf8_f32(p0, p1, wv, false); wv = __builtin_amdgcn_cvt_pk_bf8_f32(p2, p3, wv, true);
            P[4 * kb + g] = wv; }
}
template <int KIND>
DI void attn8_unit(const Frame& F, const unsigned char* Q8, const unsigned char* K8, const unsigned char* V8, int ntiles, float bound_in, bf16* Yb, float lam, const float* gain, float post) {
    const int lane = F.lane, w = F.wave, tid = F.tid, q32 = lane & 31, h = lane >> 5;
    LAS unsigned char* lds = F.lds;
    const unsigned char* qrow = Q8 + (unsigned)((32 * w + q32) * 64);
    v8i qa; long qc[2][2];
    float bound = bound_in;
    if (KIND == 0) { const u32x4 a = *(const u32x4*)(qrow + 32 * h), b2 = *(const u32x4*)(qrow + 32 * h + 16); qa = (v8i){(int)a.x, (int)a.y, (int)a.z, (int)a.w, (int)b2.x, (int)b2.y, (int)b2.z, (int)b2.w}; }
    else {
        float n0 = 0.f, n1 = 0.f;
#pragma unroll
        for (int c = 0; c < 2; ++c)
#pragma unroll
            for (int kk = 0; kk < 2; ++kk) { const u32x2 v = *(const u32x2*)(qrow + 32 * c + 16 * kk + 8 * h); qc[c][kk] = (long)(((unsigned long long)v.y << 32) | v.x);
                { const float a0 = __builtin_amdgcn_cvt_f32_fp8((int)v.x, 0), a1 = __builtin_amdgcn_cvt_f32_fp8((int)v.x, 1), a2 = __builtin_amdgcn_cvt_f32_fp8((int)v.x, 2), a3 = __builtin_amdgcn_cvt_f32_fp8((int)v.x, 3);
                  const float b0 = __builtin_amdgcn_cvt_f32_fp8((int)v.y, 0), b1 = __builtin_amdgcn_cvt_f32_fp8((int)v.y, 1), b2 = __builtin_amdgcn_cvt_f32_fp8((int)v.y, 2), b3 = __builtin_amdgcn_cvt_f32_fp8((int)v.y, 3);
                  const float nn = (a0 * a0 + a1 * a1) + (a2 * a2 + a3 * a3) + (b0 * b0 + b1 * b1) + (b2 * b2 + b3 * b3); if (c == 0) n0 += nn; else n1 += nn; } }
        n0 = xadd32(n0); n1 = xadd32(n1);
        bound = sqrtf(fmaxf(n0, n1)) * bound_in * 1.15f + 0.1f;
    }
    f32x16 cinit;
#pragma unroll
    for (int r = 0; r < 16; ++r) cinit[r] = P_OFFS - bound;
    asm volatile("" : "+v"(cinit));
    f32x16 O0[2], O1[2];
#pragma unroll
    for (int db = 0; db < 2; ++db)
#pragma unroll
        for (int r = 0; r < 16; ++r) { O0[db][r] = 0.f; O1[db][r] = 0.f; }
    float l0 = 0.f, l1 = 0.f;
    const int which = tid >> 8, srow = (tid & 255) >> 2, sc = tid & 3;
    const unsigned sw = (unsigned)(which * A8_K + srow * A8_STR + sc * 16), goff = (unsigned)(srow * 64 + sc * 16);
    const unsigned char* gsrc = which ? V8 : K8;
#define TLD(t_) (*(const u32x4*)(gsrc + (size_t)(t_) * 4096 + goff))
    const unsigned kr = (unsigned)(q32 * A8_STR), vr = (unsigned)(A8_K + q32 * A8_STR + 32 * h);
    constexpr unsigned GRP = 2 * A8_BUF;
    const bool late = w >= 4;
    u32x4 treg0 = TLD(0), treg1 = TLD(1);
    *(LAS u32x4*)(lds + sw) = treg0; *(LAS u32x4*)(lds + A8_BUF + sw) = treg1;
    if (ntiles > 2) { treg0 = TLD(2); treg1 = TLD(3); }
    unsigned gprev = 2 * GRP, gcur = 0, gnext = GRP;
    auto tile = [&](const unsigned cb) __attribute__((always_inline)) {
        const v8i vf0 = lds32(lds + cb + vr), vf1 = lds32(lds + cb + vr + 32 * A8_STR);
        if (KIND == 0) {
            const v8i k0 = lds32(lds + cb + kr + 32 * h), k1 = lds32(lds + cb + kr + 32 * A8_STR + 32 * h);
            const f32x16 S0 = __builtin_amdgcn_mfma_scale_f32_32x32x64_f8f6f4(k0, qa, cinit, 0, 0, 0, SC_ONE, 0, SC_EIGHTH);
            const f32x16 S1 = __builtin_amdgcn_mfma_scale_f32_32x32x64_f8f6f4(k1, qa, cinit, 0, 0, 0, SC_ONE, 0, SC_EIGHTH);
            v8i P; softmax8(S0, S1, l0, P);
            if (!late) __builtin_amdgcn_s_setprio(1);
            O0[0] = __builtin_amdgcn_mfma_scale_f32_32x32x64_f8f6f4(vf0, P, O0[0], 0, 1, 0, SC_ONE, 0, SC_ONE);
            O0[1] = __builtin_amdgcn_mfma_scale_f32_32x32x64_f8f6f4(vf1, P, O0[1], 0, 1, 0, SC_ONE, 0, SC_ONE);
            if (!late) __builtin_amdgcn_s_setprio(0);
        } else {
#pragma unroll
            for (int c = 0; c < 2; ++c) {
                f32x16 S0 = cinit, S1 = cinit;
#pragma unroll
                for (int kk = 0; kk < 2; ++kk) {
                    const u32x2 a0 = *(const LAS u32x2*)(lds + cb + kr + 32 * c + 16 * kk + 8 * h), a1 = *(const LAS u32x2*)(lds + cb + kr + 32 * A8_STR + 32 * c + 16 * kk + 8 * h);
                    S0 = __builtin_amdgcn_mfma_f32_32x32x16_fp8_fp8((long)(((unsigned long long)a0.y << 32) | a0.x), qc[c][kk], S0, 0, 0, 0);
                    S1 = __builtin_amdgcn_mfma_f32_32x32x16_fp8_fp8((long)(((unsigned long long)a1.y << 32) | a1.x), qc[c][kk], S1, 0, 0, 0);
                }
                v8i P;
                if (c == 0) { softmax8(S0, S1, l0, P);
                    O0[0] = __builtin_amdgcn_mfma_scale_f32_32x32x64_f8f6f4(vf0, P, O0[0], 0, 1, 0, SC_ONE, 0, SC_ONE);
                    O0[1] = __builtin_amdgcn_mfma_scale_f32_32x32x64_f8f6f4(vf1, P, O0[1], 0, 1, 0, SC_ONE, 0, SC_ONE); }
                else { softmax8(S0, S1, l1, P);
                    O1[0] = __builtin_amdgcn_mfma_scale_f32_32x32x64_f8f6f4(vf0, P, O1[0], 0, 1, 0, SC_ONE, 0, SC_ONE);
                    O1[1] = __builtin_amdgcn_mfma_scale_f32_32x32x64_f8f6f4(vf1, P, O1[1], 0, 1, 0, SC_ONE, 0, SC_ONE); }
                __builtin_amdgcn_sched_barrier(0);
            }
        }
    };
#pragma unroll 1
    for (int t = 0; t < ntiles; t += 2) {
        __syncthreads();
        if (t + 2 < ntiles) { *(LAS u32x4*)(lds + gnext + sw) = treg0; *(LAS u32x4*)(lds + gnext + A8_BUF + sw) = treg1; if (t + 4 < ntiles) { treg0 = TLD(t + 4); treg1 = TLD(t + 5); } }
        if (!(late && t == 0)) tile(late ? gprev + (unsigned)A8_BUF : gcur);
        tile(late ? gcur : gcur + (unsigned)A8_BUF);
        const unsigned o_ = gprev; gprev = gcur; gcur = gnext; gnext = o_;
    }
    if (late) tile(gprev + (unsigned)A8_BUF);
#undef TLD
    l0 = xadd32(l0);
    bf16* yrow = (bf16*)((char*)Yb + (unsigned)((32 * w + q32) * D * 2));
    if (KIND == 0) {
        const float inv = 1.0f / l0;
#pragma unroll
        for (int db = 0; db < 2; ++db)
#pragma unroll
            for (int g = 0; g < 4; ++g) { u32x2 o; o.x = pk2(O0[db][4 * g] * inv, O0[db][4 * g + 1] * inv); o.y = pk2(O0[db][4 * g + 2] * inv, O0[db][4 * g + 3] * inv);
                *(u32x2*)(yrow + 32 * db + 8 * g + 4 * h) = o; }
    } else {
        l1 = xadd32(l1);
        const float i0 = 1.0f / l0, i1 = lam / l1; float ss = 0.f;
#pragma unroll
        for (int db = 0; db < 2; ++db)
#pragma unroll
            for (int r = 0; r < 16; ++r) { const float v = O0[db][r] * i0 - O1[db][r] * i1; O0[db][r] = v; ss += v * v; }
        ss = xadd32(ss);
        const float rstd = rsqrtf(ss * (1.0f / 64.0f) + RMS_EPS) * post;
#pragma unroll
        for (int db = 0; db < 2; ++db)
#pragma unroll
            for (int g = 0; g < 4; ++g) { const f32x4 gg = *(const f32x4*)(gain + 32 * db + 8 * g + 4 * h); u32x2 o;
                o.x = pk2(O0[db][4 * g] * rstd * gg[0], O0[db][4 * g + 1] * rstd * gg[1]); o.y = pk2(O0[db][4 * g + 2] * rstd * gg[2], O0[db][4 * g + 3] * rstd * gg[3]);
                *(u32x2*)(yrow + 32 * db + 8 * g + 4 * h) = o; }
    }
    __syncthreads();
}
DI void phase_attn8(const Frame& F, int l) {
    const unsigned char* QA = (const unsigned char*)(F.ws + WS_QA); const unsigned char* KA = (const unsigned char*)(F.ws + WS_KA); const unsigned char* VA = (const unsigned char*)(F.ws + WS_VA);
    const unsigned char* QC = (const unsigned char*)(F.ws + WS_QC); const unsigned char* KC = (const unsigned char*)(F.ws + WS_KC); const unsigned char* VC = (const unsigned char*)(F.ws + WS_VC);
    bf16* Y = (bf16*)(F.ws + WS_Y);
    const float* sc = (const float*)(F.ws + WS_SCAL);
    const float lam = sc[4 * l], lam_init = sc[4 * l + 1], boundA = sc[4 * l + 2] * 1.15f + 0.1f;
    const int* MAXK = (const int*)(F.ws + WS_CTL) + CW_MAXK;
    const int nfull = NB * 4 * 64, nper = nfull + ((l == 0) ? NB * 4 : 0);
    if (F.wave >= 4) __builtin_amdgcn_s_setprio(1);
#pragma unroll 1
    for (int u = F.bid; u < nper; u += F.G) {
        const int qt = u < nfull ? u % 64 : 64, bh = u < nfull ? u / 64 : u - nfull, b = bh / 4, h = bh % 4;
        const int ntiles = (qt == 64) ? CTXL / 64 : KEYS / 64;
        const int orow0 = (qt == 64) ? NLAT + b * CTXL : b * SEQ + qt * 256;
        const Frame U = fresh(F);
        attn8_unit<0>(U, QA + ((size_t)(b * 4 + h) * QROWS + qt * 256) * 64, KA + (size_t)(b * 2 + h / 2) * KEYS * 64, VA + (size_t)(b * 2 + h / 2) * KTILES * 4096, ntiles, boundA,
                      Y + (size_t)orow0 * D + h * 64, 0.f, nullptr, 0.f);
    }
#pragma unroll 1
    for (int u = F.bid; u < nper; u += F.G) {
        const int qt = u < nfull ? u % 64 : 64, bh = u < nfull ? u / 64 : u - nfull, b = bh / 4, h = bh % 4;
        const int ntiles = (qt == 64) ? CTXL / 64 : KEYS / 64;
        const int orow0 = (qt == 64) ? NLAT + b * CTXL : b * SEQ + qt * 256;
        const Frame U = fresh(F);
        const int mi = ((l * 2 + b) * 4 + h) * 2; const float mk = sqrtf(fmaxf(__int_as_float(MAXK[16 * mi]), __int_as_float(MAXK[16 * (mi + 1)])));
        attn8_unit<1>(U, QC + ((size_t)(b * 4 + h) * QROWS + qt * 256) * 64, KC + (size_t)(b * 4 + h) * KEYS * 64, VC + (size_t)(b * 4 + h) * KTILES * 4096, ntiles, mk,
                      Y + (size_t)orow0 * D + 512 + h * 64, lam, F.in[I_CSUBLN] + l * 64, 1.0f - lam_init);
    }
    __builtin_amdgcn_s_setprio(0);
}

#ifndef PROBE_MASK
#define PROBE_MASK 0
#endif
#define PBX(b) do { if ((((PROBE_MASK) >> (b)) & 1)) { volatile LAS unsigned* M_ = (volatile LAS unsigned*)(F.lds + MISC_OFF); const unsigned long long t_ = __builtin_amdgcn_s_memrealtime(); M_[16] = (unsigned)t_; M_[17] = (unsigned)(t_ >> 32); } } while (0)
#define PEX(b) do { if ((((PROBE_MASK) >> (b)) & 1)) { volatile LAS unsigned* M_ = (volatile LAS unsigned*)(F.lds + MISC_OFF); const unsigned long long t_ = __builtin_amdgcn_s_memrealtime() - (((unsigned long long)M_[17] << 32) | M_[16]) + (((unsigned long long)M_[19] << 32) | M_[18]); __syncthreads(); M_[18] = (unsigned)t_; M_[19] = (unsigned)(t_ >> 32); __syncthreads(); } } while (0)
DI void wave_sum4(float (&v)[4]) {
#pragma unroll
    for (int i = 0; i < 4; ++i) v[i] += shx<1>(v[i]);
#pragma unroll
    for (int i = 0; i < 4; ++i) v[i] += shx<2>(v[i]);
#pragma unroll
    for (int i = 0; i < 4; ++i) v[i] += shx<4>(v[i]);
#pragma unroll
    for (int i = 0; i < 4; ++i) v[i] += shx<8>(v[i]);
#pragma unroll
    for (int i = 0; i < 4; ++i) v[i] = xadd16(v[i]);
#pragma unroll
    for (int i = 0; i < 4; ++i) v[i] = xadd32(v[i]);
}
DI void phase_route(const Frame& F, int l, int ntok) {
    constexpr int TROW = 4128, TLO = 2064;
    LAS unsigned char* TK = F.lds;
    LAS float* LG = (LAS float*)(F.lds + 32 * TROW);
    LAS float* LG1 = (LAS float*)(F.lds + 147456);
    const int lane = F.lane, w = F.wave;
    const bf16* __restrict__ Z = (const bf16*)(F.ws + WS_Z); bf16* __restrict__ T = (bf16*)(F.ws + WS_ACT);
    float* XC = (float*)(F.ws + WS_XC); float* __restrict__ RINFO = (float*)(F.ws + WS_RINFO); int* __restrict__ LISTS = (int*)(F.ws + WS_LISTS);
    unsigned* CNT = (unsigned*)(F.ws + WS_CTL) + CW_CNT;
    const int chunk = ntok / NCHUNK;
    const __amdgpu_buffer_rsrc_t rwrs = __builtin_amdgcn_make_buffer_rsrc((void*)(F.ws + WS_RWT + (size_t)l * 262144), 0, 262144, 0x00020000);
    const float rbias = F.in[I_ROUTERB][l * NEXP + lane];
    const int ngrp = ntok / 32;
    u32x2 zr[4][4]; f32x4 xr[4][4];
#define ROUTE_SRC(row0_) ((row0_) < NLAT ? (l == 0 ? F.in[I_X] : F.out) + (size_t)(row0_) * D : (l == 0 ? F.in[I_CTX] : XC) + (size_t)((row0_) - NLAT) * D)
#define ROUTE_FETCH(g_) do { const int r0_ = (g_) * 32 + 4 * w; const float* s_ = ROUTE_SRC(r0_); _Pragma("unroll") for (int tt = 0; tt < 4; ++tt) _Pragma("unroll") for (int j = 0; j < 4; ++j) { \
        zr[tt][j] = *(const u32x2*)(Z + (size_t)(r0_ + tt) * D + 4 * lane + 256 * j); xr[tt][j] = *(const f32x4*)(s_ + (size_t)tt * D + 4 * lane + 256 * j); } } while (0)
    if (F.bid < ngrp) ROUTE_FETCH(F.bid);
#pragma unroll 1
    for (int grp = F.bid; grp < ngrp; grp += F.G) {
        PBX(11);
        {
            const int row0 = grp * 32 + 4 * w, r = mod_row(row0);
            float* __restrict__ dst = row0 < NLAT ? F.out + (size_t)row0 * D : XC + (size_t)(row0 - NLAT) * D;
            f32x4 z[4][4], x[4][4];
#pragma unroll
            for (int tt = 0; tt < 4; ++tt)
#pragma unroll
                for (int j = 0; j < 4; ++j) { const u32x2 wv = zr[tt][j]; z[tt][j] = (f32x4){lo16(wv.x), hi16(wv.x), lo16(wv.y), hi16(wv.y)}; x[tt][j] = xr[tt][j]; }
            float ss[4];
#pragma unroll
            for (int tt = 0; tt < 4; ++tt) { float a = 0.f;
#pragma unroll
                for (int j = 0; j < 4; ++j) a += (z[tt][j][0] * z[tt][j][0] + z[tt][j][1] * z[tt][j][1]) + (z[tt][j][2] * z[tt][j][2] + z[tt][j][3] * z[tt][j][3]);
                ss[tt] = a; }
            wave_sum4(ss);
            { const float* gate = modp(F, l, r, 2); const float* gp = F.in[I_GPOSTMIX] + l * D;
#pragma unroll
              for (int j = 0; j < 4; ++j) { const int c = 4 * lane + 256 * j; const f32x4 gg = *(const f32x4*)(gate + c) * *(const f32x4*)(gp + c);
#pragma unroll
                for (int tt = 0; tt < 4; ++tt) x[tt][j] = x[tt][j] + gg * (z[tt][j] * rsqrtf(ss[tt] * (1.0f / D) + RMS_EPS)); } }
            f32x4 g2[4], hh2[4];
            { const float* g = F.in[I_GPREFFN] + l * D; const float* sh = modp(F, l, r, 3); const float* scl = modp(F, l, r, 4);
#pragma unroll
              for (int j = 0; j < 4; ++j) { const int c = 4 * lane + 256 * j; g2[j] = *(const f32x4*)(g + c) * (1.0f + *(const f32x4*)(scl + c)); hh2[j] = *(const f32x4*)(sh + c); } }
#pragma unroll
            for (int tt = 0; tt < 4; ++tt) { store_row_f32(dst + (size_t)tt * D, lane, x[tt]); float a = 0.f;
#pragma unroll
                for (int j = 0; j < 4; ++j) a += (x[tt][j][0] * x[tt][j][0] + x[tt][j][1] * x[tt][j][1]) + (x[tt][j][2] * x[tt][j][2] + x[tt][j][3] * x[tt][j][3]);
                ss[tt] = a; }
            wave_sum4(ss);
#pragma unroll
            for (int j = 0; j < 4; ++j)
#pragma unroll
                for (int tt = 0; tt < 4; ++tt) x[tt][j] = x[tt][j] * rsqrtf(ss[tt] * (1.0f / D) + RMS_EPS) * g2[j] + hh2[j];
#pragma unroll
            for (int tt = 0; tt < 4; ++tt) {
#pragma unroll
                for (int j = 0; j < 4; ++j) { int wv = 0; wv = __builtin_amdgcn_cvt_pk_fp8_f32(x[tt][j][0], x[tt][j][1], wv, false); wv = __builtin_amdgcn_cvt_pk_fp8_f32(x[tt][j][2], x[tt][j][3], wv, true);
                    *(int*)((unsigned char*)T + (size_t)(row0 + tt) * D + 4 * lane + 256 * j) = wv; }
#pragma unroll
                for (int j = 0; j < 4; ++j) {
                    u32x2 hi, lo; hi.x = pk2(x[tt][j][0], x[tt][j][1]); hi.y = pk2(x[tt][j][2], x[tt][j][3]);
                    lo.x = pk2(x[tt][j][0] - lo16(hi.x), x[tt][j][1] - hi16(hi.x)); lo.y = pk2(x[tt][j][2] - lo16(hi.y), x[tt][j][3] - hi16(hi.y));
                    LAS unsigned char* tp = TK + (4 * w + tt) * TROW + 8 * lane + 512 * j;
                    *(LAS u32x2*)tp = hi; *(LAS u32x2*)(tp + TLO) = lo; } }
        }
        LDS_WAIT(); __syncthreads();
        PEX(11); PBX(12);
        {
            const int eb = w & 3, kh = w >> 2, fr = lane & 15, fq = lane >> 4;
            f32x4 accB[2], accS[2];
#pragma unroll
            for (int tb = 0; tb < 2; ++tb) { accB[tb] = (f32x4){0.f, 0.f, 0.f, 0.f}; accS[tb] = (f32x4){0.f, 0.f, 0.f, 0.f}; }
            const LAS unsigned char* ap = TK + fr * TROW + 16 * fq + 1024 * kh;
            const int so = ((eb * 32 + 16 * kh) * 2) * 1024, vo = 16 * lane;
#define RW_LD(s_, part_) __builtin_bit_cast(bf16x8, __builtin_amdgcn_raw_buffer_load_b128(rwrs, vo, so + ((s_) * 2 + (part_)) * 1024, 0))
            bf16x8 bh[8], bl[8];
#pragma unroll
            for (int sI = 0; sI < 8; ++sI) { bh[sI] = RW_LD(sI, 0); bl[sI] = RW_LD(sI, 1); }
#pragma unroll
            for (int sI = 0; sI < 16; ++sI) {
#pragma unroll
                for (int tb = 0; tb < 2; ++tb) {
                    const bf16x8 ah = *(const LAS bf16x8*)(ap + tb * 16 * TROW + 64 * sI), al = *(const LAS bf16x8*)(ap + tb * 16 * TROW + TLO + 64 * sI);
                    accB[tb] = __builtin_amdgcn_mfma_f32_16x16x32_bf16(ah, bh[sI & 7], accB[tb], 0, 0, 0);
                    accS[tb] = __builtin_amdgcn_mfma_f32_16x16x32_bf16(ah, bl[sI & 7], accS[tb], 0, 0, 0);
                    accS[tb] = __builtin_amdgcn_mfma_f32_16x16x32_bf16(al, bh[sI & 7], accS[tb], 0, 0, 0);
                }
                if (sI + 8 < 16) { bh[sI & 7] = RW_LD(sI + 8, 0); bl[sI & 7] = RW_LD(sI + 8, 1); }
                if (sI == 7) {
                    __builtin_amdgcn_sched_barrier(0); if (grp + F.G < ngrp) ROUTE_FETCH(grp + F.G); __builtin_amdgcn_sched_barrier(0); }
            }
#undef RW_LD
            LAS float* lgp = kh ? LG1 : LG;
#pragma unroll
            for (int tb = 0; tb < 2; ++tb) { const f32x4 at = accB[tb] + accS[tb];
#pragma unroll
                for (int rr = 0; rr < 4; ++rr) lgp[(16 * tb + 4 * fq + rr) * 64 + 16 * eb + fr] = at[rr]; }
        }
        LDS_WAIT(); __syncthreads();
        PEX(12); PBX(13);
        {
            float score[4]; int rank[4]; bool chosen[4];
#pragma unroll
            for (int tt = 0; tt < 4; ++tt) {
                const float logit = LG[(4 * w + tt) * 64 + lane] + LG1[(4 * w + tt) * 64 + lane];
                score[tt] = 1.0f / (1.0f + __expf(-logit));
                const float sel = score[tt] + rbias;
                float m1 = sel; m1 = fmaxf(m1, shx<1>(m1)); m1 = fmaxf(m1, shx<2>(m1)); m1 = fmaxf(m1, shx<4>(m1));
                int i1 = (sel == m1) ? (lane & 7) : 8; i1 = min(i1, shx<1>(i1)); i1 = min(i1, shx<2>(i1)); i1 = min(i1, shx<4>(i1));
                float s2 = ((lane & 7) == i1) ? -INFINITY : sel; s2 = fmaxf(s2, shx<1>(s2)); s2 = fmaxf(s2, shx<2>(s2)); s2 = fmaxf(s2, shx<4>(s2));
                const float gs = m1 + s2; const int g = lane >> 3;
                int grank = 0;
#pragma unroll
                for (int g2 = 0; g2 < 8; ++g2) { const float o = rdlane(gs, 8 * g2); grank += (o > gs || (o == gs && g2 < g)) ? 1 : 0; }
                const float msel = (grank < 4) ? sel : -INFINITY;
                int rk = 0;
#pragma unroll 1
                for (int g2 = 0; g2 < 8; ++g2) if (__builtin_amdgcn_readlane(grank, 8 * g2) < 4) {
#pragma unroll
                    for (int i2 = 0; i2 < 8; ++i2) { const int l2 = 8 * g2 + i2; const float o = rdlane(msel, l2); rk += (o > msel || (o == msel && l2 < lane)) ? 1 : 0; } }
                rank[tt] = rk; chosen[tt] = (rk < TOPK) && (grank < 4);
            }
            float wsum[4];
#pragma unroll
            for (int tt = 0; tt < 4; ++tt) wsum[tt] = chosen[tt] ? score[tt] : 0.f;
            wave_sum4(wsum);
            LAS unsigned* WC = (LAS unsigned*)TK;
            unsigned loc[4], nw = 0;
#pragma unroll
            for (int tt = 0; tt < 4; ++tt) { loc[tt] = nw; nw += chosen[tt] ? 1u : 0u; }
            WC[w * 64 + lane] = nw;
            LDS_WAIT(); __syncthreads();
            if (w == 0) {
                unsigned pre[8], tot = 0;
#pragma unroll
                for (int i = 0; i < 8; ++i) { pre[i] = tot; tot += WC[i * 64 + lane]; }
                const int c = (grp * 32) / chunk;
                const unsigned base = tot ? atomicAdd(CNT + 16 * ((l * NCHUNK + c) * NEXP + lane), tot) : 0u;
#pragma unroll
                for (int i = 0; i < 8; ++i) WC[i * 64 + lane] = base + pre[i];
            }
            LDS_WAIT(); __syncthreads();
            const unsigned wbase = WC[w * 64 + lane];
#pragma unroll
            for (int tt = 0; tt < 4; ++tt) if (chosen[tt]) { const int row = grp * 32 + 4 * w + tt, c = row / chunk; const unsigned slot = wbase + loc[tt];
                if (slot < (unsigned)LCAP) LISTS[(size_t)(c * NEXP + lane) * LCAP + slot] = row * 8 + rank[tt];
                RINFO[(size_t)row * 8 + rank[tt]] = score[tt] / wsum[tt] * 2.5f; }
        }
        __syncthreads();
        PEX(13);
    }
}

struct MoeSched {
    const LAS int* pre; const LAS int* cnt; const LAS int* hsb;
    int ng, nct, G, c, K; int g0;
    const char* A; const char* Wr; const char* Wsh; size_t wstride; const int* lists;
    bool gatherA; int shared_grp;
    int xs, xn, xsh;
    DI void order_init() { xsh = (G & 7) ? 0 : 3; const int total = __builtin_amdgcn_readfirstlane(pre[ng]) * nct, q = total >> xsh, r = total & ((1 << xsh) - 1), xcd = c & ((1 << xsh) - 1); xs = xcd < r ? xcd * (q + 1) : r * (q + 1) + (xcd - r) * q; xn = xcd < r ? q + 1 : q; }
    DI bool next(int i, pg8::Unit& u) const {
        const int off = i * (G >> xsh) + (c >> xsh); if (off >= xn) return false;
        const int L = xs + off;
        const int tile = L / nct, ct = L % nct;
        int lo = 0, hi = ng;
        while (hi - lo > 1) { const int mid = (lo + hi) >> 1; if (__builtin_amdgcn_readfirstlane(pre[mid]) <= tile) lo = mid; else hi = mid; }
        const int g = lo, rt = tile - __builtin_amdgcn_readfirstlane(pre[g]);
        const int cg = __builtin_amdgcn_readfirstlane(cnt[g]), hb = __builtin_amdgcn_readfirstlane(hsb[g]);
        const bool sh = (g == shared_grp);
        u.pn = ct; u.nvalid = min(cg - rt * 256, 256); u.aux = g;
        u.rows = sh ? nullptr : lists + (size_t)(g0 + g) * LCAP + rt * 256;
        const char* Wb = sh ? Wsh : Wr + (size_t)((g0 + g) % NEXP) * wstride;
        u.B = Wb + (size_t)ct * 256 * K;
        if (gatherA) { u.A = sh ? A + (size_t)rt * 256 * K : A; u.orow0 = hb + rt * 256; }
        else { u.A = A + (size_t)(hb + rt * 256) * K; u.orow0 = rt * 256; }
        return true;
    }
};
DI void moe_tables(const Frame& F, int l, int ntok, int gbeg, int n, bool with_shared, LAS int* pre, LAS int* cnt, LAS int* hsb, LAS int* tmp) {
    const unsigned* CNT = (const unsigned*)(F.ws + WS_CTL) + CW_CNT;
    __syncthreads();
    if (F.tid < NCHUNK * NEXP) tmp[F.tid] = (int)min(__hip_atomic_load(CNT + 16 * (l * NCHUNK * NEXP + F.tid), __ATOMIC_RELAXED, __HIP_MEMORY_SCOPE_AGENT), (unsigned)LCAP);
    __syncthreads();
    if (F.wave == 0) {
        constexpr int GPL = NCHUNK * NEXP / 64;
        int c[GPL], t[GPL], ts = 0;
#pragma unroll
        for (int i = 0; i < GPL; ++i) { c[i] = tmp[GPL * F.lane + i]; t[i] = (c[i] + 255) >> 8; ts += t[i]; }
        int incl = ts;
#pragma unroll
        for (int o = 1; o < 64; o <<= 1) { const int v = __builtin_amdgcn_ds_bpermute((F.lane - o) << 2, incl); if (F.lane >= o) incl += v; }
        int run = incl - ts;
        const int before = rdlane(incl - ts, gbeg / GPL);
        const int endp = rdlane(incl, (gbeg + n) / GPL - 1);
#pragma unroll
        for (int i = 0; i < GPL; ++i) { const int g = GPL * F.lane + i;
            if (g >= gbeg && g < gbeg + n) { pre[g - gbeg] = run - before; cnt[g - gbeg] = c[i]; hsb[g - gbeg] = run * 256; }
            run += t[i]; }
        if (F.lane == 0) { const int p = endp - before;
            if (with_shared) { pre[n] = p; cnt[n] = ntok; hsb[n] = HS_SH_BASE; pre[n + 1] = p + ntok / 256; }
            else pre[n] = p; }
    }
    __syncthreads();
}

DI int ccol(int lane, int j) { return (lane >> 4) * 256 + ((lane >> 2) & 3) * 32 + (lane & 3) * 8 + (j & 1) * 4 + (j >> 1) * 128; }
struct CmbTok { u32x4 f0[2]; u32x4 o[4]; };
DI void cmb_load(CmbTok& t, const bf16* __restrict__ F0row, const unsigned char* __restrict__ O2row, int lane) {
    t.f0[0] = *(const u32x4*)(F0row + ccol(lane, 0)); t.f0[1] = *(const u32x4*)(F0row + ccol(lane, 2));
#pragma unroll
    for (int k = 0; k < 4; ++k) t.o[k] = *(const u32x4*)(O2row + (size_t)k * D + 16 * lane);
}
DI f32x4 fp8x4(unsigned w) { const auto lo = __builtin_amdgcn_cvt_pk_f32_fp8((int)w, false), hi = __builtin_amdgcn_cvt_pk_f32_fp8((int)w, true); return (f32x4){lo[0], lo[1], hi[0], hi[1]}; }
struct CmbMod { f32x4 gg[4], gm[4], sh[4]; };
DI void cmb_mod_load(const Frame& F, CmbMod& m, int l, int r, int lane) {
    const float* gate = modp(F, l, r, 5); const float* gp = F.in[I_GPOSTFFN] + l * D;
#pragma unroll
    for (int j = 0; j < 4; ++j) { const int cc = ccol(lane, j); m.gg[j] = *(const f32x4*)(gate + cc) * *(const f32x4*)(gp + cc); }
    if (l == 0) { const float* g = F.in[I_GPREMIX] + D; const float* shift = modp(F, 1, r, 0); const float* scale = modp(F, 1, r, 1);
#pragma unroll
        for (int j = 0; j < 4; ++j) { const int cc = ccol(lane, j); m.gm[j] = *(const f32x4*)(g + cc) * (1.0f + *(const f32x4*)(scale + cc)); m.sh[j] = *(const f32x4*)(shift + cc); } }
}
DI void cmb_finish(const Frame& F, const CmbTok& t, const CmbMod& md, int l, int row, const unsigned char* __restrict__ O2row, float* __restrict__ xp, bf16* __restrict__ actrow, const float* __restrict__ rinfo, int lane) {
    u32x4 o2[4]; f32x4 tx[4]; float wk[8];
#pragma unroll
    for (int k = 0; k < 4; ++k) o2[k] = *(const u32x4*)(O2row + (size_t)(4 + k) * D + 16 * lane);
#pragma unroll
    for (int j = 0; j < 4; ++j) tx[j] = *(const f32x4*)(xp + ccol(lane, j));
#pragma unroll
    for (int k = 0; k < 8; ++k) wk[k] = rinfo[k] * (1.0f / 16.0f);
    f32x4 f[4];
#pragma unroll
    for (int h2 = 0; h2 < 2; ++h2) { const u32x4 w = t.f0[h2]; f[2 * h2] = (f32x4){lo16(w.x), hi16(w.x), lo16(w.y), hi16(w.y)}; f[2 * h2 + 1] = (f32x4){lo16(w.z), hi16(w.z), lo16(w.w), hi16(w.w)}; }
#pragma unroll
    for (int k = 0; k < 4; ++k) { const u32x4 w = t.o[k]; f[0] += wk[k] * fp8x4(w.x); f[1] += wk[k] * fp8x4(w.y); f[2] += wk[k] * fp8x4(w.z); f[3] += wk[k] * fp8x4(w.w); }
#pragma unroll
    for (int k = 0; k < 4; ++k) { const u32x4 w = o2[k]; f[0] += wk[4 + k] * fp8x4(w.x); f[1] += wk[4 + k] * fp8x4(w.y); f[2] += wk[4 + k] * fp8x4(w.z); f[3] += wk[4 + k] * fp8x4(w.w); }
    const float rf = rsqrtf(row_sumsq(f) * (1.0f / D) + RMS_EPS);
    f32x4 x[4];
#pragma unroll
    for (int j = 0; j < 4; ++j) x[j] = tx[j] + md.gg[j] * (f[j] * rf);
#pragma unroll
    for (int j = 0; j < 4; ++j) *(f32x4*)(xp + ccol(lane, j)) = x[j];
    if (l == 0) {
        const float rx = rsqrtf(row_sumsq(x) * (1.0f / D) + RMS_EPS);
#pragma unroll
        for (int j = 0; j < 4; ++j) x[j] = (x[j] * rx) * md.gm[j] + md.sh[j];
#pragma unroll
        for (int h2 = 0; h2 < 2; ++h2) { int w0 = 0, w1 = 0;
            w0 = __builtin_amdgcn_cvt_pk_fp8_f32(x[2 * h2][0], x[2 * h2][1], w0, false); w0 = __builtin_amdgcn_cvt_pk_fp8_f32(x[2 * h2][2], x[2 * h2][3], w0, true);
            w1 = __builtin_amdgcn_cvt_pk_fp8_f32(x[2 * h2 + 1][0], x[2 * h2 + 1][1], w1, false); w1 = __builtin_amdgcn_cvt_pk_fp8_f32(x[2 * h2 + 1][2], x[2 * h2 + 1][3], w1, true);
            u32x2 w; w.x = (unsigned)w0; w.y = (unsigned)w1; *(u32x2*)((unsigned char*)actrow + ccol(lane, 2 * h2)) = w; }
    }
}
DI void phase_combine(const Frame& F, int l, int ntok, int c) {
    const int gw = F.bid * NWAVES + F.wave, NGW = F.G * NWAVES, lane = F.lane;
    const int chunk = ntok / NCHUNK;
    const unsigned char* OUT2 = (const unsigned char*)(F.ws + WS_OUT2 + (size_t)c * OUT2_CHUNK); const bf16* F0 = (const bf16*)(F.ws + WS_F0); const float* RINFO = (const float*)(F.ws + WS_RINFO);
    float* XC = (float*)(F.ws + WS_XC); bf16* ACT = (bf16*)(F.ws + WS_ACT);
#define CMB_PTRS(i_) const int row_##i_ = c * chunk + (i_); float* xp_##i_ = row_##i_ < NLAT ? F.out + (size_t)row_##i_ * D : XC + (size_t)(row_##i_ - NLAT) * D
    int i = gw;
    if (i >= chunk) return;
    CmbTok ta, tb; CmbMod md; int rcur = -1;
#define CMB_MOD(row_) do { const int r_ = mod_row(row_); if (r_ != rcur) { cmb_mod_load(F, md, l, r_, lane); rcur = r_; } } while (0)
    { CMB_PTRS(i); cmb_load(ta, F0 + (size_t)row_i * D, OUT2 + (size_t)i * 8 * D, lane); }
    for (;;) {
        const int i2 = i + NGW;
        if (i2 < chunk) { CMB_PTRS(i2); cmb_load(tb, F0 + (size_t)row_i2 * D, OUT2 + (size_t)i2 * 8 * D, lane); }
        { CMB_PTRS(i); CMB_MOD(row_i); cmb_finish(F, ta, md, l, row_i, OUT2 + (size_t)i * 8 * D, xp_i, (bf16*)((unsigned char*)ACT + (size_t)row_i * D), RINFO + (size_t)row_i * 8, lane); }
        if (i2 >= chunk) break;
        const int i3 = i2 + NGW;
        if (i3 < chunk) { CMB_PTRS(i3); cmb_load(ta, F0 + (size_t)row_i3 * D, OUT2 + (size_t)i3 * 8 * D, lane); }
        { CMB_PTRS(i2); CMB_MOD(row_i2); cmb_finish(F, tb, md, l, row_i2, OUT2 + (size_t)i2 * 8 * D, xp_i2, (bf16*)((unsigned char*)ACT + (size_t)row_i2 * D), RINFO + (size_t)row_i2 * 8, lane); }
        if (i3 >= chunk) break;
        i = i3;
    }
#undef CMB_PTRS
#undef CMB_MOD
}

constexpr int PH_PRO_A = 0, PH_PRO_B = 1, PH_L0 = 2, PH_PER_LAYER = 6 + 2 * NCHUNK, N_PHASES = PH_L0 + 2 * PH_PER_LAYER;
__global__ void __launch_bounds__(NTHREADS, 2) fwd(Args args) {
    extern __shared__ __attribute__((aligned(16))) unsigned char lds_raw[];
    Frame F;
    F.lds = (LAS unsigned char*)lds_raw;
    F.tid = 0; F.lane = 0; F.wave = __builtin_amdgcn_readfirstlane((int)threadIdx.x >> 6);
    F.G = gridDim.x; F.bid = blockIdx.x; F.in = args.in; F.out = args.out; F.ws = args.ws;
    volatile LAS unsigned* MISC = (volatile LAS unsigned*)(F.lds + MISC_OFF);
    for (int u = threadIdx.x; u < (147456 - LDSCTL_OFF) / 4; u += NTHREADS) ((LAS unsigned*)(F.lds + LDSCTL_OFF))[u] = 0u;
    __syncthreads();
    const int lo = args.ph_lo, hi = args.ph_hi;
    XcdBarrier bar; bar.bar = (unsigned*)(F.ws + WS_CTL) + CW_BAR; bar.x = 0; bar.st = nullptr;
    if (hi - lo > 1) bar = xcd_barrier_post((unsigned*)(F.ws + WS_CTL) + CW_BAR, MISC + 8, threadIdx.x == 0);
#ifndef EN_MASK
#define EN_MASK 0x3ff
#endif
#define EN(b) (((EN_MASK) >> (b)) & 1)
#define IN(k) (lo <= (k) && (k) < hi)
#ifndef PROBE_MASK
#define PROBE_MASK 0
#endif
#ifndef PROBE_MULT
#define PROBE_MULT 8
#endif
#define PB(b) do { if ((((PROBE_MASK) >> (b)) & 1)) { const unsigned long long t_ = __builtin_amdgcn_s_memrealtime(); MISC[16] = (unsigned)t_; MISC[17] = (unsigned)(t_ >> 32); } } while (0)
#define PE(b) do { if ((((PROBE_MASK) >> (b)) & 1)) { const unsigned long long t_ = __builtin_amdgcn_s_memrealtime() - (((unsigned long long)MISC[17] << 32) | MISC[16]) + (((unsigned long long)MISC[19] << 32) | MISC[18]); __syncthreads(); MISC[18] = (unsigned)t_; MISC[19] = (unsigned)(t_ >> 32); __syncthreads(); } } while (0)
#ifndef REP_MASK
#define REP_MASK 0
#endif
#define REPS(b) _Pragma("unroll 1") for (int rep_ = 0; rep_ < ((((REP_MASK) >> (b)) & 1) ? 2 : 1); ++rep_)
#define SEAM(k) do { if (IN(k) && IN((k) + 1)) { PB(10); const Frame B_ = fresh(F); XcdBarrier b2_ = bar; b2_.bar = bar.bar + opaque0(); xcd_barrier(b2_, B_.tid == 0); PE(10); } } while (0)
    LAS int* TPRE = (LAS int*)(F.lds + TBL_OFF); LAS int* TCNT = TPRE + 272; LAS int* THSB = TCNT + 272; LAS int* TTMP = THSB + 272;

    PB(0); if (EN(0) && IN(PH_PRO_A)) REPS(0) { const Frame P_ = fresh(F); phase_pro_a(P_); } SEAM(PH_PRO_A); PE(0);
    PB(1); if (EN(1) && IN(PH_PRO_B)) REPS(1) { const Frame P_ = fresh(F); phase_pro_b(P_); } SEAM(PH_PRO_B); PE(1);
#pragma unroll 1
    for (int l = 0; l < 2; ++l) {
        const int P = PH_L0 + l * PH_PER_LAYER;
        const int ntok = (l == 0) ? NTOK : NLAT;
        PB(2); if (EN(2) && IN(P + 0)) REPS(2) {
            const Frame Q = fresh(F);
            pg8::DenseOrder S; S.init(Q.ws + WS_ACT, Q.ws + WS_WIN + (size_t)l * PW * D, NTOK, PW, D, Q.G, Q.bid);
            pg8::EpiBf16 E{(bf16*)(Q.ws + WS_PJ), PW, 1.0f / 32.0f};
            pg8::gemm_phase<pg8::EpiBf16, pg8::DenseOrder, false, true>(Q.lds, Q.tid, D, S, E, Q.ws);
        } SEAM(P + 0); PE(2);
        PB(3); if (EN(3) && IN(P + 1)) REPS(3) { const Frame P_ = fresh(F); phase_post(P_, l); } SEAM(P + 1); PE(3);
        PB(4); if (EN(4) && IN(P + 2)) REPS(4) { const Frame P_ = fresh(F);
#if ATTN_NAIVE
            phase_attn_naive(P_, l);
#else
#if ATTN_FP8
            phase_attn8(P_, l);
#else
            phase_attn(P_, l);
#endif
#endif
        } SEAM(P + 2); PE(4);
        PB(5); if (EN(5) && IN(P + 3)) REPS(5) {
            const Frame Q = fresh(F);
            pg8::DenseOrder S; S.init(Q.ws + WS_Y, Q.ws + WS_WOUT + (size_t)l * D * D * 2, ntok, D, 2 * D, Q.G, Q.bid);
            pg8::EpiBf16 E{(bf16*)(Q.ws + WS_Z), D, 1.0f};
            pg8::gemm_phase<pg8::EpiBf16, pg8::DenseOrder, false>(Q.lds, Q.tid, 2 * D, S, E, Q.ws);
        } SEAM(P + 3); PE(5);
        PB(6); if (EN(6) && IN(P + 4)) { const Frame P_ = fresh(F); phase_route(P_, l, ntok); } SEAM(P + 4); PE(6);
        PB(7); if (EN(7) && IN(P + 5)) REPS(7) {
            const Frame Q = fresh(F);
            moe_tables(Q, l, ntok + (int)opaque0(), 0, NCHUNK * NEXP, true, TPRE, TCNT, THSB, TTMP);
            MoeSched S; S.pre = TPRE; S.cnt = TCNT; S.hsb = THSB; S.ng = NCHUNK * NEXP + 1; S.nct = 2; S.G = Q.G; S.c = Q.bid; S.K = D; S.g0 = 0;
            S.A = (const char*)(Q.ws + WS_ACT); S.Wr = (const char*)(Q.ws + WS_WE13); S.Wsh = (const char*)(Q.ws + WS_WSH13) + (size_t)l * 512 * D; S.wstride = (size_t)512 * D;
            S.lists = (const int*)(Q.ws + WS_LISTS); S.gatherA = true; S.shared_grp = NCHUNK * NEXP;
            pg8::EpiSwiglu E{(unsigned char*)(Q.ws + WS_HS)};
            S.order_init();
            pg8::gemm_phase<pg8::EpiSwiglu, MoeSched, true, true>(Q.lds, Q.tid, D, S, E, Q.ws);
        } SEAM(P + 5); PE(7);
#pragma unroll 1
        for (int c = 0; c < NCHUNK; ++c) {
            PB(8); if (EN(8) && IN(P + 6 + 2 * c)) REPS(8) {
                const Frame Q = fresh(F);
                moe_tables(Q, l, ntok + (int)opaque0(), c * NEXP, NEXP, c == 0, TPRE, TCNT, THSB, TTMP);
                MoeSched S; S.pre = TPRE; S.cnt = TCNT; S.hsb = THSB; S.ng = NEXP + (c == 0 ? 1 : 0); S.nct = 4; S.G = Q.G; S.c = Q.bid; S.K = EH; S.g0 = c * NEXP;
                S.A = (const char*)(Q.ws + WS_HS); S.Wr = (const char*)(Q.ws + WS_WE2); S.Wsh = (const char*)(Q.ws + WS_WSH2) + (size_t)l * D * EH; S.wstride = (size_t)D * EH;
                S.lists = (const int*)(Q.ws + WS_LISTS); S.gatherA = false; S.shared_grp = (c == 0) ? NEXP : -1;
                pg8::EpiMoeOut E{(bf16*)(Q.ws + WS_OUT2 + (size_t)c * OUT2_CHUNK), (bf16*)(Q.ws + WS_F0), c * (ntok / NCHUNK) * 8};
                S.order_init();
                pg8::gemm_phase<pg8::EpiMoeOut, MoeSched, false, true>(Q.lds, Q.tid, EH, S, E, Q.ws);
            } SEAM(P + 6 + 2 * c); PE(8);
            PB(9); if (EN(9) && IN(P + 7 + 2 * c)) {
                const Frame Q = fresh(F);
                phase_combine(Q, l, ntok, c);
                if (l == 0 && c == NCHUNK - 1) convert_experts(Q, 1, (LAS float*)(Q.lds + Q.wave * 16384));
            } if (c == NCHUNK - 1) SEAM(P + 7 + 2 * c); PE(9);
        }
    }
#undef IN
#undef SEAM
    const Frame E_ = fresh(F);
    if (PROBE_MASK != 0 && E_.bid == 0 && E_.tid == 0) { const unsigned long long te = __builtin_amdgcn_s_memrealtime(); const unsigned long long want = (unsigned long long)PROBE_MULT * ((((unsigned long long)MISC[19] << 32) | MISC[18]));
        while (__builtin_amdgcn_s_memrealtime() - te < want) __builtin_amdgcn_s_sleep(8); }
}

extern "C" void kernel_launch(void* const* d_in, const int* in_sizes, int n_in, void* d_out, int out_size, void* d_ws, size_t ws_size, hipStream_t stream) {
    static int grid = 0;
    if (grid == 0) {
        if (n_in != 28 || in_sizes[0] != NLAT * D || out_size != NLAT * D || ws_size < WS_END) { fprintf(stderr, "kernel_launch: unexpected shapes or workspace (%zu < %zu)\n", ws_size, (size_t)WS_END); grid = -1; return; }
        int dev = 0, cus = 0, per_cu = 0;
        if (hipGetDevice(&dev) != hipSuccess || hipDeviceGetAttribute(&cus, hipDeviceAttributeMultiprocessorCount, dev) != hipSuccess) { grid = -1; return; }
        if (hipFuncSetAttribute((const void*)fwd, hipFuncAttributeMaxDynamicSharedMemorySize, LDS_BYTES) != hipSuccess) { fprintf(stderr, "kernel_launch: hipFuncSetAttribute failed\n"); grid = -1; return; }
        if (hipOccupancyMaxActiveBlocksPerMultiprocessor(&per_cu, (const void*)fwd, NTHREADS, LDS_BYTES) != hipSuccess || per_cu < 1) { fprintf(stderr, "kernel_launch: occupancy query says %d\n", per_cu); }
        (void)hipGetLastError();
        grid = cus;
    }
    if (grid < 0) return;
    if (hipMemsetAsync((char*)d_ws + WS_CTL, 0, CTL_ZERO_BYTES, stream) != hipSuccess) return;
    Args a{};
    for (int i = 0; i < 28; ++i) a.in[i] = (const float*)d_in[i];
    a.out = (float*)d_out; a.ws = (unsigned char*)d_ws;
#if MK_ONE_LAUNCH
    a.ph_lo = 0; a.ph_hi = N_PHASES;
    hipLaunchKernelGGL(fwd, dim3(grid), dim3(NTHREADS), LDS_BYTES, stream, a);
#else
    for (int p = 0; p < N_PHASES; ++p) { a.ph_lo = p; a.ph_hi = p + 1; hipLaunchKernelGGL(fwd, dim3(grid), dim3(NTHREADS), LDS_BYTES, stream, a); }
#endif
}
```
